# Optimizing an MI355X kernel written in HIP

```python
import math
import jax, jax.numpy as jnp
from jax import lax
import numpy as np

D_MODEL = 2048
BATCH = 1
SEQ = 8192
DEPTH = 2

CHUNK = 64
HEAD_DIM = 128
D_FF = ((8 * D_MODEL // 3 + 127) // 128) * 128
N_SUB = 3
EPS = 1e-6
D_A = D_MODEL // 2
S5_GROUP = 16
S5_GROUPS = D_A // S5_GROUP
S5_STATE = 64
DT_MIN = 1e-3
DT_MAX = 1e-1
D_B = D_MODEL // 2
B_HEADS = D_B // HEAD_DIM
KV_RANK = D_MODEL // 8
IDX_HEADS = 16
IDX_DIM = 64
TOPK_MAX = 256
Q_BLOCK = 128
AB_SPLITS = (D_A, D_A + D_B, D_A + D_B + KV_RANK, D_A + D_B + KV_RANK + IDX_HEADS * IDX_DIM, D_A + D_B + KV_RANK + IDX_HEADS * IDX_DIM + IDX_DIM)
D_IN_AB = AB_SPLITS[-1] + IDX_HEADS
C_HEADS = D_MODEL // HEAD_DIM
C_LEFT_CHUNKS = 8
BAND = (C_LEFT_CHUNKS + 1) * CHUNK
MAX_REL = 256
N_EVEN = (DEPTH + 1) // 2
N_ODD = DEPTH // 2

kernel_name = 'hybrid_s5_dsa_chunkattn_macaron'


def rmsnorm(x, g):
    xf = x.astype(jnp.float32)
    y = xf * lax.rsqrt(jnp.mean(xf * xf, axis=-1, keepdims=True) + EPS)
    return (y * g.astype(jnp.float32)).astype(x.dtype)


def adaln(x, g, shift, scale):
    return rmsnorm(x, g) * (1.0 + scale[:, None, :]) + shift[:, None, :]


def swiglu(h, w_gate, w_up, w_down):
    return (jax.nn.silu(h @ w_gate) * (h @ w_up)) @ w_down


def alibi_slopes(n_heads):
    return jnp.asarray(2.0 ** (-8.0 * (np.arange(n_heads) + 1) / n_heads), dtype=jnp.float32)


def s5_mixer(u, lam_re, lam_im, log_dt, b_re, b_im, c_re, c_im, d_skip, w_glu, b_glu):
    f32 = jnp.float32
    bsz, L, _ = u.shape
    uf = u.astype(f32)
    ug = uf.reshape(bsz, L, S5_GROUPS, S5_GROUP)
    lr = lam_re.astype(f32)
    li = lam_im.astype(f32)
    dt = jnp.exp(log_dt.astype(f32))[:, None]
    mag = jnp.exp(lr * dt)
    ab_re = mag * jnp.cos(li * dt)
    ab_im = mag * jnp.sin(li * dt)
    den = lr * lr + li * li
    nr = ab_re - 1.0
    f_re = (nr * lr + ab_im * li) / den
    f_im = (ab_im * lr - nr * li) / den
    br = b_re.astype(f32)
    bi = b_im.astype(f32)
    bb_re = f_re[..., None] * br - f_im[..., None] * bi
    bb_im = f_re[..., None] * bi + f_im[..., None] * br
    bu_re = jnp.einsum('blgc,gpc->blgp', ug, bb_re)
    bu_im = jnp.einsum('blgc,gpc->blgp', ug, bb_im)
    a_re = jnp.broadcast_to(ab_re, bu_re.shape)
    a_im = jnp.broadcast_to(ab_im, bu_im.shape)

    def combine(e1, e2):
        a1r, a1i, b1r, b1i = e1
        a2r, a2i, b2r, b2i = e2
        return (a2r * a1r - a2i * a1i, a2r * a1i + a2i * a1r,
                a2r * b1r - a2i * b1i + b2r, a2r * b1i + a2i * b1r + b2i)

    _, _, xr, xi = lax.associative_scan(combine, (a_re, a_im, bu_re, bu_im), axis=1)
    y = jnp.einsum('blgp,gcp->blgc', xr, c_re.astype(f32)) - jnp.einsum('blgp,gcp->blgc', xi, c_im.astype(f32))
    y = y.reshape(bsz, L, D_A) + d_skip.astype(f32) * uf
    y = jax.nn.gelu(y.astype(u.dtype))
    return y * jax.nn.sigmoid(y @ w_glu + b_glu)


def dsa_mixer(q, kv_lat, q_idx, k_idx, w_idx, kv_norm_g, w_kv_up):
    f32 = jnp.float32
    bsz, L, _ = q.shape
    topk = min(TOPK_MAX, L // 4)
    kv = rmsnorm(kv_lat, kv_norm_g) @ w_kv_up
    k, v = jnp.split(kv, 2, axis=-1)
    k = k.reshape(bsz, L, B_HEADS, HEAD_DIM)
    v = v.reshape(bsz, L, B_HEADS, HEAD_DIM)
    q = q.reshape(bsz, L, B_HEADS, HEAD_DIM)
    q_idx = q_idx.reshape(bsz, L, IDX_HEADS, IDX_DIM)
    n_blk = L // Q_BLOCK
    key_chunk = jnp.arange(L) // CHUNK
    slopes = alibi_slopes(B_HEADS)
    k_idx32 = k_idx.astype(f32)

    def to_blocks(a):
        return jnp.moveaxis(a.reshape(bsz, n_blk, Q_BLOCK, *a.shape[2:]), 1, 0)

    def block(args):
        blk, qb, qib, wb = args
        t = blk * Q_BLOCK + jnp.arange(Q_BLOCK)
        s_h = jnp.einsum('bqhd,bsd->bqhs', qib.astype(f32), k_idx32) * (IDX_DIM ** -0.5)
        score = jnp.einsum('bqhs,bqh->bqs', jax.nn.relu(s_h), wb.astype(f32)) * (IDX_HEADS ** -0.5)
        admissible = key_chunk[None, :] <= (t // CHUNK)[:, None]
        score = jnp.where(admissible[None], score, -jnp.inf)
        _, sel = lax.top_k(score, topk)
        k_sel = jax.vmap(lambda kk, ii: kk[ii])(k, sel)
        v_sel = jax.vmap(lambda vv, ii: vv[ii])(v, sel)
        logits = jnp.einsum('bqhd,bqkhd->bhqk', qb, k_sel).astype(f32) * (HEAD_DIM ** -0.5)
        dist = jnp.abs(t[None, :, None] - sel).astype(f32)
        logits = logits - slopes[None, :, None, None] * dist[:, None]
        valid = (sel // CHUNK) <= (t // CHUNK)[None, :, None]
        logits = jnp.where(valid[:, None], logits, -jnp.inf)
        p = jax.nn.softmax(logits, axis=-1).astype(v.dtype)
        return jnp.einsum('bhqk,bqkhd->bqhd', p, v_sel)

    out = lax.map(block, (jnp.arange(n_blk), to_blocks(q), to_blocks(q_idx), to_blocks(w_idx)))
    return jnp.moveaxis(out, 0, 1).reshape(bsz, L, D_B)


def ab_mixer(h, w_in, lam_re, lam_im, log_dt, b_re, b_im, c_re, c_im, d_skip, w_glu, b_glu, kv_norm_g, w_kv_up, w_out):
    proj = h @ w_in
    u, q, kv_lat, q_idx, k_idx, w_idx = jnp.split(proj, list(AB_SPLITS), axis=-1)
    y_a = s5_mixer(u, lam_re, lam_im, log_dt, b_re, b_im, c_re, c_im, d_skip, w_glu, b_glu)
    y_b = dsa_mixer(q, kv_lat, q_idx, k_idx, w_idx, kv_norm_g, w_kv_up)
    return jnp.concatenate([y_a, y_b], axis=-1) @ w_out


def chunked_relpos_attention(h, w_qkv, rel_bias, w_out):
    f32 = jnp.float32
    bsz, L, _ = h.shape
    n_chunks = L // CHUNK
    pad = C_LEFT_CHUNKS * CHUNK
    q, k, v = jnp.split(h @ w_qkv, 3, axis=-1)
    q = q.reshape(bsz, L, C_HEADS, HEAD_DIM)
    k = jnp.pad(k.reshape(bsz, L, C_HEADS, HEAD_DIM), ((0, 0), (pad, 0), (0, 0), (0, 0)))
    v = jnp.pad(v.reshape(bsz, L, C_HEADS, HEAD_DIM), ((0, 0), (pad, 0), (0, 0), (0, 0)))
    i = jnp.arange(CHUNK)
    j = jnp.arange(BAND)
    rel = i[:, None] - j[None, :] + pad
    bias = rel_bias.astype(f32)[:, jnp.clip(rel, -MAX_REL, MAX_REL) + MAX_REL]
    q_chunks = jnp.moveaxis(q.reshape(bsz, n_chunks, CHUNK, C_HEADS, HEAD_DIM), 1, 0)

    def chunk_fn(args):
        cidx, qc = args
        kb = lax.dynamic_slice_in_dim(k, cidx * CHUNK, BAND, axis=1)
        vb = lax.dynamic_slice_in_dim(v, cidx * CHUNK, BAND, axis=1)
        logits = jnp.einsum('bqhd,bkhd->bhqk', qc, kb).astype(f32) * (HEAD_DIM ** -0.5) + bias[None]
        valid = (cidx * CHUNK - pad + j) >= 0
        logits = jnp.where(valid[None, None, None, :], logits, -jnp.inf)
        p = jax.nn.softmax(logits, axis=-1).astype(vb.dtype)
        return jnp.einsum('bhqk,bkhd->bqhd', p, vb)

    out = lax.map(chunk_fn, (jnp.arange(n_chunks), q_chunks))
    return jnp.moveaxis(out, 0, 1).reshape(bsz, L, D_MODEL) @ w_out


def setup_inputs(seed: int = 0) -> dict:
    key = jax.random.key(seed)
    ks = jax.random.split(key, 32)
    f32 = jnp.float32
    D = D_MODEL
    G, P, CG = S5_GROUPS, S5_STATE, S5_GROUP

    def nrm(k, shape, scale):
        return jax.random.normal(k, shape, f32) * scale

    return {
        'x': nrm(ks[0], (BATCH, SEQ, D), 1.0),
        'c': nrm(ks[1], (BATCH, D), 1.0),
        'ada_w': nrm(ks[2], (DEPTH, D, N_SUB * 3 * D), 0.5 * D ** -0.5),
        'ada_b': nrm(ks[3], (DEPTH, N_SUB * 3 * D), 0.02),
        'norm_g': 1.0 + nrm(ks[4], (DEPTH, N_SUB, D), 0.02),
        'ffn_w_gate': nrm(ks[5], (DEPTH, 2, D, D_FF), D ** -0.5),
        'ffn_w_up': nrm(ks[6], (DEPTH, 2, D, D_FF), D ** -0.5),
        'ffn_w_down': nrm(ks[7], (DEPTH, 2, D_FF, D), D_FF ** -0.5),
        'ab_w_in': nrm(ks[8], (N_EVEN, D, D_IN_AB), D ** -0.5),
        's5_lam_re': -0.5 + nrm(ks[9], (N_EVEN, G, P), 0.01),
        's5_lam_im': jnp.pi * jnp.arange(P, dtype=f32) + nrm(ks[10], (N_EVEN, G, P), 0.01),
        's5_log_dt': jax.random.uniform(ks[11], (N_EVEN, G), f32, minval=math.log(DT_MIN), maxval=math.log(DT_MAX)),
        's5_b_re': nrm(ks[12], (N_EVEN, G, P, CG), (2 * CG) ** -0.5),
        's5_b_im': nrm(ks[13], (N_EVEN, G, P, CG), (2 * CG) ** -0.5),
        's5_c_re': nrm(ks[14], (N_EVEN, G, CG, P), (2 * P) ** -0.5),
        's5_c_im': nrm(ks[15], (N_EVEN, G, CG, P), (2 * P) ** -0.5),
        's5_d': nrm(ks[16], (N_EVEN, D_A), 0.5),
        's5_w_glu': nrm(ks[17], (N_EVEN, D_A, D_A), D_A ** -0.5),
        's5_b_glu': nrm(ks[18], (N_EVEN, D_A), 0.02),
        'dsa_kv_norm_g': 1.0 + nrm(ks[19], (N_EVEN, KV_RANK), 0.02),
        'dsa_w_kv_up': nrm(ks[20], (N_EVEN, KV_RANK, 2 * D_B), KV_RANK ** -0.5),
        'ab_w_out': nrm(ks[21], (N_EVEN, D_A + D_B, D), (D_A + D_B) ** -0.5),
        'c_w_qkv': nrm(ks[22], (N_ODD, D, 3 * D), D ** -0.5),
        'c_rel_bias': nrm(ks[23], (N_ODD, C_HEADS, 2 * MAX_REL + 1), 0.5),
        'c_w_out': nrm(ks[24], (N_ODD, D, D), D ** -0.5),
        'final_norm_g': 1.0 + nrm(ks[25], (D,), 0.02),
    }


def reference(x, c, ada_w, ada_b, norm_g, ffn_w_gate, ffn_w_up, ffn_w_down,
              ab_w_in, s5_lam_re, s5_lam_im, s5_log_dt, s5_b_re, s5_b_im, s5_c_re, s5_c_im,
              s5_d, s5_w_glu, s5_b_glu, dsa_kv_norm_g, dsa_w_kv_up, ab_w_out,
              c_w_qkv, c_rel_bias, c_w_out, final_norm_g):
    bsz = x.shape[0]
    cond = jax.nn.silu(c)
    h = x
    for layer in range(DEPTH):
        mod = (cond @ ada_w[layer] + ada_b[layer]).reshape(bsz, N_SUB, 3, D_MODEL)
        shift, scale, gate = mod[:, :, 0], mod[:, :, 1], mod[:, :, 2]
        y = swiglu(adaln(h, norm_g[layer, 0], shift[:, 0], scale[:, 0]),
                   ffn_w_gate[layer, 0], ffn_w_up[layer, 0], ffn_w_down[layer, 0])
        h = h + 0.5 * gate[:, 0, None, :] * y
        hn = adaln(h, norm_g[layer, 1], shift[:, 1], scale[:, 1])
        if layer % 2 == 0:
            e = layer // 2
            y = ab_mixer(hn, ab_w_in[e], s5_lam_re[e], s5_lam_im[e], s5_log_dt[e], s5_b_re[e], s5_b_im[e],
                         s5_c_re[e], s5_c_im[e], s5_d[e], s5_w_glu[e], s5_b_glu[e],
                         dsa_kv_norm_g[e], dsa_w_kv_up[e], ab_w_out[e])
        else:
            o = layer // 2
            y = chunked_relpos_attention(hn, c_w_qkv[o], c_rel_bias[o], c_w_out[o])
        h = h + gate[:, 1, None, :] * y
        y = swiglu(adaln(h, norm_g[layer, 2], shift[:, 2], scale[:, 2]),
                   ffn_w_gate[layer, 1], ffn_w_up[layer, 1], ffn_w_down[layer, 1])
        h = h + 0.5 * gate[:, 2, None, :] * y
    return rmsnorm(h, final_norm_g)
```

```cpp
#include <hip/hip_runtime.h>
#include <cstdio>
#include <cstdint>

#ifndef SELFCHECK
#define SELFCHECK 0
#endif
#ifndef N_PHASES_RUN
#define N_PHASES_RUN 24
#endif

#ifndef EN_MASK
#define EN_MASK 0xFFFFFFFFu
#endif
#define EN(b) ((EN_MASK >> (b)) & 1u)
#define GAS __attribute__((address_space(1)))
#define LAS __attribute__((address_space(3)))
typedef unsigned short bf16;
typedef short bf16x8 __attribute__((ext_vector_type(8)));
typedef short s16x4 __attribute__((ext_vector_type(4)));
typedef float f32x2 __attribute__((ext_vector_type(2)));
typedef float f32x4 __attribute__((ext_vector_type(4)));
typedef float f32x16 __attribute__((ext_vector_type(16)));
typedef unsigned u32x2 __attribute__((ext_vector_type(2)));
typedef unsigned u32x4 __attribute__((ext_vector_type(4)));
typedef short v4i16_t __attribute__((ext_vector_type(4)));

constexpr int SEQ = 8192, DM = 2048, FF = 5504, NGU = 2 * FF  , NMOD = 18432;
constexpr int NIN = 4608;
constexpr int C_U = 0, C_QT = 1024, C_KVL = 3072, C_QI = 3328, C_KI = 4352, C_WI = 4416;
constexpr int NCAT = 3072;
constexpr int NWAVES = 8, NTHR = 512;

constexpr size_t MiB = 1u << 20;
constexpr size_t WS_CTL = 0, CTL_ZERO_BYTES = 1 * MiB;
constexpr size_t WS_MOD = 1 * MiB;
constexpr size_t WS_S5T = WS_MOD + 256 * 1024;
constexpr size_t WS_DIAG = 3 * MiB;
constexpr size_t WS_WGU = 4 * MiB;
constexpr size_t WS_WD = WS_WGU + 172 * MiB;
constexpr size_t WS_WIN = WS_WD + 86 * MiB;
constexpr size_t WS_WQRAW = WS_WIN + 18 * MiB;
constexpr size_t WS_WUPRAW = WS_WQRAW + 8 * MiB;
constexpr size_t WS_WGLU = WS_WUPRAW + 1 * MiB;
constexpr size_t WS_WOUT = WS_WGLU + 2 * MiB;
constexpr size_t WS_WOUTB = WS_WOUT + 12 * MiB;
constexpr size_t WS_WQKV = WS_WOUTB + 8 * MiB;
constexpr size_t WS_WCOUT = WS_WQKV + 24 * MiB;
constexpr size_t WS_HN = WS_WCOUT + 8 * MiB;
constexpr size_t WS_HMID = WS_HN + 32 * MiB;
constexpr size_t WS_PROJ = WS_HMID + 86 * MiB;
constexpr size_t WS_KVN = WS_PROJ + 72 * MiB;
constexpr size_t WS_E = WS_KVN + 4 * MiB;
constexpr size_t WS_YAPRE = WS_E + 4 * MiB;
constexpr size_t WS_YCAT = WS_YAPRE + 16 * MiB;
constexpr size_t WS_SCORE = WS_YCAT + 48 * MiB;
constexpr size_t WS_Q = WS_SCORE, WS_K = WS_SCORE + 32 * MiB, WS_VT = WS_SCORE + 64 * MiB, WS_O = WS_SCORE + 96 * MiB;
constexpr size_t WS_END = WS_SCORE + 256 * MiB;
constexpr int S5_AR = 0, S5_AI = 4096, S5_A64R = 8192, S5_A64I = 12288, S5_BBR = 16384, S5_BBI = 16384 + 65536;

constexpr int CW_BAR = 4096;

constexpr int RING_BYTES = 131072;
constexpr int SCRATCH_BYTES = 155648;
constexpr int MISC_OFF = SCRATCH_BYTES;
constexpr int LDS_BYTES = SCRATCH_BYTES + 256;

#define LDS_WAIT() asm volatile("s_waitcnt lgkmcnt(0)" ::: "memory")
#define VM_WAIT() asm volatile("s_waitcnt vmcnt(0)" ::: "memory")

__device__ __forceinline__ unsigned f2bf(float f) { unsigned u = __builtin_bit_cast(unsigned, f); return (u + 0x7fffu + ((u >> 16) & 1u)) >> 16; }
__device__ __forceinline__ unsigned pk2(float lo, float hi) { unsigned r; asm volatile("v_cvt_pk_bf16_f32 %0, %1, %2" : "=v"(r) : "v"(lo), "v"(hi)); return r; }
__device__ __forceinline__ float bf2f(unsigned short b) { return __builtin_bit_cast(float, (unsigned)b << 16); }
__device__ __forceinline__ float bflo(unsigned w) { return __builtin_bit_cast(float, w << 16); }
__device__ __forceinline__ float bfhi(unsigned w) { return __builtin_bit_cast(float, w & 0xffff0000u); }
__device__ __forceinline__ float fast_exp2(float x) { return __builtin_amdgcn_exp2f(x); }
__device__ __forceinline__ float fast_rcp(float x) { return __builtin_amdgcn_rcpf(x); }
__device__ __forceinline__ float silu_f(float x) { return x * fast_rcp(1.0f + fast_exp2(-1.4426950408889634f * x)); }
__device__ __forceinline__ float sigmoid_f(float x) { return fast_rcp(1.0f + fast_exp2(-1.4426950408889634f * x)); }
__device__ __forceinline__ float gelu_tanh_f(float y) {
    const float z = 0.7978845608028654f * (y + 0.044715f * y * y * y);
    const float e = fast_exp2(2.0f * 1.4426950408889634f * z);
    const float th = 1.0f - 2.0f * fast_rcp(e + 1.0f);
    return 0.5f * y * (1.0f + th);
}
__device__ __forceinline__ float wave_sum(float v) {
#pragma unroll
    for (int o = 1; o < 64; o <<= 1) v += __shfl_xor(v, o);
    return v;
}

namespace pg8 {
constexpr int BM = 256, BK = 64, HALF = 128, HTB = HALF * BK * 2, STAGE_BYTES = 8 * HTB, NXCD = 8, WGM = 8;
__host__ __device__ __forceinline__ int lds_byte(int r, int c) { const int st = (r >> 4) * 2 + (c >> 5), rr = r & 15, cc = c & 31, ob = rr * 64 + cc * 2; return st * 1024 + (ob ^ (((ob >> 9) & 1) << 5)); }
__host__ __device__ __forceinline__ void stage_rc(int b, int& R, int& C) { const int st = b / 1024, sb = b % 1024, swz = sb ^ (((sb >> 9) & 1) << 5); R = (st >> 1) * 16 + swz / 64; C = (st & 1) * 32 + (swz % 64) / 2; }
__host__ __device__ __forceinline__ int perm32(int rho) { const int n = rho >> 4, i = rho & 15; return 8 * (i >> 2) + 4 * n + (i & 3); }

struct Unit { int pm, pn, z, seg; };
struct Gemm { const bf16* A; const bf16* Bt; int M, N, K, lda, ldb, nz; size_t zA, zB; const bf16* A1; const bf16* Bt1; int M1, N1, nz1; size_t zA1, zB1; };

struct StaticOrder {
    int nM0, nN0, n0, nM1, nN1, ntot, G, c;
    __device__ void init(const Gemm& g, int G_, int c_) { nM0 = g.M / BM; nN0 = g.N / BM; n0 = nM0 * nN0 * g.nz; nM1 = g.M1 / BM; nN1 = g.N1 / BM; ntot = n0 + nM1 * nN1 * g.nz1; G = G_; c = c_; }
    __device__ bool next(int i, Unit& u) const {
        int L = i * G + c; if (L >= ntot) return false;
        const int seg = L >= n0 ? 1 : 0; if (seg) L -= n0;
        const int nM = seg ? nM1 : nM0, nN = seg ? nN1 : nN0, nwg = nM * nN;
        u.seg = seg; u.z = L / nwg;
        int wgid = L % nwg; { const int q = nwg / NXCD, r = nwg % NXCD, xcd = wgid % NXCD, off = wgid / NXCD; wgid = (xcd < r ? xcd * (q + 1) : r * (q + 1) + (xcd - r) * q) + off; }
        const int nig = WGM * nN, gid = wgid / nig, fm = gid * WGM, gsz = (nM - fm) < WGM ? (nM - fm) : WGM;
        u.pm = fm + ((wgid % nig) % gsz); u.pn = (wgid % nig) / gsz; return true;
    }
};

struct EpiBf16 {
    static constexpr bool PERM = true;
    bf16* O; int ldc; size_t zC; float scale; bf16* O1; int ldc1; size_t zC1; float scale1;
    __device__ __forceinline__ void operator()(const f32x4 (&acc)[2][2][4][2], const Unit& u, int wr, int wc, int fr, int fq) const {
        const int row0 = u.pm * BM + wr * 64 + fr; const int col0 = u.pn * BM + wc * 32 + 8 * fq;
        bf16* base = u.seg ? O1 + (size_t)u.z * zC1 : O + (size_t)u.z * zC; const int ldc = u.seg ? ldc1 : this->ldc; const float scale = u.seg ? scale1 : this->scale;
#pragma unroll
        for (int ai = 0; ai < 2; ++ai)
#pragma unroll
            for (int m = 0; m < 4; ++m) { bf16* rowp = base + (size_t)(row0 + ai * HALF + m * 16) * ldc + col0;
#pragma unroll
                for (int bj = 0; bj < 2; ++bj) { const f32x4 v0 = acc[ai][bj][m][0] * scale, v1 = acc[ai][bj][m][1] * scale;
                    u32x4 w; w.x = pk2(v0[0], v0[1]); w.y = pk2(v0[2], v0[3]); w.z = pk2(v1[0], v1[1]); w.w = pk2(v1[2], v1[3]);
                    *(u32x4*)(rowp + bj * HALF) = w; } }
    }
};
struct EpiSwiGLU {
    static constexpr bool PERM = true;
    bf16* O; int ldc;
    __device__ __forceinline__ void operator()(const f32x4 (&acc)[2][2][4][2], const Unit& u, int wr, int wc, int fr, int fq) const {
        const int row0 = u.pm * BM + wr * 64 + fr; const int col0 = u.pn * HALF + wc * 32 + 8 * fq;
#pragma unroll
        for (int ai = 0; ai < 2; ++ai)
#pragma unroll
            for (int m = 0; m < 4; ++m) { bf16* rowp = O + (size_t)(row0 + ai * HALF + m * 16) * ldc + col0;
                const f32x4 g0 = acc[ai][0][m][0], g1 = acc[ai][0][m][1], u0 = acc[ai][1][m][0], u1 = acc[ai][1][m][1];
                u32x4 w; w.x = pk2(silu_f(g0[0]) * u0[0], silu_f(g0[1]) * u0[1]); w.y = pk2(silu_f(g0[2]) * u0[2], silu_f(g0[3]) * u0[3]);
                w.z = pk2(silu_f(g1[0]) * u1[0], silu_f(g1[1]) * u1[1]); w.w = pk2(silu_f(g1[2]) * u1[2], silu_f(g1[3]) * u1[3]);
                *(u32x4*)rowp = w; }
    }
};
struct EpiResid {
    static constexpr bool PERM = false;
    const float* hin; float* out; const float* gate; float coef;
    __device__ __forceinline__ void operator()(const f32x4 (&acc)[2][2][4][2], const Unit& u, int wr, int wc, int fr, int fq) const {
        const int row0 = u.pm * BM + wr * 64 + fr; const int col0 = u.pn * BM + wc * 32 + 4 * fq;
        f32x4 gv[2][2];
#pragma unroll
        for (int bj = 0; bj < 2; ++bj)
#pragma unroll
            for (int n = 0; n < 2; ++n) gv[bj][n] = *(const f32x4*)(gate + col0 + bj * HALF + n * 16) * coef;
#pragma unroll
        for (int ai = 0; ai < 2; ++ai)
#pragma unroll
            for (int m = 0; m < 4; ++m) { const size_t off = (size_t)(row0 + ai * HALF + m * 16) * DM + col0;
#pragma unroll
                for (int bj = 0; bj < 2; ++bj)
#pragma unroll
                    for (int n = 0; n < 2; ++n) { const f32x4 b = *(const f32x4*)(hin + off + bj * HALF + n * 16);
                        *(f32x4*)(out + off + bj * HALF + n * 16) = b + gv[bj][n] * acc[ai][bj][m][n]; } }
    }
};
struct EpiGLU {
    static constexpr bool PERM = true;
    const bf16* yp; const float* bias; bf16* O; int ldc;
    __device__ __forceinline__ void operator()(const f32x4 (&acc)[2][2][4][2], const Unit& u, int wr, int wc, int fr, int fq) const {
        const int row0 = u.pm * BM + wr * 64 + fr; const int col0 = u.pn * BM + wc * 32 + 8 * fq;
#pragma unroll
        for (int bj = 0; bj < 2; ++bj) { const f32x4 b0 = *(const f32x4*)(bias + col0 + bj * HALF), b1 = *(const f32x4*)(bias + col0 + bj * HALF + 4);
#pragma unroll
            for (int ai = 0; ai < 2; ++ai)
#pragma unroll
                for (int m = 0; m < 4; ++m) { const size_t r = (size_t)(row0 + ai * HALF + m * 16);
                    const u32x4 y = *(const u32x4*)(yp + r * 1024 + col0 + bj * HALF);
                    const f32x4 z0 = acc[ai][bj][m][0] + b0, z1 = acc[ai][bj][m][1] + b1;
                    u32x4 w; w.x = pk2(bflo(y.x) * sigmoid_f(z0[0]), bfhi(y.x) * sigmoid_f(z0[1])); w.y = pk2(bflo(y.y) * sigmoid_f(z0[2]), bfhi(y.y) * sigmoid_f(z0[3]));
                    w.z = pk2(bflo(y.z) * sigmoid_f(z1[0]), bfhi(y.z) * sigmoid_f(z1[1])); w.w = pk2(bflo(y.w) * sigmoid_f(z1[2]), bfhi(y.w) * sigmoid_f(z1[3]));
                    *(u32x4*)(O + r * ldc + col0 + bj * HALF) = w; } }
    }
};

template <class Epi>
__device__ __forceinline__ void gemm_phase(LAS unsigned char* lds, const Gemm g, const StaticOrder& S, const Epi& E, int wave_s) {
    int lane_o = (int)__builtin_amdgcn_mbcnt_hi(~0u, __builtin_amdgcn_mbcnt_lo(~0u, 0u)); asm volatile("" : "+v"(lane_o));
    const int wid = wave_s, lane = lane_o, tid = wave_s * 64 + lane_o, wr = wid >> 2, wc = wid & 3, fr = lane & 15, fq = lane >> 4;
    const int K = g.K, nt = K / BK;
    unsigned voffA[2], voffB[2];
#pragma unroll
    for (int i = 0; i < 2; ++i) { int R, C; stage_rc(tid * 16 + i * 8192, R, C); const int Rb = Epi::PERM ? ((R & ~31) + perm32(R & 31)) : R;
        voffA[i] = (unsigned)(R * g.lda + C) * 2u; voffB[i] = (unsigned)(Rb * g.ldb + C) * 2u; }
    const size_t kstep = (size_t)(BK * 2);
    const size_t hstepA = (size_t)HALF * g.lda * 2, hstepB = (size_t)HALF * g.ldb * 2;
    const size_t tstepA = 2 * hstepA, tstepB = 2 * hstepB;
    const unsigned ldsw = (unsigned)wid * 1024u;
    const int aoff = lds_byte(wr * 64 + fr, fq * 8), boff = lds_byte(wc * 32 + fr, fq * 8);
#define PG8_SA(b, h) (((b) * 2 + (h)) * HTB)
#define PG8_SB(b, h) ((4 + (b) * 2 + (h)) * HTB)
#define PG8_STAGE(bufoff, gbase, voff) do { _Pragma("unroll") for (int _i = 0; _i < 2; ++_i) \
        __builtin_amdgcn_global_load_lds((const unsigned*)((const char*)(gbase) + (voff)[_i]), (LAS unsigned*)(lds + (bufoff) + ldsw + _i * 8192), 16, 0, 0); } while (0)
#define PG8_LDA(dst, b, h) do { _Pragma("unroll") for (int m = 0; m < 4; ++m) _Pragma("unroll") for (int k = 0; k < 2; ++k) dst[m][k] = *(const LAS bf16x8*)(lds + PG8_SA(b, h) + aoff + m * 2048 + k * 1024); } while (0)
#define PG8_LDB(dst, b, h) do { _Pragma("unroll") for (int n = 0; n < 2; ++n) _Pragma("unroll") for (int k = 0; k < 2; ++k) dst[n][k] = *(const LAS bf16x8*)(lds + PG8_SB(b, h) + boff + n * 2048 + k * 1024); } while (0)
#define PG8_MMA(ai, bj, At, Bt) do { __builtin_amdgcn_s_setprio(1); _Pragma("unroll") for (int m = 0; m < 4; ++m) _Pragma("unroll") for (int n = 0; n < 2; ++n) _Pragma("unroll") for (int k = 0; k < 2; ++k) \
        acc[ai][bj][m][n] = __builtin_amdgcn_mfma_f32_16x16x32_bf16(Bt[n][k], At[m][k], acc[ai][bj][m][n], 0, 0, 0); __builtin_amdgcn_s_setprio(0); } while (0)
#define PG8_WAIT_V(n) asm volatile("s_waitcnt vmcnt(" #n ")" ::: "memory")
#define PG8_WAIT_L(n) asm volatile("s_waitcnt lgkmcnt(" #n ")" ::: "memory")
#define PG8_BAR __builtin_amdgcn_s_barrier()
#define PG8_SCHED __builtin_amdgcn_sched_barrier(0)
    Unit cur, nxt; int ui = 0;
    if (!S.next(0, cur)) return;
    f32x4 acc[2][2][4][2];
#pragma unroll
    for (int a = 0; a < 2; ++a)
#pragma unroll
        for (int b = 0; b < 2; ++b)
#pragma unroll
            for (int m = 0; m < 4; ++m)
#pragma unroll
                for (int n = 0; n < 2; ++n) acc[a][b][m][n] = (f32x4){0.f, 0.f, 0.f, 0.f};
    bf16x8 At[4][2], B0[2][2], B1[2][2];
#define PG8_ABASE(u) ((const char*)((u).seg ? g.A1 + (size_t)(u).z * g.zA1 : g.A + (size_t)(u).z * g.zA) + (size_t)(u).pm * tstepA)
#define PG8_BBASE(u) ((const char*)((u).seg ? g.Bt1 + (size_t)(u).z * g.zB1 : g.Bt + (size_t)(u).z * g.zB) + (size_t)(u).pn * tstepB)
    const char* cA = PG8_ABASE(cur); const char* cB = PG8_BBASE(cur);
    PG8_STAGE(PG8_SB(0, 0), cB, voffB); PG8_STAGE(PG8_SB(0, 1), cB + hstepB, voffB); PG8_STAGE(PG8_SA(0, 0), cA, voffA); PG8_STAGE(PG8_SA(0, 1), cA + hstepA, voffA);
    if (wr == 1) PG8_BAR;
    PG8_WAIT_V(2); PG8_BAR;
    PG8_STAGE(PG8_SB(1, 0), cB + kstep, voffB); PG8_STAGE(PG8_SA(1, 0), cA + kstep, voffA); PG8_STAGE(PG8_SB(1, 1), cB + hstepB + kstep, voffB);
    PG8_WAIT_V(6); PG8_BAR;
    for (;;) {
        const bool has_next = S.next(ui + 1, nxt);
        const char* nA = has_next ? PG8_ABASE(nxt) : cA; const char* nB = has_next ? PG8_BBASE(nxt) : cB;
        for (int t = 0; t < nt; t += 2) {
            const bool last = (t == nt - 2);
            const char* a1 = cA + (size_t)(t + 1) * kstep;
            const char* a2 = last ? nA : cA + (size_t)(t + 2) * kstep; const char* b2 = last ? nB : cB + (size_t)(t + 2) * kstep;
            const char* a3 = a2 + kstep; const char* b3 = b2 + kstep;
            PG8_LDB(B0, 0, 0); PG8_LDB(B1, 0, 1); PG8_SCHED; PG8_LDA(At, 0, 0); PG8_STAGE(PG8_SA(1, 1), a1 + hstepA, voffA);
            PG8_WAIT_V(8); PG8_WAIT_L(0); PG8_BAR; PG8_MMA(0, 0, At, B0); PG8_MMA(0, 1, At, B1); PG8_BAR; PG8_SCHED;
            PG8_LDA(At, 0, 1); PG8_STAGE(PG8_SB(0, 0), b2, voffB); PG8_STAGE(PG8_SB(0, 1), b2 + hstepB, voffB); PG8_STAGE(PG8_SA(0, 0), a2, voffA);
            PG8_WAIT_V(8); PG8_WAIT_L(0); PG8_BAR; PG8_MMA(1, 0, At, B0); PG8_MMA(1, 1, At, B1); PG8_BAR; PG8_SCHED;
            PG8_LDB(B0, 1, 0); PG8_LDB(B1, 1, 1); PG8_SCHED; PG8_LDA(At, 1, 0); PG8_STAGE(PG8_SA(0, 1), a2 + hstepA, voffA);
            PG8_WAIT_V(8); PG8_WAIT_L(0); PG8_BAR; PG8_MMA(0, 0, At, B0); PG8_MMA(0, 1, At, B1); PG8_BAR; PG8_SCHED;
            PG8_LDA(At, 1, 1); PG8_STAGE(PG8_SB(1, 0), b3, voffB); PG8_STAGE(PG8_SB(1, 1), b3 + hstepB, voffB); PG8_STAGE(PG8_SA(1, 0), a3, voffA);
            PG8_WAIT_V(8); PG8_WAIT_L(0); PG8_BAR; PG8_MMA(1, 0, At, B0); PG8_MMA(1, 1, At, B1); PG8_BAR; PG8_SCHED;
        }
        if (wr == 0) PG8_BAR;
        E(acc, cur, wr, wc, fr, fq);
        if (!has_next) break;
#pragma unroll
        for (int a = 0; a < 2; ++a)
#pragma unroll
            for (int b = 0; b < 2; ++b)
#pragma unroll
                for (int m = 0; m < 4; ++m)
#pragma unroll
                    for (int n = 0; n < 2; ++n) acc[a][b][m][n] = (f32x4){0.f, 0.f, 0.f, 0.f};
        cur = nxt; cA = nA; cB = nB; ++ui;
        if (wr == 1) PG8_BAR;
    }
    PG8_WAIT_V(0);
    PG8_BAR;
#undef PG8_ABASE
#undef PG8_BBASE
#undef PG8_SA
#undef PG8_SB
#undef PG8_STAGE
#undef PG8_LDA
#undef PG8_LDB
#undef PG8_MMA
#undef PG8_WAIT_V
#undef PG8_WAIT_L
#undef PG8_BAR
#undef PG8_SCHED
}
}

#define XB_TMO      128
#define XB_XCNT(j)  (256  + 64 * (j))
#define XB_XSUB(j)  (1280 + 64 * (j))
#define XB_XGEN(j)  (2304 + 64 * (j))
#define XB_TOP      3328
#define XB_TOPGEN   3392
#define XCD_BAR_WORDS 3456
#define XB_SPIN_CAP (1u << 18)
__device__ __forceinline__ unsigned xb_ld(unsigned* p)              { return __hip_atomic_load(p, __ATOMIC_RELAXED, __HIP_MEMORY_SCOPE_AGENT); }
__device__ __forceinline__ unsigned xb_add(unsigned* p, unsigned v) { return __hip_atomic_fetch_add(p, v, __ATOMIC_RELAXED, __HIP_MEMORY_SCOPE_AGENT); }
__device__ __forceinline__ unsigned xb_xcc_id() { return (unsigned)__builtin_amdgcn_s_getreg((3 << 11) | 20) & 0xFu; }
#define XB_SPIN(cond, bar) do { unsigned _sp = 0; while (cond) { __builtin_amdgcn_s_sleep(1); \
    if ((++_sp & 255u) == 0u) { if (xb_ld(&(bar)[XB_TMO])) break; if (_sp > XB_SPIN_CAP) { atomicAdd(&(bar)[XB_TMO], 1u); break; } } } } while (0)
struct XcdBarrier { unsigned* bar; unsigned x; volatile LAS unsigned* st; int wave; };
__device__ __forceinline__ XcdBarrier xcd_barrier_post(unsigned* bar, volatile LAS unsigned* st) {
    XcdBarrier b; b.bar = bar; b.x = xb_xcc_id(); b.st = st;
    if (threadIdx.x == 0) (void)xb_add(&bar[XB_XCNT(b.x)], 1u);
    return b;
}
__device__ __forceinline__ void xcd_barrier_complete(unsigned* bar, unsigned x, unsigned& nloc, unsigned& nx) {
    const unsigned G = gridDim.x * gridDim.y * gridDim.z;
    unsigned sum, cnt, mine, sp = 0u;
    for (;;) {
        sum = 0u; cnt = 0u; mine = 0u;
#pragma unroll
        for (unsigned j = 0; j < 16; ++j) { const unsigned c = xb_ld(&bar[XB_XCNT(j)]); sum += c; cnt += (c > 0u) ? 1u : 0u; mine = (j == x) ? c : mine; }
        if (sum == G) break;
        __builtin_amdgcn_s_sleep(1);
        if ((++sp & 255u) == 0u) { if (xb_ld(&bar[XB_TMO])) break; if (sp > XB_SPIN_CAP) { atomicAdd(&bar[XB_TMO], 1u); break; } }
    }
    nloc = mine > 0u ? mine : 1u; nx = cnt > 0u ? cnt : 1u;
}
__device__ __forceinline__ void xcd_barrier(const XcdBarrier& b) {
    asm volatile("s_waitcnt vmcnt(0)" ::: "memory");
    __syncthreads();
    if (b.wave == 0 && __builtin_amdgcn_mbcnt_hi(~0u, __builtin_amdgcn_mbcnt_lo(~0u, 0u)) == 0u) {
        unsigned* bar = b.bar;
        __builtin_amdgcn_s_waitcnt(0);
        unsigned nloc = b.st[0], nx = b.st[1];
        if (nloc == 0u) { xcd_barrier_complete(bar, b.x, nloc, nx); b.st[0] = nloc; b.st[1] = nx; }
        const unsigned old = xb_add(&bar[XB_XSUB(b.x)], 1u);
        const unsigned gen = old / nloc;
        if (old + 1u == (gen + 1u) * nloc) {
            __builtin_amdgcn_fence(__ATOMIC_RELEASE, "agent");
            asm volatile("s_waitcnt vmcnt(0)" ::: "memory");
            const unsigned og = xb_add(&bar[XB_TOP], 1u);
            const unsigned tg = og / nx;
            if (og + 1u == (tg + 1u) * nx) xb_add(&bar[XB_TOPGEN], 1u);
            else XB_SPIN(xb_ld(&bar[XB_TOPGEN]) == tg, bar);
            __builtin_amdgcn_fence(__ATOMIC_ACQUIRE, "agent");
            xb_add(&bar[XB_XGEN(b.x)], 1u);
            asm volatile("s_waitcnt vmcnt(0)" ::: "memory");
        } else {
            XB_SPIN(xb_ld(&bar[XB_XGEN(b.x)]) == gen, bar);
            __builtin_amdgcn_fence(__ATOMIC_ACQUIRE, "agent");
            asm volatile("s_waitcnt vmcnt(0)" ::: "memory");
        }
    }
    __syncthreads();
}

struct Args { const float* in[26]; float* out; unsigned char* ws; int ph_lo, ph_hi; };
enum { I_X = 0, I_C, I_ADAW, I_ADAB, I_NORMG, I_WG, I_WU, I_WDN, I_ABWIN, I_LRE, I_LIM, I_LOGDT, I_BRE, I_BIM, I_CRE, I_CIM, I_S5D, I_WGLU, I_BGLU, I_KVG, I_WKVUP, I_ABWOUT,
       I_CWQKV, I_RELB, I_CWOUT, I_FING };

__device__ __forceinline__ void tr_item(const float* src, int ldsrc, int nvalid, int k0, int n0, bf16* dst, int lddst, LAS float* scr, int lane) {
    const int nn = n0 + (lane & 31); const bool ok = nn < nvalid;
#pragma unroll 8
    for (int i = 0; i < 32; ++i) { const int kk = 2 * i + (lane >> 5); scr[kk * 33 + (lane & 31)] = ok ? src[(size_t)(k0 + kk) * ldsrc + nn] : 0.f; }
    LDS_WAIT(); asm volatile("" ::: "memory");
    const int c = lane & 7;
#pragma unroll
    for (int j = 0; j < 4; ++j) { const int n = (lane >> 3) + 8 * j; const LAS float* s = scr + (8 * c) * 33 + n;
        u32x4 o; o.x = pk2(s[0 * 33], s[1 * 33]); o.y = pk2(s[2 * 33], s[3 * 33]); o.z = pk2(s[4 * 33], s[5 * 33]); o.w = pk2(s[6 * 33], s[7 * 33]);
        if (n0 + n < nvalid) *(u32x4*)(dst + (size_t)n * lddst + 8 * c) = o; }
    LDS_WAIT(); asm volatile("" ::: "memory");
}

__device__ __forceinline__ void p0_prologue(const Args& a, LAS unsigned char* lds, int G, int wave_s) {
    int lane_o = (int)__builtin_amdgcn_mbcnt_hi(~0u, __builtin_amdgcn_mbcnt_lo(~0u, 0u)); asm volatile("" : "+v"(lane_o)); const int lane = lane_o, wave = wave_s, tid_o = wave_s * 64 + lane_o;
    unsigned char* ws = a.ws;
    const int tid = tid_o;
    {
        LAS float* cond = (LAS float*)(lds + 131072); LAS float* red = (LAS float*)(lds + 131072 + 8192);
        for (int k = tid; k < DM; k += NTHR) cond[k] = silu_f(a.in[I_C][k]);
        __syncthreads();
        float* mod = (float*)(ws + WS_MOD);
        for (int u = blockIdx.x; u < 288; u += G) {
            const int layer = u / 144, col0 = (u % 144) * 128 + 2 * lane;
            const float* w = a.in[I_ADAW] + (size_t)layer * DM * NMOD + (size_t)(wave * 256) * NMOD + col0;
            float s0 = 0.f, s1 = 0.f;
#pragma unroll 8
            for (int k = 0; k < 256; ++k) { const f32x2 v = *(const f32x2*)(w + (size_t)k * NMOD); const float cv = cond[wave * 256 + k]; s0 += cv * v.x; s1 += cv * v.y; }
            red[wave * 128 + 2 * lane] = s0; red[wave * 128 + 2 * lane + 1] = s1;
            __syncthreads();
            if (tid < 128) { float s = 0.f;
#pragma unroll
                for (int w8 = 0; w8 < 8; ++w8) s += red[w8 * 128 + tid];
                const int n = (u % 144) * 128 + tid; mod[layer * NMOD + n] = s + a.in[I_ADAB][layer * NMOD + n]; }
            __syncthreads();
        }
    }
    LAS float* scr = (LAS float*)(lds + wave * 16384);
    const int gw = blockIdx.x * NWAVES + wave, NGW = G * NWAVES;
    bf16* Wgu = (bf16*)(ws + WS_WGU); bf16* Wd = (bf16*)(ws + WS_WD); bf16* Win = (bf16*)(ws + WS_WIN); bf16* Wglu = (bf16*)(ws + WS_WGLU);
    bf16* Wout = (bf16*)(ws + WS_WOUT); bf16* Woutb = (bf16*)(ws + WS_WOUTB); bf16* Wqkv = (bf16*)(ws + WS_WQKV); bf16* Wcout = (bf16*)(ws + WS_WCOUT);
    constexpr int I_FFN = 4 * 3 * 5504, I_IN = 32 * 107, I_GLU = 16 * 32, I_OUT = 32 * 64, I_QKV = 32 * 192, I_CO = 32 * 64;
    constexpr int NITEMS = I_FFN + I_IN + I_GLU + I_OUT + I_QKV + I_CO;
    for (int it = gw; it < NITEMS; it += NGW) {
        int r = it;
        if (r < I_FFN) {
            const int f = r / 16512, rr = r % 16512, which = rr / 5504, q = rr % 5504;
            if (which < 2) { const int kb = q / 172, nb = q % 172, n0 = 32 * nb, k0 = 64 * kb;
                const float* src = a.in[which ? I_WU : I_WG] + (size_t)f * DM * FF;
                const int row = 256 * (n0 / 128) + (n0 % 128) + 128 * which;
                tr_item(src, FF, FF, k0, n0, Wgu + (size_t)f * NGU * DM + (size_t)row * DM + k0, DM, scr, lane);
            } else { const int kb = q / 64, nb = q % 64, n0 = 32 * nb, k0 = 64 * kb;
                const float* src = a.in[I_WDN] + (size_t)f * FF * DM;
                tr_item(src, DM, DM, k0, n0, Wd + (size_t)f * DM * FF + (size_t)n0 * FF + k0, FF, scr, lane); }
            continue; }
        r -= I_FFN;
        if (r < I_IN) { const int kb = r / 107, nb = r % 107, n0 = 32 * nb, k0 = 64 * kb;
            if (n0 >= 1024 && n0 < 2048) continue;
            const int row = n0 + (n0 >= 2048 ? 1024 : 0);
            tr_item(a.in[I_ABWIN], 3408, 3408, k0, n0, Win + (size_t)row * DM + k0, DM, scr, lane); continue; }
        r -= I_IN;
        if (r < I_GLU) { const int kb = r / 32, nb = r % 32, n0 = 32 * nb, k0 = 64 * kb;
            tr_item(a.in[I_WGLU], 1024, 1024, k0, n0, Wglu + (size_t)n0 * 1024 + k0, 1024, scr, lane); continue; }
        r -= I_GLU;
        if (r < I_OUT) { const int kb = r / 64, nb = r % 64, n0 = 32 * nb, k0 = 64 * kb;
            if (k0 < 1024) tr_item(a.in[I_ABWOUT], DM, DM, k0, n0, Wout + (size_t)n0 * NCAT + k0, NCAT, scr, lane);
            else           tr_item(a.in[I_ABWOUT], DM, DM, k0, n0, Woutb + (size_t)n0 * DM + k0, DM, scr, lane);
            continue; }
        r -= I_OUT;
        if (r < I_QKV) { const int kb = r / 192, nb = r % 192, n0 = 32 * nb, k0 = 64 * kb;
            tr_item(a.in[I_CWQKV], 6144, 6144, k0, n0, Wqkv + (size_t)n0 * DM + k0, DM, scr, lane); continue; }
        r -= I_QKV;
        { const int kb = r / 64, nb = r % 64, n0 = 32 * nb, k0 = 64 * kb;
            tr_item(a.in[I_CWOUT], DM, DM, k0, n0, Wcout + (size_t)n0 * DM + k0, DM, scr, lane); }
    }
    {
        const int gt = blockIdx.x * NTHR + tid, NGT = G * NTHR;
        bf16* Wqraw = (bf16*)(ws + WS_WQRAW); bf16* Wupraw = (bf16*)(ws + WS_WUPRAW);
        for (int i = gt; i < 2048 * 256; i += NGT) { const int k = i >> 8, d4 = (i & 255) * 4; const f32x4 v = *(const f32x4*)(a.in[I_ABWIN] + (size_t)k * 3408 + 1024 + d4);
            u32x2 o; o.x = pk2(v.x, v.y); o.y = pk2(v.z, v.w); *(u32x2*)(Wqraw + (size_t)k * DM + d4) = o; }
        for (int i = gt; i < 256 * 512; i += NGT) { const f32x4 v = *(const f32x4*)(a.in[I_WKVUP] + (size_t)i * 4);
            u32x2 o; o.x = pk2(v.x, v.y); o.y = pk2(v.z, v.w); *(u32x2*)(Wupraw + (size_t)i * 4) = o; }
        for (int i = gt; i < (NIN - 4432) * DM / 8; i += NGT) *(u32x4*)(Win + (size_t)4432 * DM + (size_t)i * 8) = (u32x4){0u, 0u, 0u, 0u};
        if (gt < 4096) { const int g = gt >> 6;
            const double dt = exp((double)a.in[I_LOGDT][g]); const double lr = a.in[I_LRE][gt], li = a.in[I_LIM][gt];
            const double mag = exp(lr * dt), ar = mag * cos(li * dt), ai = mag * sin(li * dt);
            const double den = lr * lr + li * li, nr = ar - 1.0, fre = (nr * lr + ai * li) / den, fim = (ai * lr - nr * li) / den;
            const double m64 = exp(64.0 * lr * dt), a64r = m64 * cos(64.0 * li * dt), a64i = m64 * sin(64.0 * li * dt);
            float* T = (float*)(ws + WS_S5T);
            T[S5_AR + gt] = (float)ar; T[S5_AI + gt] = (float)ai; T[S5_A64R + gt] = (float)a64r; T[S5_A64I + gt] = (float)a64i;
            for (int c = 0; c < 16; ++c) { const double br = a.in[I_BRE][gt * 16 + c], bi = a.in[I_BIM][gt * 16 + c];
                T[S5_BBR + gt * 16 + c] = (float)(fre * br - fim * bi); T[S5_BBI + gt * 16 + c] = (float)(fre * bi + fim * br); }
        }
    }
}

template <bool FINAL>
__device__ __forceinline__ void norm_phase(const float* hin, const float* gvec, const float* shift, const float* scale, bf16* hn, float* fout, int G, int wave_s) {
    int lane_o = (int)__builtin_amdgcn_mbcnt_hi(~0u, __builtin_amdgcn_mbcnt_lo(~0u, 0u)); asm volatile("" : "+v"(lane_o)); const int lane = lane_o, wave = wave_s, tid_o = wave_s * 64 + lane_o;
    const int gw = blockIdx.x * NWAVES + wave, NGW = G * NWAVES;
    f32x4 gs[8], sh[8];
#pragma unroll
    for (int j = 0; j < 8; ++j) { const int c = 4 * lane + 256 * j; const f32x4 gg = *(const f32x4*)(gvec + c);
        if (FINAL) { gs[j] = gg; sh[j] = (f32x4){0.f, 0.f, 0.f, 0.f}; }
        else { const f32x4 sc = *(const f32x4*)(scale + c); gs[j] = gg * (sc + 1.0f); sh[j] = *(const f32x4*)(shift + c); } }
    for (int m = gw; m < SEQ; m += NGW) {
        const f32x4* xr = (const f32x4*)(hin + (size_t)m * DM) + lane;
        f32x4 v[8]; float s = 0.f;
#pragma unroll
        for (int j = 0; j < 8; ++j) { v[j] = xr[64 * j]; s += (v[j].x * v[j].x + v[j].y * v[j].y) + (v[j].z * v[j].z + v[j].w * v[j].w); }
        const float rstd = 1.0f / sqrtf(wave_sum(s) * (1.0f / DM) + 1e-6f);
        if (FINAL) { f32x4* o = (f32x4*)(fout + (size_t)m * DM) + lane;
#pragma unroll
            for (int j = 0; j < 8; ++j) o[64 * j] = v[j] * rstd * gs[j];
        } else { u32x2* o = (u32x2*)(hn + (size_t)m * DM) + lane;
#pragma unroll
            for (int j = 0; j < 8; ++j) { const f32x4 y = v[j] * rstd * gs[j] + sh[j]; u32x2 w; w.x = pk2(y.x, y.y); w.y = pk2(y.z, y.w); o[64 * j] = w; } }
    }
}

__device__ __forceinline__ void s5_stage_u(const bf16* proj, int g, int j, LAS float* ut, int lane) {
    const u32x4* p = (const u32x4*)(proj + (size_t)(64 * j + lane) * NIN + C_U + 16 * g);
    const u32x4 a = p[0], b = p[1];
    LAS f32x4* o = (LAS f32x4*)(ut + lane * 16);
    o[0] = (f32x4){bflo(a.x), bfhi(a.x), bflo(a.y), bfhi(a.y)}; o[1] = (f32x4){bflo(a.z), bfhi(a.z), bflo(a.w), bfhi(a.w)};
    o[2] = (f32x4){bflo(b.x), bfhi(b.x), bflo(b.y), bfhi(b.y)}; o[3] = (f32x4){bflo(b.z), bfhi(b.z), bflo(b.w), bfhi(b.w)};
    LDS_WAIT(); asm volatile("" ::: "memory");
}
__device__ __forceinline__ void phase_a2(const Args& a, LAS unsigned char* lds, int G, int wave_s) {
    int lane_o = (int)__builtin_amdgcn_mbcnt_hi(~0u, __builtin_amdgcn_mbcnt_lo(~0u, 0u)); asm volatile("" : "+v"(lane_o)); const int lane = lane_o, wave = wave_s, tid_o = wave_s * 64 + lane_o;
    unsigned char* ws = a.ws; const bf16* proj = (const bf16*)(ws + WS_PROJ);
    const int gw = blockIdx.x * NWAVES + wave, NGW = G * NWAVES;
    { bf16* kvn = (bf16*)(ws + WS_KVN); const f32x4 gg = *(const f32x4*)(a.in[I_KVG] + 4 * lane);
      for (int m = gw; m < SEQ; m += NGW) { const u32x2 w = *(const u32x2*)(proj + (size_t)m * NIN + C_KVL + 4 * lane);
          const f32x4 v = (f32x4){bflo(w.x), bfhi(w.x), bflo(w.y), bfhi(w.y)};
          const float s = wave_sum((v.x * v.x + v.y * v.y) + (v.z * v.z + v.w * v.w)); const float rstd = 1.0f / sqrtf(s * (1.0f / 256.0f) + 1e-6f);
          const f32x4 y = v * rstd * gg; u32x2 o; o.x = pk2(y.x, y.y); o.y = pk2(y.z, y.w); *(u32x2*)(kvn + (size_t)m * 256 + 4 * lane) = o; } }
    const float* T = (const float*)(ws + WS_S5T); float* E = (float*)(ws + WS_E);
    LAS float* ut = (LAS float*)(lds + wave * 8192);
    for (int u = gw; u < 64 * 128; u += NGW) { const int g = u & 63, j = u >> 6, sp = g * 64 + lane;
        s5_stage_u(proj, g, j, ut, lane);
        const float ar = T[S5_AR + sp], ai = T[S5_AI + sp];
        float bbr[16], bbi[16];
#pragma unroll
        for (int c4 = 0; c4 < 4; ++c4) { const f32x4 r = *(const f32x4*)(T + S5_BBR + sp * 16 + 4 * c4), i = *(const f32x4*)(T + S5_BBI + sp * 16 + 4 * c4);
            bbr[4 * c4] = r.x; bbr[4 * c4 + 1] = r.y; bbr[4 * c4 + 2] = r.z; bbr[4 * c4 + 3] = r.w; bbi[4 * c4] = i.x; bbi[4 * c4 + 1] = i.y; bbi[4 * c4 + 2] = i.z; bbi[4 * c4 + 3] = i.w; }
        float xr = 0.f, xi = 0.f;
        for (int t = 0; t < 64; ++t) { const LAS f32x4* up = (const LAS f32x4*)(ut + t * 16); float bur = 0.f, bui = 0.f;
#pragma unroll
            for (int c4 = 0; c4 < 4; ++c4) { const f32x4 uv = up[c4];
                bur += bbr[4 * c4] * uv.x + bbr[4 * c4 + 1] * uv.y + bbr[4 * c4 + 2] * uv.z + bbr[4 * c4 + 3] * uv.w;
                bui += bbi[4 * c4] * uv.x + bbi[4 * c4 + 1] * uv.y + bbi[4 * c4 + 2] * uv.z + bbi[4 * c4 + 3] * uv.w; }
            const float nr = ar * xr - ai * xi + bur, ni = ar * xi + ai * xr + bui; xr = nr; xi = ni; }
        E[(size_t)(g * 128 + j) * 64 + lane] = xr; E[(size_t)(64 * 128 * 64) + (size_t)(g * 128 + j) * 64 + lane] = xi;
        LDS_WAIT(); asm volatile("" ::: "memory");
    }
}

__device__ __forceinline__ void s5_scan_out(const Args& a, LAS unsigned char* lds, int G, int wave_s) {
    int lane_o = (int)__builtin_amdgcn_mbcnt_hi(~0u, __builtin_amdgcn_mbcnt_lo(~0u, 0u)); asm volatile("" : "+v"(lane_o)); const int lane = lane_o, wave = wave_s, tid_o = wave_s * 64 + lane_o;
    unsigned char* ws = a.ws; const bf16* proj = (const bf16*)(ws + WS_PROJ);
    const int gw = blockIdx.x * NWAVES + wave, NGW = G * NWAVES;
    const float* T = (const float*)(ws + WS_S5T); const float* E = (const float*)(ws + WS_E); bf16* yap = (bf16*)(ws + WS_YAPRE);
    LAS float* ut = (LAS float*)(lds + wave * 16384);
    LAS unsigned char* X = lds + wave * 16384 + 4096;
    const int fr = lane & 15, fq = lane >> 4;
    for (int u = gw; u < 64 * 128; u += NGW) { const int g = u & 63, j = u >> 6, sp = g * 64 + lane;
        s5_stage_u(proj, g, j, ut, lane);
        const float ar = T[S5_AR + sp], ai = T[S5_AI + sp], a64r = T[S5_A64R + sp], a64i = T[S5_A64I + sp];
        float bbr[16], bbi[16];
#pragma unroll
        for (int c4 = 0; c4 < 4; ++c4) { const f32x4 r = *(const f32x4*)(T + S5_BBR + sp * 16 + 4 * c4), i = *(const f32x4*)(T + S5_BBI + sp * 16 + 4 * c4);
            bbr[4 * c4] = r.x; bbr[4 * c4 + 1] = r.y; bbr[4 * c4 + 2] = r.z; bbr[4 * c4 + 3] = r.w; bbi[4 * c4] = i.x; bbi[4 * c4 + 1] = i.y; bbi[4 * c4 + 2] = i.z; bbi[4 * c4 + 3] = i.w; }
        bf16x8 cf[4];
#pragma unroll
        for (int ks = 0; ks < 4; ++ks) { const int k0 = 32 * ks + 8 * fq; const bool im = k0 >= 64; const float* src = a.in[im ? I_CIM : I_CRE] + (size_t)(g * 16 + fr) * 64 + (k0 & 63);
            const f32x4 v0 = *(const f32x4*)src, v1 = *(const f32x4*)(src + 4); const float sg = im ? -1.f : 1.f;
            u32x4 w; w.x = pk2(sg * v0.x, sg * v0.y); w.y = pk2(sg * v0.z, sg * v0.w); w.z = pk2(sg * v1.x, sg * v1.y); w.w = pk2(sg * v1.z, sg * v1.w);
            cf[ks] = __builtin_bit_cast(bf16x8, w); }
        const float dsk = a.in[I_S5D][g * 16 + fr];
        float xr = 0.f, xi = 0.f;
        for (int i = 0; i < j; ++i) { const float er = E[(size_t)(g * 128 + i) * 64 + lane], ei = E[(size_t)(64 * 128 * 64) + (size_t)(g * 128 + i) * 64 + lane];
            const float nr = a64r * xr - a64i * xi + er, ni = a64r * xi + a64i * xr + ei; xr = nr; xi = ni; }
        for (int tt = 0; tt < 4; ++tt) {
            for (int t16 = 0; t16 < 16; ++t16) { const LAS f32x4* up = (const LAS f32x4*)(ut + (16 * tt + t16) * 16); float bur = 0.f, bui = 0.f;
#pragma unroll
                for (int c4 = 0; c4 < 4; ++c4) { const f32x4 uv = up[c4];
                    bur += bbr[4 * c4] * uv.x + bbr[4 * c4 + 1] * uv.y + bbr[4 * c4 + 2] * uv.z + bbr[4 * c4 + 3] * uv.w;
                    bui += bbi[4 * c4] * uv.x + bbi[4 * c4 + 1] * uv.y + bbi[4 * c4 + 2] * uv.z + bbi[4 * c4 + 3] * uv.w; }
                const float nr = ar * xr - ai * xi + bur, ni = ar * xi + ai * xr + bui; xr = nr; xi = ni;
                *(LAS unsigned short*)(X + t16 * 272 + 2 * lane) = (unsigned short)f2bf(xr); *(LAS unsigned short*)(X + t16 * 272 + 128 + 2 * lane) = (unsigned short)f2bf(xi); }
            LDS_WAIT(); asm volatile("" ::: "memory");
            f32x4 acc = (f32x4){0.f, 0.f, 0.f, 0.f};
#pragma unroll
            for (int ks = 0; ks < 4; ++ks) { const bf16x8 af = *(const LAS bf16x8*)(X + fr * 272 + 64 * ks + 16 * fq); acc = __builtin_amdgcn_mfma_f32_16x16x32_bf16(af, cf[ks], acc, 0, 0, 0); }
#pragma unroll
            for (int r = 0; r < 4; ++r) { const int tl = 16 * tt + 4 * fq + r; const float y = acc[r] + dsk * ut[tl * 16 + fr];
                yap[(size_t)(64 * j + tl) * 1024 + 16 * g + fr] = (bf16)f2bf(gelu_tanh_f(y)); }
            LDS_WAIT(); asm volatile("" ::: "memory");
        }
    }
}

__device__ __forceinline__ void lds_add(LAS unsigned* p, unsigned v) { (void)__hip_atomic_fetch_add(p, v, __ATOMIC_RELAXED, __HIP_MEMORY_SCOPE_WORKGROUP); }
__device__ __forceinline__ unsigned ord_key(float s) { const unsigned u = __builtin_bit_cast(unsigned, s); return u ^ ((u >> 31) ? 0xFFFFFFFFu : 0x80000000u); }
template <int NB, bool PACKED>
__device__ __forceinline__ void hist_search(const LAS unsigned* hist, int field, unsigned need, int lane, int& bstar, unsigned& above) {
    constexpr int PER = NB / 64;
    unsigned cnt[PER]; unsigned tot = 0;
#pragma unroll
    for (int i = 0; i < PER; ++i) { unsigned h = hist[lane * PER + i]; if (PACKED) h = (h >> (16 * field)) & 0xffffu; cnt[i] = h; tot += h; }
    unsigned incl = tot;
#pragma unroll
    for (int o = 1; o < 64; o <<= 1) { const unsigned v = __shfl_down(incl, o); if (lane + o < 64) incl += v; }
    const unsigned excl = incl - tot;
    const unsigned long long mask = __ballot(incl >= need);
    const int lstar = 63 - __builtin_clzll(mask | 1ull);
    unsigned cum = excl; int b = -1; unsigned ab = 0;
#pragma unroll
    for (int i = PER - 1; i >= 0; --i) { if (b < 0) { if (cum + cnt[i] >= need) { b = lane * PER + i; ab = cum; } else cum += cnt[i]; } }
    bstar = __shfl(b, lstar); above = __shfl(ab, lstar);
}

__device__ __forceinline__ void dsa_phase(const Args& a, LAS unsigned char* lds, int G, int wave_s) {
    int lane_o = (int)__builtin_amdgcn_mbcnt_hi(~0u, __builtin_amdgcn_mbcnt_lo(~0u, 0u)); asm volatile("" : "+v"(lane_o)); const int lane = lane_o, wave = wave_s, tid_o = wave_s * 64 + lane_o;
    unsigned char* ws = a.ws; const bf16* proj = (const bf16*)(ws + WS_PROJ); const bf16* kvn = (const bf16*)(ws + WS_KVN);
    float* score = (float*)(ws + WS_SCORE); bf16* ycat = (bf16*)(ws + WS_YCAT);
    constexpr int WREG = 18944;
    LAS unsigned char* wl = lds + wave * WREG;
    LAS unsigned* hist = (LAS unsigned*)wl; LAS int* sel = (LAS int*)(wl + 16896);
    const int l31 = lane & 31, hh = lane >> 5, fr = lane & 15, fq = lane >> 4;
    for (int un = blockIdx.x; un < 512; un += G) {
        const int unit = (un & 1) ? (511 - (un >> 1)) : (un >> 1);
        const int t0 = unit * 16, tq = t0 + 2 * wave;
        const int nadm = ((t0 >> 6) + 1) * 64;
        if (nadm > 256) {
            for (int i = lane; i < 2048; i += 64) hist[i] = 0u;
            bf16x8 qa[4];
            { const int r = l31, qq = (r >> 2) & 1, head = (r & 3) + 4 * (r >> 3);
              const bf16* qp = proj + (size_t)(tq + qq) * NIN + C_QI + head * 64 + 8 * hh;
#pragma unroll
              for (int ks = 0; ks < 4; ++ks) qa[ks] = *(const bf16x8*)(qp + 16 * ks); }
            float wv[16];
            { const u32x4 w0 = *(const u32x4*)(proj + (size_t)(tq + hh) * NIN + C_WI), w1 = *(const u32x4*)(proj + (size_t)(tq + hh) * NIN + C_WI + 8);
              const float sc = 1.0f / 32.0f;
              wv[0] = bflo(w0.x) * sc; wv[1] = bfhi(w0.x) * sc; wv[2] = bflo(w0.y) * sc; wv[3] = bfhi(w0.y) * sc; wv[4] = bflo(w0.z) * sc; wv[5] = bfhi(w0.z) * sc; wv[6] = bflo(w0.w) * sc; wv[7] = bfhi(w0.w) * sc;
              wv[8] = bflo(w1.x) * sc; wv[9] = bfhi(w1.x) * sc; wv[10] = bflo(w1.y) * sc; wv[11] = bfhi(w1.y) * sc; wv[12] = bflo(w1.z) * sc; wv[13] = bfhi(w1.z) * sc; wv[14] = bflo(w1.w) * sc; wv[15] = bfhi(w1.w) * sc; }
            LDS_WAIT(); asm volatile("" ::: "memory");
            float* srow = score + (size_t)(tq + hh) * SEQ;
            for (int kt = 0; kt < nadm / 32; ++kt) {
                const bf16* kp = proj + (size_t)(32 * kt + l31) * NIN + C_KI + 8 * hh;
                bf16x8 kb[4];
#pragma unroll
                for (int ks = 0; ks < 4; ++ks) kb[ks] = *(const bf16x8*)(kp + 16 * ks);
                f32x16 acc;
#pragma unroll
                for (int i = 0; i < 16; ++i) acc[i] = 0.f;
#pragma unroll
                for (int ks = 0; ks < 4; ++ks) acc = __builtin_amdgcn_mfma_f32_32x32x16_bf16(qa[ks], kb[ks], acc, 0, 0, 0);
                float s = 0.f;
#pragma unroll
                for (int i = 0; i < 16; ++i) s += wv[i] * fmaxf(acc[i], 0.f);
                srow[32 * kt + l31] = s;
                const unsigned ok = ord_key(s);
                lds_add(&hist[ok >> 21], 1u << (16 * hh));
            }
            LDS_WAIT(); VM_WAIT(); asm volatile("" ::: "memory");
            int b1[2]; unsigned ab1[2];
            hist_search<2048, true>(hist, 0, 256u, lane, b1[0], ab1[0]);
            hist_search<2048, true>(hist, 1, 256u, lane, b1[1], ab1[1]);
#pragma unroll 1
            for (int qq = 0; qq < 2; ++qq) {
                const float* sr = score + (size_t)(tq + qq) * SEQ;
                const unsigned pre1 = (unsigned)b1[qq]; unsigned need = 256u - ab1[qq];
                asm volatile("" ::: "memory");
                for (int i = lane; i < 2048; i += 64) hist[i] = 0u;
                LDS_WAIT(); asm volatile("" ::: "memory");
                for (int k0 = 0; k0 < nadm; k0 += 64) { const unsigned ok = ord_key(sr[k0 + lane]); if ((ok >> 21) == pre1) lds_add(&hist[(ok >> 10) & 2047u], 1u); }
                LDS_WAIT(); asm volatile("" ::: "memory");
                int b2; unsigned ab2; hist_search<2048, false>(hist, 0, need, lane, b2, ab2); need -= ab2;
                const unsigned pre2 = (pre1 << 11) | (unsigned)b2;
                asm volatile("" ::: "memory");
                for (int i = lane; i < 1024; i += 64) hist[i] = 0u;
                LDS_WAIT(); asm volatile("" ::: "memory");
                for (int k0 = 0; k0 < nadm; k0 += 64) { const unsigned ok = ord_key(sr[k0 + lane]); if ((ok >> 10) == pre2) lds_add(&hist[ok & 1023u], 1u); }
                LDS_WAIT(); asm volatile("" ::: "memory");
                int b3; unsigned ab3; hist_search<1024, false>(hist, 0, need, lane, b3, ab3); need -= ab3;
                const unsigned T = (pre2 << 10) | (unsigned)b3;
                unsigned nsel = 0, neq = 0;
                for (int k0 = 0; k0 < nadm; k0 += 64) { const unsigned ok = ord_key(sr[k0 + lane]);
                    const unsigned long long meq = __ballot(ok == T); const unsigned eqrank = neq + (unsigned)__builtin_popcountll(meq & ((1ull << lane) - 1ull));
                    const bool take = (ok > T) || (ok == T && eqrank < need);
                    const unsigned long long mt = __ballot(take); const unsigned pos = nsel + (unsigned)__builtin_popcountll(mt & ((1ull << lane) - 1ull));
                    if (take && pos < 256u) sel[qq * 256 + pos] = k0 + lane;
                    nsel += (unsigned)__builtin_popcountll(mt); neq += (unsigned)__builtin_popcountll(meq); }
                for (int i = (int)nsel + lane; i < 256; i += 64) sel[qq * 256 + i] = -1;
                LDS_WAIT(); asm volatile("" ::: "memory");
            }
        } else {
            for (int i = lane; i < 512; i += 64) { const int k = i & 255; sel[i] = k < nadm ? k : -1; }
            LDS_WAIT(); asm volatile("" ::: "memory");
        }
#pragma unroll 1
        for (int qq = 0; qq < 2; ++qq) {
            const int t = tq + qq; const int head = fr & 7;
            const float slope = fast_exp2(-(float)(head + 1));
            bf16x8 qf[8];
            { const bf16* qp = proj + (size_t)t * NIN + C_QT + head * 256 + 8 * fq;
#pragma unroll
              for (int ks = 0; ks < 8; ++ks) qf[ks] = *(const bf16x8*)(qp + 32 * ks); }
            f32x4 oacc[16];
#pragma unroll
            for (int i = 0; i < 16; ++i) oacc[i] = (f32x4){0.f, 0.f, 0.f, 0.f};
            float mrun = -1e30f, lrun = 0.f;
            for (int kt = 0; kt < 8; ++kt) {
                asm volatile("" ::: "memory");
#pragma unroll
                for (int i = 0; i < 16; ++i) { const int row = hh + 2 * i; int s = sel[qq * 256 + 32 * kt + row]; s = s < 0 ? 0 : s;
                    const u32x4 v = *(const u32x4*)(kvn + (size_t)s * 256 + 8 * l31); *(LAS u32x4*)(wl + row * 528 + 16 * l31) = v; }
                LDS_WAIT(); asm volatile("" ::: "memory");
                f32x4 sacc[2];
#pragma unroll
                for (int sb = 0; sb < 2; ++sb) { f32x4 c4 = (f32x4){0.f, 0.f, 0.f, 0.f};
#pragma unroll
                    for (int ks = 0; ks < 8; ++ks) { const bf16x8 af = *(const LAS bf16x8*)(wl + (16 * sb + fr) * 528 + 64 * ks + 16 * fq); c4 = __builtin_amdgcn_mfma_f32_16x16x32_bf16(af, qf[ks], c4, 0, 0, 0); }
                    sacc[sb] = c4; }
                float lg[8]; float mx = -1e30f;
#pragma unroll
                for (int sb = 0; sb < 2; ++sb) { const LAS int* sp = sel + qq * 256 + 32 * kt + 16 * sb + 4 * fq;
#pragma unroll
                    for (int r = 0; r < 4; ++r) { const int s = sp[r]; const float d = (float)(t - s); float v = sacc[sb][r] - slope * fabsf(d); v = s < 0 ? -1e30f : v; lg[4 * sb + r] = v; mx = fmaxf(mx, v); } }
                mx = fmaxf(mx, __shfl_xor(mx, 16)); mx = fmaxf(mx, __shfl_xor(mx, 32));
                const float mnew = fmaxf(mrun, mx); const float alpha = fast_exp2((mrun - mnew) * 1.4426950408889634f);
                float ps = 0.f; float p[8];
#pragma unroll
                for (int i = 0; i < 8; ++i) { p[i] = lg[i] <= -1e29f ? 0.f : fast_exp2((lg[i] - mnew) * 1.4426950408889634f); ps += p[i]; }
                lrun = lrun * alpha + ps; mrun = mnew;
#pragma unroll
                for (int i = 0; i < 16; ++i) oacc[i] = oacc[i] * alpha;
                u32x4 pw; pw.x = pk2(p[0], p[1]); pw.y = pk2(p[2], p[3]); pw.z = pk2(p[4], p[5]); pw.w = pk2(p[6], p[7]);
                const bf16x8 pf = __builtin_bit_cast(bf16x8, pw);
#pragma unroll
                for (int rt = 0; rt < 16; ++rt) {
                    const LAS unsigned char* p0 = wl + (4 * fq + (fr >> 2)) * 528 + (16 * rt + 4 * (fr & 3)) * 2;
                    const v4i16_t a0 = __builtin_amdgcn_ds_read_tr16_b64_v4i16((LAS v4i16_t*)p0);
                    const v4i16_t a1 = __builtin_amdgcn_ds_read_tr16_b64_v4i16((LAS v4i16_t*)(p0 + 16 * 528));
                    bf16x8 af; af[0] = a0[0]; af[1] = a0[1]; af[2] = a0[2]; af[3] = a0[3]; af[4] = a1[0]; af[5] = a1[1]; af[6] = a1[2]; af[7] = a1[3];
                    oacc[rt] = __builtin_amdgcn_mfma_f32_16x16x32_bf16(af, pf, oacc[rt], 0, 0, 0); }
                LDS_WAIT(); asm volatile("" ::: "memory");
            }
            float lt = lrun; lt += __shfl_xor(lt, 16); lt += __shfl_xor(lt, 32);
            const float inv = 1.0f / lt;
            if (fr < 8) { bf16* op = ycat + (size_t)t * NCAT + 1024 + fr * 256 + 4 * fq;
#pragma unroll
                for (int rt = 0; rt < 16; ++rt) { const f32x4 v = oacc[rt] * inv; u32x2 w; w.x = pk2(v.x, v.y); w.y = pk2(v.z, v.w); *(u32x2*)(op + 16 * rt) = w; } }
        }
        LDS_WAIT(); asm volatile("" ::: "memory");
    }
}

__device__ __forceinline__ void attn_c_phase(const Args& a, LAS unsigned char* lds, int G, int wave_s) {
    int lane_o = (int)__builtin_amdgcn_mbcnt_hi(~0u, __builtin_amdgcn_mbcnt_lo(~0u, 0u)); asm volatile("" : "+v"(lane_o)); const int lane = lane_o, wave = wave_s, tid_o = wave_s * 64 + lane_o;
    unsigned char* ws = a.ws; const bf16* Q = (const bf16*)(ws + WS_Q); const bf16* K = (const bf16*)(ws + WS_K); const bf16* VT = (const bf16*)(ws + WS_VT); bf16* O = (bf16*)(ws + WS_O);
    LAS float* btab = (LAS float*)lds;
    const int l31 = lane & 31, hh = lane >> 5;
    const float sc = 0.08838834764831845f * 1.4426950408889634f;
    for (int un = blockIdx.x; un < 512; un += G) {
        const int head = un >> 5, cg = un & 31, chunk = 4 * cg + (wave >> 1);
        __syncthreads();
        for (int i = tid_o; i < 513; i += NTHR) btab[i] = a.in[I_RELB][head * 513 + i] * 1.4426950408889634f;
        __syncthreads();
        const int t = 64 * chunk + 32 * (wave & 1) + l31;
        bf16x8 qf[8];
        { const bf16* qp = Q + (size_t)t * DM + head * 128 + 8 * hh;
#pragma unroll
          for (int ks = 0; ks < 8; ++ks) qf[ks] = *(const bf16x8*)(qp + 16 * ks); }
        f32x16 oacc[4];
#pragma unroll
        for (int d = 0; d < 4; ++d)
#pragma unroll
            for (int i = 0; i < 16; ++i) oacc[d][i] = 0.f;
        float mrun = -1e30f, lrun = 0.f;
        const int sbeg = 64 * (chunk - 8);
        for (int kt = 0; kt < 18; ++kt) {
            const int s0 = sbeg + 32 * kt; if (s0 < 0) continue;
            const bf16* kp = K + (size_t)(s0 + l31) * DM + head * 128 + 8 * hh;
            f32x16 sa;
#pragma unroll
            for (int i = 0; i < 16; ++i) sa[i] = 0.f;
#pragma unroll
            for (int ks = 0; ks < 8; ++ks) { const bf16x8 kf = *(const bf16x8*)(kp + 16 * ks); sa = __builtin_amdgcn_mfma_f32_32x32x16_bf16(kf, qf[ks], sa, 0, 0, 0); }
            float mx = -1e30f; float lg[16];
#pragma unroll
            for (int i = 0; i < 16; ++i) { const int s = s0 + (i & 3) + 8 * (i >> 2) + 4 * hh; int rel = t - s; rel = rel > 256 ? 256 : rel; lg[i] = sa[i] * sc + btab[rel + 256]; mx = fmaxf(mx, lg[i]); }
            mx = fmaxf(mx, __shfl_xor(mx, 32));
            const float mnew = fmaxf(mrun, mx), alpha = fast_exp2(mrun - mnew);
            float ps = 0.f; float p[16];
#pragma unroll
            for (int i = 0; i < 16; ++i) { p[i] = fast_exp2(lg[i] - mnew); ps += p[i]; }
            lrun = lrun * alpha + ps; mrun = mnew;
#pragma unroll
            for (int d = 0; d < 4; ++d)
#pragma unroll
                for (int i = 0; i < 16; ++i) oacc[d][i] *= alpha;
#pragma unroll
            for (int s = 0; s < 2; ++s) {
                u32x4 pw; pw.x = pk2(p[8 * s], p[8 * s + 1]); pw.y = pk2(p[8 * s + 2], p[8 * s + 3]); pw.z = pk2(p[8 * s + 4], p[8 * s + 5]); pw.w = pk2(p[8 * s + 6], p[8 * s + 7]);
                const bf16x8 pf = __builtin_bit_cast(bf16x8, pw);
#pragma unroll
                for (int d = 0; d < 4; ++d) { const bf16* vp = VT + (size_t)(head * 128 + 32 * d + l31) * SEQ + s0 + 16 * s + 4 * hh;
                    const u32x2 v0 = *(const u32x2*)vp, v1 = *(const u32x2*)(vp + 8);
                    u32x4 vw; vw.x = v0.x; vw.y = v0.y; vw.z = v1.x; vw.w = v1.y;
                    oacc[d] = __builtin_amdgcn_mfma_f32_32x32x16_bf16(__builtin_bit_cast(bf16x8, vw), pf, oacc[d], 0, 0, 0); }
            }
        }
        float lt = lrun + __shfl_xor(lrun, 32); const float inv = 1.0f / lt;
        bf16* op = O + (size_t)t * DM + head * 128 + 4 * hh;
#pragma unroll
        for (int d = 0; d < 4; ++d)
#pragma unroll
            for (int gq = 0; gq < 4; ++gq) { u32x2 w; w.x = pk2(oacc[d][4 * gq] * inv, oacc[d][4 * gq + 1] * inv); w.y = pk2(oacc[d][4 * gq + 2] * inv, oacc[d][4 * gq + 3] * inv);
                *(u32x2*)(op + 32 * d + 8 * gq) = w; }
    }
    __syncthreads();
}

__global__ void __launch_bounds__(NTHR, 2) fwd_kernel(Args args) {
    extern __shared__ __attribute__((aligned(16))) unsigned char lds_raw[];
    LAS unsigned char* lds = (LAS unsigned char*)lds_raw;
    volatile LAS unsigned* MISC = (volatile LAS unsigned*)(lds + MISC_OFF);
    const int wave_s = __builtin_amdgcn_readfirstlane((int)threadIdx.x >> 6);
    const int G = gridDim.x;
    unsigned char* ws = args.ws;
    if (threadIdx.x < 64) MISC[threadIdx.x] = 0u;
    __syncthreads();
    const int lo = args.ph_lo, hi = args.ph_hi;
    const bool multi = (hi - lo) > 1;
    XcdBarrier bar; bar.bar = (unsigned*)(ws + WS_CTL) + CW_BAR; bar.x = 0; bar.st = nullptr;
    if (multi) bar = xcd_barrier_post((unsigned*)(ws + WS_CTL) + CW_BAR, MISC + 8);
    bar.wave = wave_s;
#define IN(k) (lo <= (k) && (k) < hi)
#define SEAM(k) do { if (IN((k) + 1)) xcd_barrier(bar); } while (0)

    float* H = args.out;
    float* mod = (float*)(ws + WS_MOD);
    bf16* hn = (bf16*)(ws + WS_HN); bf16* hmid = (bf16*)(ws + WS_HMID); bf16* proj = (bf16*)(ws + WS_PROJ);

    if (EN(0) && IN(0)) p0_prologue(args, lds, G, wave_s);
    if (IN(0)) SEAM(0);

#define FFN_PHASES(S_, PB_) do { \
        constexpr int layer_ = (S_) >> 1, sub_ = ((S_) & 1) ? 2 : 0; \
        const float* hin_ = ((S_) == 0) ? args.in[I_X] : H; \
        const float* mvec_ = mod + layer_ * NMOD + sub_ * 3 * DM; \
        if (EN(1) && IN(PB_)) norm_phase<false>(hin_, args.in[I_NORMG] + (layer_ * 3 + sub_) * DM, mvec_, mvec_ + DM, hn, nullptr, G, wave_s); \
        if ((S_) == 0 && EN(2) && IN(PB_)) { \
              \
            pg8::Gemm g{(const bf16*)(ws + WS_WUPRAW), (const bf16*)(ws + WS_WQRAW), 256, 2048, 128, 2048, 2048, 8, 128, 128, \
                        (const bf16*)(ws + WS_WOUTB) + 1024, (const bf16*)(ws + WS_WUPRAW) + 1024, 2048, 256, 8, 128, 128}; \
            pg8::StaticOrder S; S.init(g, G, (int)blockIdx.x); \
            pg8::EpiBf16 E{(bf16*)(ws + WS_WIN) + (size_t)1024 * DM, DM, (size_t)256 * DM, 0.08838834764831845f, (bf16*)(ws + WS_WOUT) + 1024, NCAT, (size_t)256, 1.0f}; \
            pg8::gemm_phase<pg8::EpiBf16>(lds, g, S, E, wave_s); } \
        if (IN(PB_)) SEAM(PB_); \
        if (EN(3) && IN((PB_) + 1)) { \
            pg8::Gemm g{hn, (const bf16*)(ws + WS_WGU) + (size_t)(S_) * NGU * DM, SEQ, NGU, DM, DM, DM, 1, 0, 0, nullptr, nullptr, 0, 0, 0, 0, 0}; \
            pg8::StaticOrder S; S.init(g, G, (int)blockIdx.x); \
            pg8::EpiSwiGLU E{hmid, FF}; \
            pg8::gemm_phase<pg8::EpiSwiGLU>(lds, g, S, E, wave_s); } \
        if (IN((PB_) + 1)) SEAM((PB_) + 1); \
        if (EN(4) && IN((PB_) + 2)) { \
            pg8::Gemm g{hmid, (const bf16*)(ws + WS_WD) + (size_t)(S_) * DM * FF, SEQ, DM, FF, FF, FF, 1, 0, 0, nullptr, nullptr, 0, 0, 0, 0, 0}; \
            pg8::StaticOrder S; S.init(g, G, (int)blockIdx.x); \
            pg8::EpiResid E{hin_, H, mvec_ + 2 * DM, 0.5f}; \
            pg8::gemm_phase<pg8::EpiResid>(lds, g, S, E, wave_s); } \
        if (IN((PB_) + 2)) SEAM((PB_) + 2); \
    } while (0)
#define MIXOUT_PHASE(LYR_, PM_, APTR_, BPTR_, K_) do { \
        if (EN(12) && IN(PM_)) { \
            const float* m1_ = mod + (LYR_) * NMOD + 1 * 3 * DM; \
            pg8::Gemm g{(const bf16*)(APTR_), (const bf16*)(BPTR_), SEQ, DM, (K_), (K_), (K_), 1, 0, 0, nullptr, nullptr, 0, 0, 0, 0, 0}; \
            pg8::StaticOrder S; S.init(g, G, (int)blockIdx.x); \
            pg8::EpiResid E{H, H, m1_ + 2 * DM, 1.0f}; \
            pg8::gemm_phase<pg8::EpiResid>(lds, g, S, E, wave_s); } \
        if (IN(PM_)) SEAM(PM_); \
    } while (0)

    FFN_PHASES(0, 1);
    {
        const float* m1 = mod + 0 * NMOD + 1 * 3 * DM;
        if (EN(1) && IN(4)) norm_phase<false>(H, args.in[I_NORMG] + (0 * 3 + 1) * DM, m1, m1 + DM, hn, nullptr, G, wave_s);
        if (IN(4)) SEAM(4);
        if (EN(5) && IN(5)) {
            pg8::Gemm g{hn, (const bf16*)(ws + WS_WIN), SEQ, NIN, DM, DM, DM, 1, 0, 0, nullptr, nullptr, 0, 0, 0, 0, 0};
            pg8::StaticOrder S; S.init(g, G, (int)blockIdx.x);
            pg8::EpiBf16 E{proj, NIN, 0, 1.0f, nullptr, 0, 0, 0.f};
            pg8::gemm_phase<pg8::EpiBf16>(lds, g, S, E, wave_s);
        }
        if (IN(5)) SEAM(5);
        if (EN(6) && IN(6)) phase_a2(args, lds, G, wave_s);
        if (IN(6)) SEAM(6);
        if (EN(7) && IN(7)) { s5_scan_out(args, lds, G, wave_s); __syncthreads(); }
        if (EN(8) && IN(7)) dsa_phase(args, lds, G, wave_s);
        if (IN(7)) SEAM(7);
        if (EN(9) && IN(8)) {
            pg8::Gemm g{(const bf16*)(ws + WS_YAPRE), (const bf16*)(ws + WS_WGLU), SEQ, 1024, 1024, 1024, 1024, 1, 0, 0, nullptr, nullptr, 0, 0, 0, 0, 0};
            pg8::StaticOrder S; S.init(g, G, (int)blockIdx.x);
            pg8::EpiGLU E{(const bf16*)(ws + WS_YAPRE), args.in[I_BGLU], (bf16*)(ws + WS_YCAT), NCAT};
            pg8::gemm_phase<pg8::EpiGLU>(lds, g, S, E, wave_s);
        }
        if (IN(8)) SEAM(8);
    }
    MIXOUT_PHASE(0, 9, ws + WS_YCAT, ws + WS_WOUT, NCAT);
    FFN_PHASES(1, 10);
    FFN_PHASES(2, 13);
    {
        const float* m1 = mod + 1 * NMOD + 1 * 3 * DM;
        if (EN(1) && IN(16)) norm_phase<false>(H, args.in[I_NORMG] + (1 * 3 + 1) * DM, m1, m1 + DM, hn, nullptr, G, wave_s);
        if (IN(16)) SEAM(16);
        if (EN(10) && IN(17)) {
            pg8::Gemm g{hn, (const bf16*)(ws + WS_WQKV), SEQ, 2048, DM, DM, DM, 2, 0, (size_t)2048 * DM,
                        (const bf16*)(ws + WS_WQKV) + (size_t)4096 * DM, hn, 2048, SEQ, 1, 0, 0};
            pg8::StaticOrder S; S.init(g, G, (int)blockIdx.x);
            pg8::EpiBf16 E{(bf16*)(ws + WS_Q), DM, (size_t)SEQ * DM, 1.0f, (bf16*)(ws + WS_VT), SEQ, 0, 1.0f};
            pg8::gemm_phase<pg8::EpiBf16>(lds, g, S, E, wave_s);
        }
        if (IN(17)) SEAM(17);
        if (EN(11) && IN(18)) attn_c_phase(args, lds, G, wave_s);
        if (IN(18)) SEAM(18);
    }
    MIXOUT_PHASE(1, 19, ws + WS_O, ws + WS_WCOUT, DM);
    FFN_PHASES(3, 20);
    if (EN(13) && IN(23)) { norm_phase<true>(H, args.in[I_FING], nullptr, nullptr, nullptr, args.out, G, wave_s); }
#undef IN
#undef SEAM
}

extern "C" void kernel_launch(void* const* d_in, const int* in_sizes, int n_in, void* d_out, int out_size, void* d_ws, size_t ws_size, hipStream_t stream) {
    static int grid = 0;
    if (grid == 0) {
        if (n_in != 26 || out_size != SEQ * DM || ws_size < WS_END) { fprintf(stderr, "kernel_launch: unexpected shapes (n_in %d out %d ws %zu need %zu)\n", n_in, out_size, ws_size, (size_t)WS_END); grid = -1; return; }
        int dev = 0, cus = 0, per_cu = 0;
        if (hipGetDevice(&dev) != hipSuccess || hipDeviceGetAttribute(&cus, hipDeviceAttributeMultiprocessorCount, dev) != hipSuccess) { grid = -1; return; }
        if (hipFuncSetAttribute((const void*)fwd_kernel, hipFuncAttributeMaxDynamicSharedMemorySize, LDS_BYTES) != hipSuccess) { fprintf(stderr, "kernel_launch: hipFuncSetAttribute failed\n"); grid = -1; return; }
        if (hipOccupancyMaxActiveBlocksPerMultiprocessor(&per_cu, (const void*)fwd_kernel, NTHR, LDS_BYTES) != hipSuccess || per_cu < 1) { fprintf(stderr, "kernel_launch: occupancy query says %d\n", per_cu); }
        (void)hipGetLastError();
        grid = cus;
    }
    if (grid < 0) return;
    (void)hipMemsetAsync((char*)d_ws + WS_CTL, 0, CTL_ZERO_BYTES, stream);
    Args a{};
    for (int i = 0; i < 26; ++i) a.in[i] = (const float*)d_in[i];
    a.out = (float*)d_out; a.ws = (unsigned char*)d_ws;
    a.ph_lo = 0; a.ph_hi = N_PHASES_RUN;
    hipLaunchKernelGGL(fwd_kernel, dim3(grid), dim3(NTHR), LDS_BYTES, stream, a);
}
```

```cpp
#include <hip/hip_runtime.h>
#include <cstdio>
#include <cstdint>

#ifndef SELFCHECK
#define SELFCHECK 0
#endif
#ifndef N_PHASES_RUN
#define N_PHASES_RUN 24
#endif
#ifndef REP_MASK
#define REP_MASK 0u
#endif
#ifndef REP_N
#define REP_N 2
#endif
#ifndef TIMING
#define TIMING 0
#endif
#ifndef TSEL_A
#define TSEL_A 0
#define TSEL_A_N 1
#define TSEL_B 1
#define TSEL_B_N 1
#endif

#ifndef EN_MASK
#define EN_MASK 0xFFFFFFFFu
#endif
#define EN(b) ((EN_MASK >> (b)) & 1u)
#define GAS __attribute__((address_space(1)))
#define LAS __attribute__((address_space(3)))
typedef unsigned short bf16;
typedef short bf16x8 __attribute__((ext_vector_type(8)));
typedef short s16x4 __attribute__((ext_vector_type(4)));
typedef float f32x2 __attribute__((ext_vector_type(2)));
typedef float f32x4 __attribute__((ext_vector_type(4)));
typedef float f32x16 __attribute__((ext_vector_type(16)));
typedef unsigned u32x2 __attribute__((ext_vector_type(2)));
typedef unsigned u32x4 __attribute__((ext_vector_type(4)));
typedef short v4i16_t __attribute__((ext_vector_type(4)));

constexpr int SEQ = 8192, DM = 2048, FF = 5504, NGU = 2 * FF  , NMOD = 18432;
constexpr int NIN = 4608;
constexpr int C_U = 0, C_QT = 1024, C_KVL = 3072, C_QI = 3328, C_KI = 4352, C_WI = 4416;
constexpr int FFP = 5632;
constexpr int NCAT = 3072;
constexpr int NWAVES = 8, NTHR = 512;

constexpr size_t MiB = 1u << 20;
constexpr size_t WS_CTL = 0, CTL_ZERO_BYTES = 1 * MiB;
constexpr size_t WS_MOD = 1 * MiB;
constexpr size_t WS_S5T = WS_MOD + 256 * 1024;
constexpr size_t WS_DIAG = 3 * MiB;
constexpr size_t WS_WGU = 4 * MiB;
constexpr size_t WS_WD = WS_WGU + 172 * MiB;
constexpr size_t WS_WIN = WS_WD + 86 * MiB;
constexpr size_t WS_WQRAW = WS_WIN + 18 * MiB;
constexpr size_t WS_WUPRAW = WS_WQRAW + 8 * MiB;
constexpr size_t WS_WGLU = WS_WUPRAW + 1 * MiB;
constexpr size_t WS_WOUT = WS_WGLU + 2 * MiB;
constexpr size_t WS_WOUTB = WS_WOUT + 12 * MiB;
constexpr size_t WS_WQKV = WS_WOUTB + 8 * MiB;
constexpr size_t WS_WCOUT = WS_WQKV + 24 * MiB;
constexpr size_t WS_HN = WS_WCOUT + 8 * MiB;
constexpr size_t WS_HMID = WS_HN + 32 * MiB;
constexpr size_t WS_PROJ = WS_HMID + 86 * MiB;
constexpr size_t WS_KVN = WS_PROJ + 72 * MiB;
constexpr size_t WS_E = WS_KVN + 4 * MiB;
constexpr size_t WS_YAPRE = WS_E + 4 * MiB;
constexpr size_t WS_YCAT = WS_YAPRE + 16 * MiB;
constexpr size_t WS_SCORE = WS_YCAT + 48 * MiB;
constexpr size_t WS_Q = WS_SCORE, WS_K = WS_SCORE + 32 * MiB, WS_VT = WS_SCORE + 64 * MiB, WS_O = WS_SCORE + 96 * MiB;
constexpr size_t WS_END = WS_SCORE + 256 * MiB;
constexpr int S5_AR = 0, S5_AI = 4096, S5_A64R = 8192, S5_A64I = 12288, S5_BBR = 16384, S5_BBI = 16384 + 65536;

constexpr int CW_BAR = 4096;

constexpr int RING_BYTES = 131072;
constexpr int SCRATCH_BYTES = 155648;
constexpr int MISC_OFF = SCRATCH_BYTES;
constexpr int LDS_BYTES = SCRATCH_BYTES + 256;

#define LDS_WAIT() asm volatile("s_waitcnt lgkmcnt(0)" ::: "memory")
#define VM_WAIT() asm volatile("s_waitcnt vmcnt(0)" ::: "memory")

__device__ __forceinline__ unsigned f2bf(float f) { unsigned u = __builtin_bit_cast(unsigned, f); return (u + 0x7fffu + ((u >> 16) & 1u)) >> 16; }
__device__ __forceinline__ unsigned pk2(float lo, float hi) { unsigned r; asm volatile("v_cvt_pk_bf16_f32 %0, %1, %2" : "=v"(r) : "v"(lo), "v"(hi)); return r; }
__device__ __forceinline__ float clamp448(float x) { return __builtin_amdgcn_fmed3f(x, -448.0f, 448.0f); }
__device__ __forceinline__ unsigned pk4_fp8(float a, float b, float c, float d) {
    int w = 0; w = __builtin_amdgcn_cvt_pk_fp8_f32(clamp448(a), clamp448(b), w, false); w = __builtin_amdgcn_cvt_pk_fp8_f32(clamp448(c), clamp448(d), w, true); return (unsigned)w; }
__device__ __forceinline__ float bf2f(unsigned short b) { return __builtin_bit_cast(float, (unsigned)b << 16); }
__device__ __forceinline__ float bflo(unsigned w) { return __builtin_bit_cast(float, w << 16); }
__device__ __forceinline__ float bfhi(unsigned w) { return __builtin_bit_cast(float, w & 0xffff0000u); }
__device__ __forceinline__ float fast_exp2(float x) { return __builtin_amdgcn_exp2f(x); }
__device__ __forceinline__ float fast_rcp(float x) { return __builtin_amdgcn_rcpf(x); }
__device__ __forceinline__ float silu_f(float x) { return x * fast_rcp(1.0f + fast_exp2(-1.4426950408889634f * x)); }
__device__ __forceinline__ float sigmoid_f(float x) { return fast_rcp(1.0f + fast_exp2(-1.4426950408889634f * x)); }
__device__ __forceinline__ float gelu_tanh_f(float y) {
    const float z = 0.7978845608028654f * (y + 0.044715f * y * y * y);
    const float e = fast_exp2(2.0f * 1.4426950408889634f * z);
    const float th = 1.0f - 2.0f * fast_rcp(e + 1.0f);
    return 0.5f * y * (1.0f + th);
}
__device__ __forceinline__ float wave_sum(float v) {
#pragma unroll
    for (int o = 1; o < 64; o <<= 1) v += __shfl_xor(v, o);
    return v;
}

namespace pg8 {
constexpr int BM = 256, BK = 64, HALF = 128, HTB = HALF * BK * 2, STAGE_BYTES = 8 * HTB, NXCD = 8, WGM = 8;
__host__ __device__ __forceinline__ int lds_byte(int r, int c) { const int st = (r >> 4) * 2 + (c >> 5), rr = r & 15, cc = c & 31, ob = rr * 64 + cc * 2; return st * 1024 + (ob ^ (((ob >> 9) & 1) << 5)); }
__host__ __device__ __forceinline__ void stage_rc(int b, int& R, int& C) { const int st = b / 1024, sb = b % 1024, swz = sb ^ (((sb >> 9) & 1) << 5); R = (st >> 1) * 16 + swz / 64; C = (st & 1) * 32 + (swz % 64) / 2; }
__host__ __device__ __forceinline__ int perm32(int rho) { const int n = rho >> 4, i = rho & 15; return 8 * (i >> 2) + 4 * n + (i & 3); }

typedef int v4i_t __attribute__((ext_vector_type(4)));
typedef int v8i_t __attribute__((ext_vector_type(8)));
__device__ __forceinline__ v8i_t cat8(bf16x8 lo, bf16x8 hi) { return __builtin_shufflevector(__builtin_bit_cast(v4i_t, lo), __builtin_bit_cast(v4i_t, hi), 0, 1, 2, 3, 4, 5, 6, 7); }
__device__ __forceinline__ bf16x8 lo8(v8i_t v) { return __builtin_bit_cast(bf16x8, __builtin_shufflevector(v, v, 0, 1, 2, 3)); }
__device__ __forceinline__ bf16x8 hi8(v8i_t v) { return __builtin_bit_cast(bf16x8, __builtin_shufflevector(v, v, 4, 5, 6, 7)); }
struct Unit { int pm, pn, z, seg; };
struct Gemm { const bf16* A; const bf16* Bt; int M, N, K, lda, ldb, nz; size_t zA, zB; const bf16* A1; const bf16* Bt1; int M1, N1, nz1; size_t zA1, zB1; };

struct StaticOrder {
    int nM0, nN0, n0, nM1, nN1, ntot, G, c;
    __device__ void init(const Gemm& g, int G_, int c_) { nM0 = g.M / BM; nN0 = g.N / BM; n0 = nM0 * nN0 * g.nz; nM1 = g.M1 / BM; nN1 = g.N1 / BM; ntot = n0 + nM1 * nN1 * g.nz1; G = G_; c = c_; }
    __device__ bool next(int i, Unit& u) const {
        int L = i * G + c; if (L >= ntot) return false;
        const int seg = L >= n0 ? 1 : 0; if (seg) L -= n0;
        const int nM = seg ? nM1 : nM0, nN = seg ? nN1 : nN0, nwg = nM * nN;
        u.seg = seg; u.z = L / nwg;
        int wgid = L % nwg; { const int q = nwg / NXCD, r = nwg % NXCD, xcd = wgid % NXCD, off = wgid / NXCD; wgid = (xcd < r ? xcd * (q + 1) : r * (q + 1) + (xcd - r) * q) + off; }
        const int nig = WGM * nN, gid = wgid / nig, fm = gid * WGM, gsz = (nM - fm) < WGM ? (nM - fm) : WGM;
        u.pm = fm + ((wgid % nig) % gsz); u.pn = (wgid % nig) / gsz; return true;
    }
};

struct EpiBf16 {
    static constexpr bool PERM = true;
    bf16* O; int ldc; size_t zC; float scale; bf16* O1; int ldc1; size_t zC1; float scale1; int scale_a = 0, scale_w = 0;
    __device__ __forceinline__ void operator()(const f32x4 (&acc)[2][2][4][2], const Unit& u, int wr, int wc, int fr, int fq) const {
        const int row0 = u.pm * BM + wr * 64 + fr; const int col0 = u.pn * BM + wc * 32 + 8 * fq;
        bf16* base = u.seg ? O1 + (size_t)u.z * zC1 : O + (size_t)u.z * zC; const int ldc = u.seg ? ldc1 : this->ldc; const float scale = u.seg ? scale1 : this->scale;
#pragma unroll
        for (int ai = 0; ai < 2; ++ai)
#pragma unroll
            for (int m = 0; m < 4; ++m) { bf16* rowp = base + (size_t)(row0 + ai * HALF + m * 16) * ldc + col0;
#pragma unroll
                for (int bj = 0; bj < 2; ++bj) { const f32x4 v0 = acc[ai][bj][m][0] * scale, v1 = acc[ai][bj][m][1] * scale;
                    u32x4 w; w.x = pk2(v0[0], v0[1]); w.y = pk2(v0[2], v0[3]); w.z = pk2(v1[0], v1[1]); w.w = pk2(v1[2], v1[3]);
                    *(u32x4*)(rowp + bj * HALF) = w; } }
    }
};
struct EpiSwiGLU {
    static constexpr bool PERM = true;
    unsigned char* O; int ldc; int scale_a, scale_w;
    __device__ __forceinline__ void operator()(const f32x4 (&acc)[2][2][4][2], const Unit& u, int wr, int wc, int fr, int fq) const {
        const int row0 = u.pm * BM + wr * 64 + fr; const int col0 = u.pn * HALF + wc * 32 + 8 * fq;
#pragma unroll
        for (int ai = 0; ai < 2; ++ai)
#pragma unroll
            for (int m = 0; m < 4; ++m) { unsigned char* rowp = O + (size_t)(row0 + ai * HALF + m * 16) * ldc + col0;
                const f32x4 g0 = acc[ai][0][m][0], g1 = acc[ai][0][m][1], u0 = acc[ai][1][m][0] * 8.0f, u1 = acc[ai][1][m][1] * 8.0f;
                u32x2 w; w.x = pk4_fp8(silu_f(g0[0]) * u0[0], silu_f(g0[1]) * u0[1], silu_f(g0[2]) * u0[2], silu_f(g0[3]) * u0[3]);
                w.y = pk4_fp8(silu_f(g1[0]) * u1[0], silu_f(g1[1]) * u1[1], silu_f(g1[2]) * u1[2], silu_f(g1[3]) * u1[3]);
                *(u32x2*)rowp = w; }
    }
};
struct EpiResid {
    static constexpr bool PERM = false;
    const float* hin; float* out; const float* gate; float coef; int scale_a, scale_w;
    __device__ __forceinline__ void operator()(const f32x4 (&acc)[2][2][4][2], const Unit& u, int wr, int wc, int fr, int fq) const {
        const int row0 = u.pm * BM + wr * 64 + fr; const int col0 = u.pn * BM + wc * 32 + 4 * fq;
        f32x4 gv[2][2];
#pragma unroll
        for (int bj = 0; bj < 2; ++bj)
#pragma unroll
            for (int n = 0; n < 2; ++n) gv[bj][n] = *(const f32x4*)(gate + col0 + bj * HALF + n * 16) * coef;
#pragma unroll
        for (int ai = 0; ai < 2; ++ai)
#pragma unroll
            for (int m = 0; m < 4; ++m) { const size_t off = (size_t)(row0 + ai * HALF + m * 16) * DM + col0;
#pragma unroll
                for (int bj = 0; bj < 2; ++bj)
#pragma unroll
                    for (int n = 0; n < 2; ++n) { const f32x4 b = *(const f32x4*)(hin + off + bj * HALF + n * 16);
                        *(f32x4*)(out + off + bj * HALF + n * 16) = b + gv[bj][n] * acc[ai][bj][m][n]; } }
    }
};
struct EpiGLU {
    static constexpr bool PERM = true;
    const bf16* yp; const float* bias; bf16* O; int ldc; int scale_a = 0, scale_w = 0;
    __device__ __forceinline__ void operator()(const f32x4 (&acc)[2][2][4][2], const Unit& u, int wr, int wc, int fr, int fq) const {
        const int row0 = u.pm * BM + wr * 64 + fr; const int col0 = u.pn * BM + wc * 32 + 8 * fq;
#pragma unroll
        for (int bj = 0; bj < 2; ++bj) { const f32x4 b0 = *(const f32x4*)(bias + col0 + bj * HALF), b1 = *(const f32x4*)(bias + col0 + bj * HALF + 4);
#pragma unroll
            for (int ai = 0; ai < 2; ++ai)
#pragma unroll
                for (int m = 0; m < 4; ++m) { const size_t r = (size_t)(row0 + ai * HALF + m * 16);
                    const u32x4 y = *(const u32x4*)(yp + r * 1024 + col0 + bj * HALF);
                    const f32x4 z0 = acc[ai][bj][m][0] + b0, z1 = acc[ai][bj][m][1] + b1;
                    u32x4 w; w.x = pk2(bflo(y.x) * sigmoid_f(z0[0]), bfhi(y.x) * sigmoid_f(z0[1])); w.y = pk2(bflo(y.y) * sigmoid_f(z0[2]), bfhi(y.y) * sigmoid_f(z0[3]));
                    w.z = pk2(bflo(y.z) * sigmoid_f(z1[0]), bfhi(y.z) * sigmoid_f(z1[1])); w.w = pk2(bflo(y.w) * sigmoid_f(z1[2]), bfhi(y.w) * sigmoid_f(z1[3]));
                    *(u32x4*)(O + r * ldc + col0 + bj * HALF) = w; } }
    }
};

template <class Epi, bool FP8 = false>
__device__ __forceinline__ void gemm_phase(LAS unsigned char* lds, const Gemm g, const StaticOrder& S, const Epi& E, int wave_s) {
    int lane_o = (int)__builtin_amdgcn_mbcnt_hi(~0u, __builtin_amdgcn_mbcnt_lo(~0u, 0u)); asm volatile("" : "+v"(lane_o));
    const int wid = wave_s, lane = lane_o, tid = wave_s * 64 + lane_o, wr = wid >> 2, wc = wid & 3, fr = lane & 15, fq = lane >> 4;
    const int K = g.K, nt = K / BK;
    unsigned voffA[2], voffB[2];
#pragma unroll
    for (int i = 0; i < 2; ++i) { int R, C; stage_rc(tid * 16 + i * 8192, R, C); const int Rb = Epi::PERM ? ((R & ~31) + perm32(R & 31)) : R;
        voffA[i] = (unsigned)(R * g.lda + C) * 2u; voffB[i] = (unsigned)(Rb * g.ldb + C) * 2u; }
    const size_t kstep = (size_t)(BK * 2);
    const size_t hstepA = (size_t)HALF * g.lda * 2, hstepB = (size_t)HALF * g.ldb * 2;
    const size_t tstepA = 2 * hstepA, tstepB = 2 * hstepB;
    const unsigned ldsw = (unsigned)wid * 1024u;
    const int aoff = lds_byte(wr * 64 + fr, fq * 8), boff = lds_byte(wc * 32 + fr, fq * 8);
#define PG8_SA(b, h) (((b) * 2 + (h)) * HTB)
#define PG8_SB(b, h) ((4 + (b) * 2 + (h)) * HTB)
#define PG8_STAGE(bufoff, gbase, voff) do { _Pragma("unroll") for (int _i = 0; _i < 2; ++_i) \
        __builtin_amdgcn_global_load_lds((const unsigned*)((const char*)(gbase) + (voff)[_i]), (LAS unsigned*)(lds + (bufoff) + ldsw + _i * 8192), 16, 0, 0); } while (0)
#define PG8_LDA(dst, b, h) do { _Pragma("unroll") for (int m = 0; m < 4; ++m) { const bf16x8 l_ = *(const LAS bf16x8*)(lds + PG8_SA(b, h) + aoff + m * 2048), h_ = *(const LAS bf16x8*)(lds + PG8_SA(b, h) + aoff + m * 2048 + 1024); dst[m] = cat8(l_, h_); } } while (0)
#define PG8_LDB(dst, b, h) do { _Pragma("unroll") for (int n = 0; n < 2; ++n) { const bf16x8 l_ = *(const LAS bf16x8*)(lds + PG8_SB(b, h) + boff + n * 2048), h_ = *(const LAS bf16x8*)(lds + PG8_SB(b, h) + boff + n * 2048 + 1024); dst[n] = cat8(l_, h_); } } while (0)
#define PG8_MMA(ai, bj, At, Bt) do { __builtin_amdgcn_s_setprio(1); _Pragma("unroll") for (int m = 0; m < 4; ++m) _Pragma("unroll") for (int n = 0; n < 2; ++n) { \
        if constexpr (FP8) asm volatile("v_mfma_scale_f32_16x16x128_f8f6f4 %0, %1, %2, %0, %3, %4 op_sel_hi:[0,0,0]" : "+v"(acc[ai][bj][m][n]) : "v"(Bt[n]), "v"(At[m]), "v"(sc_w), "v"(sc_a)); \
        else { acc[ai][bj][m][n] = __builtin_amdgcn_mfma_f32_16x16x32_bf16(lo8(Bt[n]), lo8(At[m]), acc[ai][bj][m][n], 0, 0, 0); acc[ai][bj][m][n] = __builtin_amdgcn_mfma_f32_16x16x32_bf16(hi8(Bt[n]), hi8(At[m]), acc[ai][bj][m][n], 0, 0, 0); } } __builtin_amdgcn_s_setprio(0); } while (0)
#define PG8_WAIT_V(n) asm volatile("s_waitcnt vmcnt(" #n ")" ::: "memory")
#define PG8_WAIT_L(n) asm volatile("s_waitcnt lgkmcnt(" #n ")" ::: "memory")
#define PG8_BAR __builtin_amdgcn_s_barrier()
#define PG8_SCHED __builtin_amdgcn_sched_barrier(0)
    Unit cur, nxt; int ui = 0;
    if (!S.next(0, cur)) return;
    f32x4 acc[2][2][4][2];
#pragma unroll
    for (int a = 0; a < 2; ++a)
#pragma unroll
        for (int b = 0; b < 2; ++b)
#pragma unroll
            for (int m = 0; m < 4; ++m)
#pragma unroll
                for (int n = 0; n < 2; ++n) acc[a][b][m][n] = (f32x4){0.f, 0.f, 0.f, 0.f};
    v8i_t At[4], B0[2], B1[2];
    int sc_w = E.scale_w, sc_a = E.scale_a;
#define PG8_ABASE(u) ((const char*)((u).seg ? g.A1 + (size_t)(u).z * g.zA1 : g.A + (size_t)(u).z * g.zA) + (size_t)(u).pm * tstepA)
#define PG8_BBASE(u) ((const char*)((u).seg ? g.Bt1 + (size_t)(u).z * g.zB1 : g.Bt + (size_t)(u).z * g.zB) + (size_t)(u).pn * tstepB)
    const char* cA = PG8_ABASE(cur); const char* cB = PG8_BBASE(cur);
    PG8_STAGE(PG8_SB(0, 0), cB, voffB); PG8_STAGE(PG8_SB(0, 1), cB + hstepB, voffB); PG8_STAGE(PG8_SA(0, 0), cA, voffA); PG8_STAGE(PG8_SA(0, 1), cA + hstepA, voffA);
    if (wr == 1) PG8_BAR;
    PG8_WAIT_V(2); PG8_BAR;
    PG8_STAGE(PG8_SB(1, 0), cB + kstep, voffB); PG8_STAGE(PG8_SA(1, 0), cA + kstep, voffA); PG8_STAGE(PG8_SB(1, 1), cB + hstepB + kstep, voffB);
    PG8_WAIT_V(6); PG8_BAR;
    for (;;) {
        const bool has_next = S.next(ui + 1, nxt);
        const char* nA = has_next ? PG8_ABASE(nxt) : cA; const char* nB = has_next ? PG8_BBASE(nxt) : cB;
        for (int t = 0; t < nt; t += 2) {
            const bool last = (t == nt - 2);
            const char* a1 = cA + (size_t)(t + 1) * kstep;
            const char* a2 = last ? nA : cA + (size_t)(t + 2) * kstep; const char* b2 = last ? nB : cB + (size_t)(t + 2) * kstep;
            const char* a3 = a2 + kstep; const char* b3 = b2 + kstep;
            PG8_LDB(B0, 0, 0); PG8_LDB(B1, 0, 1); PG8_SCHED; PG8_LDA(At, 0, 0); PG8_STAGE(PG8_SA(1, 1), a1 + hstepA, voffA);
            PG8_WAIT_V(8); PG8_WAIT_L(0); PG8_BAR; PG8_MMA(0, 0, At, B0); PG8_MMA(0, 1, At, B1); PG8_BAR; PG8_SCHED;
            PG8_LDA(At, 0, 1); PG8_STAGE(PG8_SB(0, 0), b2, voffB); PG8_STAGE(PG8_SB(0, 1), b2 + hstepB, voffB); PG8_STAGE(PG8_SA(0, 0), a2, voffA);
            PG8_WAIT_V(8); PG8_WAIT_L(0); PG8_BAR; PG8_MMA(1, 0, At, B0); PG8_MMA(1, 1, At, B1); PG8_BAR; PG8_SCHED;
            PG8_LDB(B0, 1, 0); PG8_LDB(B1, 1, 1); PG8_SCHED; PG8_LDA(At, 1, 0); PG8_STAGE(PG8_SA(0, 1), a2 + hstepA, voffA);
            PG8_WAIT_V(8); PG8_WAIT_L(0); PG8_BAR; PG8_MMA(0, 0, At, B0); PG8_MMA(0, 1, At, B1); PG8_BAR; PG8_SCHED;
            PG8_LDA(At, 1, 1); PG8_STAGE(PG8_SB(1, 0), b3, voffB); PG8_STAGE(PG8_SB(1, 1), b3 + hstepB, voffB); PG8_STAGE(PG8_SA(1, 0), a3, voffA);
            PG8_WAIT_V(8); PG8_WAIT_L(0); PG8_BAR; PG8_MMA(1, 0, At, B0); PG8_MMA(1, 1, At, B1); PG8_BAR; PG8_SCHED;
        }
        if (wr == 0) PG8_BAR;
        if constexpr (FP8) asm volatile("s_nop 15\n\ts_nop 15" ::: "memory");
        E(acc, cur, wr, wc, fr, fq);
        if (!has_next) break;
#pragma unroll
        for (int a = 0; a < 2; ++a)
#pragma unroll
            for (int b = 0; b < 2; ++b)
#pragma unroll
                for (int m = 0; m < 4; ++m)
#pragma unroll
                    for (int n = 0; n < 2; ++n) acc[a][b][m][n] = (f32x4){0.f, 0.f, 0.f, 0.f};
        cur = nxt; cA = nA; cB = nB; ++ui;
        if (wr == 1) PG8_BAR;
    }
    PG8_WAIT_V(0);
    PG8_BAR;
#undef PG8_ABASE
#undef PG8_BBASE
#undef PG8_SA
#undef PG8_SB
#undef PG8_STAGE
#undef PG8_LDA
#undef PG8_LDB
#undef PG8_MMA
#undef PG8_WAIT_V
#undef PG8_WAIT_L
#undef PG8_BAR
#undef PG8_SCHED
}
}

#define XB_TMO      128
#define XB_XCNT(j)  (256  + 64 * (j))
#define XB_XSUB(j)  (1280 + 64 * (j))
#define XB_XGEN(j)  (2304 + 64 * (j))
#define XB_TOP      3328
#define XB_TOPGEN   3392
#define XCD_BAR_WORDS 3456
#define XB_SPIN_CAP (1u << 18)
__device__ __forceinline__ unsigned xb_ld(unsigned* p)              { return __hip_atomic_load(p, __ATOMIC_RELAXED, __HIP_MEMORY_SCOPE_AGENT); }
__device__ __forceinline__ unsigned xb_add(unsigned* p, unsigned v) { return __hip_atomic_fetch_add(p, v, __ATOMIC_RELAXED, __HIP_MEMORY_SCOPE_AGENT); }
__device__ __forceinline__ unsigned xb_xcc_id() { return (unsigned)__builtin_amdgcn_s_getreg((3 << 11) | 20) & 0xFu; }
#define XB_SPIN(cond, bar) do { unsigned _sp = 0; while (cond) { __builtin_amdgcn_s_sleep(1); \
    if ((++_sp & 255u) == 0u) { if (xb_ld(&(bar)[XB_TMO])) break; if (_sp > XB_SPIN_CAP) { atomicAdd(&(bar)[XB_TMO], 1u); break; } } } } while (0)
struct XcdBarrier { unsigned* bar; unsigned x; volatile LAS unsigned* st; int wave; };
__device__ __forceinline__ XcdBarrier xcd_barrier_post(unsigned* bar, volatile LAS unsigned* st) {
    XcdBarrier b; b.bar = bar; b.x = xb_xcc_id(); b.st = st;
    if (threadIdx.x == 0) (void)xb_add(&bar[XB_XCNT(b.x)], 1u);
    return b;
}
__device__ __forceinline__ void xcd_barrier_complete(unsigned* bar, unsigned x, unsigned& nloc, unsigned& nx) {
    const unsigned G = gridDim.x * gridDim.y * gridDim.z;
    unsigned sum, cnt, mine, sp = 0u;
    for (;;) {
        sum = 0u; cnt = 0u; mine = 0u;
#pragma unroll
        for (unsigned j = 0; j < 16; ++j) { const unsigned c = xb_ld(&bar[XB_XCNT(j)]); sum += c; cnt += (c > 0u) ? 1u : 0u; mine = (j == x) ? c : mine; }
        if (sum == G) break;
        __builtin_amdgcn_s_sleep(1);
        if ((++sp & 255u) == 0u) { if (xb_ld(&bar[XB_TMO])) break; if (sp > XB_SPIN_CAP) { atomicAdd(&bar[XB_TMO], 1u); break; } }
    }
    nloc = mine > 0u ? mine : 1u; nx = cnt > 0u ? cnt : 1u;
}
__device__ __forceinline__ void xcd_barrier(const XcdBarrier& b) {
    asm volatile("s_waitcnt vmcnt(0)" ::: "memory");
    __syncthreads();
    if (b.wave == 0 && __builtin_amdgcn_mbcnt_hi(~0u, __builtin_amdgcn_mbcnt_lo(~0u, 0u)) == 0u) {
        unsigned* bar = b.bar;
        __builtin_amdgcn_s_waitcnt(0);
        unsigned nloc = b.st[0], nx = b.st[1];
        if (nloc == 0u) { xcd_barrier_complete(bar, b.x, nloc, nx); b.st[0] = nloc; b.st[1] = nx; }
        const unsigned old = xb_add(&bar[XB_XSUB(b.x)], 1u);
        const unsigned gen = old / nloc;
        if (old + 1u == (gen + 1u) * nloc) {
            __builtin_amdgcn_fence(__ATOMIC_RELEASE, "agent");
            asm volatile("s_waitcnt vmcnt(0)" ::: "memory");
            const unsigned og = xb_add(&bar[XB_TOP], 1u);
            const unsigned tg = og / nx;
            if (og + 1u == (tg + 1u) * nx) xb_add(&bar[XB_TOPGEN], 1u);
            else XB_SPIN(xb_ld(&bar[XB_TOPGEN]) == tg, bar);
            __builtin_amdgcn_fence(__ATOMIC_ACQUIRE, "agent");
            xb_add(&bar[XB_XGEN(b.x)], 1u);
            asm volatile("s_waitcnt vmcnt(0)" ::: "memory");
        } else {
            XB_SPIN(xb_ld(&bar[XB_XGEN(b.x)]) == gen, bar);
            __builtin_amdgcn_fence(__ATOMIC_ACQUIRE, "agent");
            asm volatile("s_waitcnt vmcnt(0)" ::: "memory");
        }
    }
    __syncthreads();
}

#ifndef DSA_XREP
#define DSA_XREP 0
#define DSA_XF 0
#endif
#ifndef DSA_REP_P1
#define DSA_REP_P1 1
#endif
#ifndef DSA_REP_P2
#define DSA_REP_P2 1
#endif
#ifndef DSA_REP_ATT
#define DSA_REP_ATT 1
#endif
__device__ __forceinline__ int opaque_int(int n) { asm volatile("" : "+s"(n)); return n; }
__device__ __forceinline__ int ph_reps(int k) { int n = ((REP_MASK >> k) & 1u) ? REP_N : 1; asm volatile("" : "+s"(n)); return n; }
struct Args { const float* in[26]; float* out; unsigned char* ws; int ph_lo, ph_hi; };
enum { I_X = 0, I_C, I_ADAW, I_ADAB, I_NORMG, I_WG, I_WU, I_WDN, I_ABWIN, I_LRE, I_LIM, I_LOGDT, I_BRE, I_BIM, I_CRE, I_CIM, I_S5D, I_WGLU, I_BGLU, I_KVG, I_WKVUP, I_ABWOUT,
       I_CWQKV, I_RELB, I_CWOUT, I_FING };

__device__ __forceinline__ void tr_item(const float* src, int ldsrc, int nvalid, int k0, int n0, bf16* dst, int lddst, LAS float* scr, int lane) {
    const int nn = n0 + (lane & 31); const bool ok = nn < nvalid;
#pragma unroll 8
    for (int i = 0; i < 32; ++i) { const int kk = 2 * i + (lane >> 5); scr[kk * 33 + (lane & 31)] = ok ? src[(size_t)(k0 + kk) * ldsrc + nn] : 0.f; }
    LDS_WAIT(); asm volatile("" ::: "memory");
    const int c = lane & 7;
#pragma unroll
    for (int j = 0; j < 4; ++j) { const int n = (lane >> 3) + 8 * j; const LAS float* s = scr + (8 * c) * 33 + n;
        u32x4 o; o.x = pk2(s[0 * 33], s[1 * 33]); o.y = pk2(s[2 * 33], s[3 * 33]); o.z = pk2(s[4 * 33], s[5 * 33]); o.w = pk2(s[6 * 33], s[7 * 33]);
        if (n0 + n < nvalid) *(u32x4*)(dst + (size_t)n * lddst + 8 * c) = o; }
    LDS_WAIT(); asm volatile("" ::: "memory");
}

__device__ __forceinline__ void tr_item8(const float* src, int ldsrc, int k0, int n0, unsigned char* dst, int lddst, float scale, LAS float* scr, int lane) {
    const int nn = n0 + (lane & 31);
#pragma unroll 8
    for (int i = 0; i < 32; ++i) { const int kk = 2 * i + (lane >> 5); scr[kk * 33 + (lane & 31)] = src[(size_t)(k0 + kk) * ldsrc + nn] * scale; }
    LDS_WAIT(); asm volatile("" ::: "memory");
    const int n = lane & 31, kh = lane >> 5; const LAS float* sp = scr + (32 * kh) * 33 + n;
    u32x4 o0, o1;
    o0.x = pk4_fp8(sp[0 * 33], sp[1 * 33], sp[2 * 33], sp[3 * 33]); o0.y = pk4_fp8(sp[4 * 33], sp[5 * 33], sp[6 * 33], sp[7 * 33]);
    o0.z = pk4_fp8(sp[8 * 33], sp[9 * 33], sp[10 * 33], sp[11 * 33]); o0.w = pk4_fp8(sp[12 * 33], sp[13 * 33], sp[14 * 33], sp[15 * 33]);
    o1.x = pk4_fp8(sp[16 * 33], sp[17 * 33], sp[18 * 33], sp[19 * 33]); o1.y = pk4_fp8(sp[20 * 33], sp[21 * 33], sp[22 * 33], sp[23 * 33]);
    o1.z = pk4_fp8(sp[24 * 33], sp[25 * 33], sp[26 * 33], sp[27 * 33]); o1.w = pk4_fp8(sp[28 * 33], sp[29 * 33], sp[30 * 33], sp[31 * 33]);
    unsigned char* d = dst + (size_t)n * lddst + 32 * kh;
    *(u32x4*)d = o0; *(u32x4*)(d + 16) = o1;
    LDS_WAIT(); asm volatile("" ::: "memory");
}

__device__ __forceinline__ void p0_prologue(const Args& a, LAS unsigned char* lds, int G, int wave_s) {
    int lane_o = (int)__builtin_amdgcn_mbcnt_hi(~0u, __builtin_amdgcn_mbcnt_lo(~0u, 0u)); asm volatile("" : "+v"(lane_o)); const int lane = lane_o, wave = wave_s, tid_o = wave_s * 64 + lane_o;
    unsigned char* ws = a.ws;
    const int tid = tid_o;
    {
        LAS float* cond = (LAS float*)(lds + 131072); LAS float* red = (LAS float*)(lds + 131072 + 8192);
        for (int k = tid; k < DM; k += NTHR) cond[k] = silu_f(a.in[I_C][k]);
        __syncthreads();
        float* mod = (float*)(ws + WS_MOD);
        for (int u = blockIdx.x; u < 288; u += G) {
            const int layer = u / 144, col0 = (u % 144) * 128 + 2 * lane;
            const float* w = a.in[I_ADAW] + (size_t)layer * DM * NMOD + (size_t)(wave * 256) * NMOD + col0;
            float s0 = 0.f, s1 = 0.f;
#pragma unroll 8
            for (int k = 0; k < 256; ++k) { const f32x2 v = *(const f32x2*)(w + (size_t)k * NMOD); const float cv = cond[wave * 256 + k]; s0 += cv * v.x; s1 += cv * v.y; }
            red[wave * 128 + 2 * lane] = s0; red[wave * 128 + 2 * lane + 1] = s1;
            __syncthreads();
            if (tid < 128) { float s = 0.f;
#pragma unroll
                for (int w8 = 0; w8 < 8; ++w8) s += red[w8 * 128 + tid];
                const int n = (u % 144) * 128 + tid; mod[layer * NMOD + n] = s + a.in[I_ADAB][layer * NMOD + n]; }
            __syncthreads();
        }
    }
    LAS float* scr = (LAS float*)(lds + wave * 16384);
    const int gw = blockIdx.x * NWAVES + wave, NGW = G * NWAVES;
    unsigned char* Wgu = ws + WS_WGU; unsigned char* Wd = ws + WS_WD; bf16* Win = (bf16*)(ws + WS_WIN); bf16* Wglu = (bf16*)(ws + WS_WGLU);
    bf16* Wout = (bf16*)(ws + WS_WOUT); bf16* Woutb = (bf16*)(ws + WS_WOUTB); bf16* Wqkv = (bf16*)(ws + WS_WQKV); bf16* Wcout = (bf16*)(ws + WS_WCOUT);
    constexpr int I_FFN = 4 * 3 * 5504, I_IN = 32 * 107, I_GLU = 16 * 32, I_OUT = 32 * 64, I_QKV = 32 * 192, I_CO = 32 * 64;
    constexpr int NITEMS = I_FFN + I_IN + I_GLU + I_OUT + I_QKV + I_CO;
    for (int it = gw; it < NITEMS; it += NGW) {
        int r = it;
        if (r < I_FFN) {
            const int f = r / 16512, rr = r % 16512, which = rr / 5504, q = rr % 5504;
            if (which < 2) { const int kb = q / 172, nb = q % 172, n0 = 32 * nb, k0 = 64 * kb;
                const float* src = a.in[which ? I_WU : I_WG] + (size_t)f * DM * FF;
                const int row = 256 * (n0 / 128) + (n0 % 128) + 128 * which;
                tr_item8(src, FF, k0, n0, Wgu + (size_t)f * NGU * DM + (size_t)row * DM + k0, DM, 64.0f, scr, lane);
            } else { const int kb = q / 64, nb = q % 64, n0 = 32 * nb, k0 = 64 * kb;
                const float* src = a.in[I_WDN] + (size_t)f * FF * DM;
                tr_item8(src, DM, k0, n0, Wd + (size_t)f * DM * FFP + (size_t)n0 * FFP + k0, FFP, 128.0f, scr, lane); }
            continue; }
        r -= I_FFN;
        if (r < I_IN) { const int kb = r / 107, nb = r % 107, n0 = 32 * nb, k0 = 64 * kb;
            if (n0 >= 1024 && n0 < 2048) continue;
            const int row = n0 + (n0 >= 2048 ? 1024 : 0);
            tr_item(a.in[I_ABWIN], 3408, 3408, k0, n0, Win + (size_t)row * DM + k0, DM, scr, lane); continue; }
        r -= I_IN;
        if (r < I_GLU) { const int kb = r / 32, nb = r % 32, n0 = 32 * nb, k0 = 64 * kb;
            tr_item(a.in[I_WGLU], 1024, 1024, k0, n0, Wglu + (size_t)n0 * 1024 + k0, 1024, scr, lane); continue; }
        r -= I_GLU;
        if (r < I_OUT) { const int kb = r / 64, nb = r % 64, n0 = 32 * nb, k0 = 64 * kb;
            if (k0 < 1024) tr_item(a.in[I_ABWOUT], DM, DM, k0, n0, Wout + (size_t)n0 * NCAT + k0, NCAT, scr, lane);
            else           tr_item(a.in[I_ABWOUT], DM, DM, k0, n0, Woutb + (size_t)n0 * DM + k0, DM, scr, lane);
            continue; }
        r -= I_OUT;
        if (r < I_QKV) { const int kb = r / 192, nb = r % 192, n0 = 32 * nb, k0 = 64 * kb;
            tr_item(a.in[I_CWQKV], 6144, 6144, k0, n0, Wqkv + (size_t)n0 * DM + k0, DM, scr, lane); continue; }
        r -= I_QKV;
        { const int kb = r / 64, nb = r % 64, n0 = 32 * nb, k0 = 64 * kb;
            tr_item(a.in[I_CWOUT], DM, DM, k0, n0, Wcout + (size_t)n0 * DM + k0, DM, scr, lane); }
    }
    {
        const int gt = blockIdx.x * NTHR + tid, NGT = G * NTHR;
        bf16* Wqraw = (bf16*)(ws + WS_WQRAW); bf16* Wupraw = (bf16*)(ws + WS_WUPRAW);
        for (int i = gt; i < 2048 * 256; i += NGT) { const int k = i >> 8, d4 = (i & 255) * 4; const f32x4 v = *(const f32x4*)(a.in[I_ABWIN] + (size_t)k * 3408 + 1024 + d4);
            u32x2 o; o.x = pk2(v.x, v.y); o.y = pk2(v.z, v.w); *(u32x2*)(Wqraw + (size_t)k * DM + d4) = o; }
        for (int i = gt; i < 256 * 512; i += NGT) { const f32x4 v = *(const f32x4*)(a.in[I_WKVUP] + (size_t)i * 4);
            u32x2 o; o.x = pk2(v.x, v.y); o.y = pk2(v.z, v.w); *(u32x2*)(Wupraw + (size_t)i * 4) = o; }
        for (int i = gt; i < (NIN - 4432) * DM / 8; i += NGT) *(u32x4*)(Win + (size_t)4432 * DM + (size_t)i * 8) = (u32x4){0u, 0u, 0u, 0u};
        for (int i = gt; i < 4 * DM * 8; i += NGT) *(u32x4*)(Wd + (size_t)(i >> 3) * FFP + FF + 16 * (i & 7)) = (u32x4){0u, 0u, 0u, 0u};
        for (int i = gt; i < SEQ * 8; i += NGT) *(u32x4*)(ws + WS_HMID + (size_t)(i >> 3) * FFP + FF + 16 * (i & 7)) = (u32x4){0u, 0u, 0u, 0u};
        if (gt < 4096) { const int g = gt >> 6;
            const double dt = exp((double)a.in[I_LOGDT][g]); const double lr = a.in[I_LRE][gt], li = a.in[I_LIM][gt];
            const double mag = exp(lr * dt), ar = mag * cos(li * dt), ai = mag * sin(li * dt);
            const double den = lr * lr + li * li, nr = ar - 1.0, fre = (nr * lr + ai * li) / den, fim = (ai * lr - nr * li) / den;
            const double m64 = exp(64.0 * lr * dt), a64r = m64 * cos(64.0 * li * dt), a64i = m64 * sin(64.0 * li * dt);
            float* T = (float*)(ws + WS_S5T);
            T[S5_AR + gt] = (float)ar; T[S5_AI + gt] = (float)ai; T[S5_A64R + gt] = (float)a64r; T[S5_A64I + gt] = (float)a64i;
            for (int c = 0; c < 16; ++c) { const double br = a.in[I_BRE][gt * 16 + c], bi = a.in[I_BIM][gt * 16 + c];
                T[S5_BBR + gt * 16 + c] = (float)(fre * br - fim * bi); T[S5_BBI + gt * 16 + c] = (float)(fre * bi + fim * br); }
        }
    }
}

template <bool FINAL, bool OUT8 = false>
__device__ __forceinline__ void norm_phase(const float* hin, const float* gvec, const float* shift, const float* scale, bf16* hn, float* fout, int G, int wave_s) {
    int lane_o = (int)__builtin_amdgcn_mbcnt_hi(~0u, __builtin_amdgcn_mbcnt_lo(~0u, 0u)); asm volatile("" : "+v"(lane_o)); const int lane = lane_o, wave = wave_s, tid_o = wave_s * 64 + lane_o;
    const int gw = blockIdx.x * NWAVES + wave, NGW = G * NWAVES;
    f32x4 gs[8], sh[8];
#pragma unroll
    for (int j = 0; j < 8; ++j) { const int c = 4 * lane + 256 * j; const f32x4 gg = *(const f32x4*)(gvec + c);
        if (FINAL) { gs[j] = gg; sh[j] = (f32x4){0.f, 0.f, 0.f, 0.f}; }
        else { const f32x4 sc = *(const f32x4*)(scale + c); gs[j] = gg * (sc + 1.0f); sh[j] = *(const f32x4*)(shift + c); } }
    for (int m = gw; m < SEQ; m += NGW) {
        const f32x4* xr = (const f32x4*)(hin + (size_t)m * DM) + lane;
        f32x4 v[8]; float s = 0.f;
#pragma unroll
        for (int j = 0; j < 8; ++j) { v[j] = xr[64 * j]; s += (v[j].x * v[j].x + v[j].y * v[j].y) + (v[j].z * v[j].z + v[j].w * v[j].w); }
        const float rstd = 1.0f / sqrtf(wave_sum(s) * (1.0f / DM) + 1e-6f);
        if (FINAL) { f32x4* o = (f32x4*)(fout + (size_t)m * DM) + lane;
#pragma unroll
            for (int j = 0; j < 8; ++j) o[64 * j] = v[j] * rstd * gs[j];
        } else if (OUT8) { unsigned* o = (unsigned*)((unsigned char*)hn + (size_t)m * DM) + lane;
#pragma unroll
            for (int j = 0; j < 8; ++j) { const f32x4 y = (v[j] * rstd * gs[j] + sh[j]) * 8.0f; o[64 * j] = pk4_fp8(y.x, y.y, y.z, y.w); }
        } else { u32x2* o = (u32x2*)(hn + (size_t)m * DM) + lane;
#pragma unroll
            for (int j = 0; j < 8; ++j) { const f32x4 y = v[j] * rstd * gs[j] + sh[j]; u32x2 w; w.x = pk2(y.x, y.y); w.y = pk2(y.z, y.w); o[64 * j] = w; } }
    }
}

__device__ __forceinline__ void s5_stage_u(const bf16* proj, int g, int j, LAS float* ut, int lane) {
    const u32x4* p = (const u32x4*)(proj + (size_t)(64 * j + lane) * NIN + C_U + 16 * g);
    const u32x4 a = p[0], b = p[1];
    LAS f32x4* o = (LAS f32x4*)(ut + lane * 16);
    o[0] = (f32x4){bflo(a.x), bfhi(a.x), bflo(a.y), bfhi(a.y)}; o[1] = (f32x4){bflo(a.z), bfhi(a.z), bflo(a.w), bfhi(a.w)};
    o[2] = (f32x4){bflo(b.x), bfhi(b.x), bflo(b.y), bfhi(b.y)}; o[3] = (f32x4){bflo(b.z), bfhi(b.z), bflo(b.w), bfhi(b.w)};
    LDS_WAIT(); asm volatile("" ::: "memory");
}
__device__ __forceinline__ void phase_a2(const Args& a, LAS unsigned char* lds, int G, int wave_s) {
    int lane_o = (int)__builtin_amdgcn_mbcnt_hi(~0u, __builtin_amdgcn_mbcnt_lo(~0u, 0u)); asm volatile("" : "+v"(lane_o)); const int lane = lane_o, wave = wave_s, tid_o = wave_s * 64 + lane_o;
    unsigned char* ws = a.ws; const bf16* proj = (const bf16*)(ws + WS_PROJ);
    const int gw = blockIdx.x * NWAVES + wave, NGW = G * NWAVES;
    { bf16* kvn = (bf16*)(ws + WS_KVN); const f32x4 gg = *(const f32x4*)(a.in[I_KVG] + 4 * lane);
      for (int m = gw; m < SEQ; m += NGW) { const u32x2 w = *(const u32x2*)(proj + (size_t)m * NIN + C_KVL + 4 * lane);
          const f32x4 v = (f32x4){bflo(w.x), bfhi(w.x), bflo(w.y), bfhi(w.y)};
          const float s = wave_sum((v.x * v.x + v.y * v.y) + (v.z * v.z + v.w * v.w)); const float rstd = 1.0f / sqrtf(s * (1.0f / 256.0f) + 1e-6f);
          const f32x4 y = v * rstd * gg; u32x2 o; o.x = pk2(y.x, y.y); o.y = pk2(y.z, y.w); *(u32x2*)(kvn + (size_t)m * 256 + 4 * lane) = o; } }
    const float* T = (const float*)(ws + WS_S5T); float* E = (float*)(ws + WS_E);
    LAS float* ut = (LAS float*)(lds + wave * 8192);
    for (int u = gw; u < 64 * 128; u += NGW) { const int g = u & 63, j = u >> 6, sp = g * 64 + lane;
        s5_stage_u(proj, g, j, ut, lane);
        const float ar = T[S5_AR + sp], ai = T[S5_AI + sp];
        float bbr[16], bbi[16];
#pragma unroll
        for (int c4 = 0; c4 < 4; ++c4) { const f32x4 r = *(const f32x4*)(T + S5_BBR + sp * 16 + 4 * c4), i = *(const f32x4*)(T + S5_BBI + sp * 16 + 4 * c4);
            bbr[4 * c4] = r.x; bbr[4 * c4 + 1] = r.y; bbr[4 * c4 + 2] = r.z; bbr[4 * c4 + 3] = r.w; bbi[4 * c4] = i.x; bbi[4 * c4 + 1] = i.y; bbi[4 * c4 + 2] = i.z; bbi[4 * c4 + 3] = i.w; }
        float xr = 0.f, xi = 0.f;
        for (int t = 0; t < 64; ++t) { const LAS f32x4* up = (const LAS f32x4*)(ut + t * 16); float bur = 0.f, bui = 0.f;
#pragma unroll
            for (int c4 = 0; c4 < 4; ++c4) { const f32x4 uv = up[c4];
                bur += bbr[4 * c4] * uv.x + bbr[4 * c4 + 1] * uv.y + bbr[4 * c4 + 2] * uv.z + bbr[4 * c4 + 3] * uv.w;
                bui += bbi[4 * c4] * uv.x + bbi[4 * c4 + 1] * uv.y + bbi[4 * c4 + 2] * uv.z + bbi[4 * c4 + 3] * uv.w; }
            const float nr = ar * xr - ai * xi + bur, ni = ar * xi + ai * xr + bui; xr = nr; xi = ni; }
        E[(size_t)(g * 128 + j) * 64 + lane] = xr; E[(size_t)(64 * 128 * 64) + (size_t)(g * 128 + j) * 64 + lane] = xi;
        LDS_WAIT(); asm volatile("" ::: "memory");
    }
}

__device__ __forceinline__ void s5_scan_out(const Args& a, LAS unsigned char* lds, int G, int wave_s) {
    int lane_o = (int)__builtin_amdgcn_mbcnt_hi(~0u, __builtin_amdgcn_mbcnt_lo(~0u, 0u)); asm volatile("" : "+v"(lane_o)); const int lane = lane_o, wave = wave_s, tid_o = wave_s * 64 + lane_o;
    unsigned char* ws = a.ws; const bf16* proj = (const bf16*)(ws + WS_PROJ);
    const int gw = blockIdx.x * NWAVES + wave, NGW = G * NWAVES;
    const float* T = (const float*)(ws + WS_S5T); const float* E = (const float*)(ws + WS_E); bf16* yap = (bf16*)(ws + WS_YAPRE);
    LAS float* ut = (LAS float*)(lds + wave * 16384);
    LAS unsigned char* X = lds + wave * 16384 + 4096;
    const int fr = lane & 15, fq = lane >> 4;
    for (int u = gw; u < 64 * 128; u += NGW) { const int g = u & 63, j = u >> 6, sp = g * 64 + lane;
        s5_stage_u(proj, g, j, ut, lane);
        const float ar = T[S5_AR + sp], ai = T[S5_AI + sp], a64r = T[S5_A64R + sp], a64i = T[S5_A64I + sp];
        float bbr[16], bbi[16];
#pragma unroll
        for (int c4 = 0; c4 < 4; ++c4) { const f32x4 r = *(const f32x4*)(T + S5_BBR + sp * 16 + 4 * c4), i = *(const f32x4*)(T + S5_BBI + sp * 16 + 4 * c4);
            bbr[4 * c4] = r.x; bbr[4 * c4 + 1] = r.y; bbr[4 * c4 + 2] = r.z; bbr[4 * c4 + 3] = r.w; bbi[4 * c4] = i.x; bbi[4 * c4 + 1] = i.y; bbi[4 * c4 + 2] = i.z; bbi[4 * c4 + 3] = i.w; }
        bf16x8 cf[4];
#pragma unroll
        for (int ks = 0; ks < 4; ++ks) { const int k0 = 32 * ks + 8 * fq; const bool im = k0 >= 64; const float* src = a.in[im ? I_CIM : I_CRE] + (size_t)(g * 16 + fr) * 64 + (k0 & 63);
            const f32x4 v0 = *(const f32x4*)src, v1 = *(const f32x4*)(src + 4); const float sg = im ? -1.f : 1.f;
            u32x4 w; w.x = pk2(sg * v0.x, sg * v0.y); w.y = pk2(sg * v0.z, sg * v0.w); w.z = pk2(sg * v1.x, sg * v1.y); w.w = pk2(sg * v1.z, sg * v1.w);
            cf[ks] = __builtin_bit_cast(bf16x8, w); }
        const float dsk = a.in[I_S5D][g * 16 + fr];
        float xr = 0.f, xi = 0.f;
        for (int i = 0; i < j; ++i) { const float er = E[(size_t)(g * 128 + i) * 64 + lane], ei = E[(size_t)(64 * 128 * 64) + (size_t)(g * 128 + i) * 64 + lane];
            const float nr = a64r * xr - a64i * xi + er, ni = a64r * xi + a64i * xr + ei; xr = nr; xi = ni; }
        for (int tt = 0; tt < 4; ++tt) {
            for (int t16 = 0; t16 < 16; ++t16) { const LAS f32x4* up = (const LAS f32x4*)(ut + (16 * tt + t16) * 16); float bur = 0.f, bui = 0.f;
#pragma unroll
                for (int c4 = 0; c4 < 4; ++c4) { const f32x4 uv = up[c4];
                    bur += bbr[4 * c4] * uv.x + bbr[4 * c4 + 1] * uv.y + bbr[4 * c4 + 2] * uv.z + bbr[4 * c4 + 3] * uv.w;
                    bui += bbi[4 * c4] * uv.x + bbi[4 * c4 + 1] * uv.y + bbi[4 * c4 + 2] * uv.z + bbi[4 * c4 + 3] * uv.w; }
                const float nr = ar * xr - ai * xi + bur, ni = ar * xi + ai * xr + bui; xr = nr; xi = ni;
                *(LAS unsigned short*)(X + t16 * 272 + 2 * lane) = (unsigned short)f2bf(xr); *(LAS unsigned short*)(X + t16 * 272 + 128 + 2 * lane) = (unsigned short)f2bf(xi); }
            LDS_WAIT(); asm volatile("" ::: "memory");
            f32x4 acc = (f32x4){0.f, 0.f, 0.f, 0.f};
#pragma unroll
            for (int ks = 0; ks < 4; ++ks) { const bf16x8 af = *(const LAS bf16x8*)(X + fr * 272 + 64 * ks + 16 * fq); acc = __builtin_amdgcn_mfma_f32_16x16x32_bf16(af, cf[ks], acc, 0, 0, 0); }
#pragma unroll
            for (int r = 0; r < 4; ++r) { const int tl = 16 * tt + 4 * fq + r; const float y = acc[r] + dsk * ut[tl * 16 + fr];
                yap[(size_t)(64 * j + tl) * 1024 + 16 * g + fr] = (bf16)f2bf(gelu_tanh_f(y)); }
            LDS_WAIT(); asm volatile("" ::: "memory");
        }
    }
}

__device__ __forceinline__ void lds_add(LAS unsigned* p, unsigned v) { (void)__hip_atomic_fetch_add(p, v, __ATOMIC_RELAXED, __HIP_MEMORY_SCOPE_WORKGROUP); }
__device__ __forceinline__ unsigned ord_key(float s) { const unsigned u = __builtin_bit_cast(unsigned, s); return u ^ ((u >> 31) ? 0xFFFFFFFFu : 0x80000000u); }
template <int NB, bool PACKED>
__device__ __forceinline__ void hist_search(const LAS unsigned* hist, int field, unsigned need, int lane, int& bstar, unsigned& above) {
    constexpr int PER = NB / 64;
    const int sh = PACKED ? 16 * field : 0; const unsigned fm = PACKED ? 0xffffu : 0xffffffffu;
    unsigned tot = 0;
#pragma unroll 4
    for (int i = 0; i < PER; i += 4) { const u32x4 h = *(const LAS u32x4*)(hist + lane * PER + i); tot += ((h.x >> sh) & fm) + ((h.y >> sh) & fm) + ((h.z >> sh) & fm) + ((h.w >> sh) & fm); }
    unsigned incl = tot;
#pragma unroll
    for (int o = 1; o < 64; o <<= 1) { const unsigned v = __shfl_down(incl, o); if (lane + o < 64) incl += v; }
    const unsigned excl = incl - tot;
    const unsigned long long mask = __ballot(incl >= need);
    const int lstar = 63 - __builtin_clzll(mask | 1ull);
    unsigned cum = excl; int b = -1; unsigned ab = 0;
#pragma unroll 1
    for (int i = PER - 4; i >= 0; i -= 4) { const u32x4 h = *(const LAS u32x4*)(hist + lane * PER + i);
        const unsigned c3 = (h.w >> sh) & fm, c2 = (h.z >> sh) & fm, c1 = (h.y >> sh) & fm, c0 = (h.x >> sh) & fm;
        if (b < 0) { if (cum + c3 >= need) { b = lane * PER + i + 3; ab = cum; } else cum += c3; }
        if (b < 0) { if (cum + c2 >= need) { b = lane * PER + i + 2; ab = cum; } else cum += c2; }
        if (b < 0) { if (cum + c1 >= need) { b = lane * PER + i + 1; ab = cum; } else cum += c1; }
        if (b < 0) { if (cum + c0 >= need) { b = lane * PER + i + 0; ab = cum; } else cum += c0; } }
    bstar = __shfl(b, lstar); above = __shfl(ab, lstar);
}

template <int MODE, int XF = 0>
__device__ __forceinline__ void dsa_pass(const bf16* proj, LAS unsigned char* lds, LAS unsigned char* wl, int nadm, int tid, int lane, const bf16x8 (&qa)[4], const float (&wv)[16],
                                         unsigned myb, unsigned& ns0, unsigned& ns1, unsigned& nc0, unsigned& nc1) {
    const int l31 = lane & 31, hh = lane >> 5;
    LAS unsigned* hist = (LAS unsigned*)wl; LAS unsigned* cok = (LAS unsigned*)wl; LAS int* cix = (LAS int*)(wl + 4096); LAS int* sel = (LAS int*)(wl + 16896);
    const int skey = tid >> 3, ssub = tid & 7;
    const bf16* gsrc = proj + (size_t)skey * NIN + C_KI + 8 * ssub;
    const int sdst = ((skey >> 5) * 18944) + 8192 + (skey & 31) * 128 + ((ssub ^ (skey & 7)) * 16);
    const int nch = (nadm + 127) / 128;
#define DSA_LD(c_, r0_, r1_) do { const int cc_ = (c_) < nch ? (c_) : nch - 1; r0_ = *(const u32x4*)(gsrc + (size_t)(128 * cc_) * NIN); r1_ = *(const u32x4*)(gsrc + (size_t)(128 * cc_ + 64) * NIN); } while (0)
    u32x4 stg0, stg1, sA0, sA1, sB0, sB1, sC0, sC1;
    DSA_LD(0, stg0, stg1); DSA_LD(1, sA0, sA1); DSA_LD(2, sB0, sB1); DSA_LD(3, sC0, sC1);
    if (!(XF & 2)) { *(LAS u32x4*)(lds + sdst) = stg0; *(LAS u32x4*)(lds + sdst + 2 * 18944) = stg1; }
    __syncthreads();
    for (int ch = 0; ch < nch; ++ch) {
        if (!(XF & 2)) { stg0 = sA0; stg1 = sA1; sA0 = sB0; sA1 = sB1; sB0 = sC0; sB1 = sC1; DSA_LD(ch + 4, sC0, sC1); }
#pragma unroll
        for (int tp = 0; tp < 2; ++tp) {
            if (128 * ch + 64 * tp < nadm) {
            const LAS unsigned char* tb0 = lds + ((ch & 1) * 4 + 2 * tp) * 18944 + 8192 + l31 * 128; const LAS unsigned char* tb1 = tb0 + 18944;
            f32x16 acc0, acc1;
#pragma unroll
            for (int i = 0; i < 16; ++i) { acc0[i] = 0.f; acc1[i] = 0.f; }
#pragma unroll
            for (int ks = 0; ks < 4; ++ks) { const int so = ((2 * ks + hh) ^ (l31 & 7)) * 16;
                const bf16x8 k0 = *(const LAS bf16x8*)(tb0 + so), k1 = *(const LAS bf16x8*)(tb1 + so);
                if (!(XF & 8)) { acc0 = __builtin_amdgcn_mfma_f32_32x32x16_bf16(qa[ks], k0, acc0, 0, 0, 0); acc1 = __builtin_amdgcn_mfma_f32_32x32x16_bf16(qa[ks], k1, acc1, 0, 0, 0); }
                else { acc0[ks] += __builtin_bit_cast(float, (int)k0[0] << 16); acc1[ks] += __builtin_bit_cast(float, (int)k1[0] << 16); } }
            float sa0 = 0.f, sa1 = 0.f, sb0 = 0.f, sb1 = 0.f;
#pragma unroll
            for (int i = 0; i < ((XF & 16) ? 2 : 16); i += 2) { sa0 += wv[i] * fmaxf(acc0[i], 0.f); sa1 += wv[i + 1] * fmaxf(acc0[i + 1], 0.f); sb0 += wv[i] * fmaxf(acc1[i], 0.f); sb1 += wv[i + 1] * fmaxf(acc1[i + 1], 0.f); }
            const float sc[2] = {sa0 + sa1, sb0 + sb1};
#pragma unroll
            for (int tl = 0; tl < 2; ++tl) {
                const unsigned ok = ord_key(sc[tl]), bin = ok >> 21;
                if (MODE == 1) lds_add(&hist[bin], 1u << (16 * hh));
                else if (MODE == 3) { if (!(XF & 1)) lds_add(&hist[bin], 0u); else asm volatile("" :: "v"(bin)); }
                else {
                    const int key = 128 * ch + 64 * tp + 32 * tl + l31;
                    const bool isel = bin > myb, icand = bin == myb;
                    const unsigned long long ms = __ballot(isel), mc = __ballot(icand);
                    const unsigned ms0 = (unsigned)ms, ms1 = (unsigned)(ms >> 32), mc0 = (unsigned)mc, mc1 = (unsigned)(mc >> 32);
                    const unsigned lowm = (1u << l31) - 1u;
                    const unsigned ps = (hh ? ns1 + (unsigned)__builtin_popcount(ms1 & lowm) : ns0 + (unsigned)__builtin_popcount(ms0 & lowm));
                    const unsigned pc = (hh ? nc1 + (unsigned)__builtin_popcount(mc1 & lowm) : nc0 + (unsigned)__builtin_popcount(mc0 & lowm));
                    if (isel && ps < 256u) sel[hh * 256 + ps] = key;
                    if (icand && pc < 512u) { cok[hh * 512 + pc] = ok; cix[hh * 512 + pc] = key; }
                    ns0 += (unsigned)__builtin_popcount(ms0); ns1 += (unsigned)__builtin_popcount(ms1); nc0 += (unsigned)__builtin_popcount(mc0); nc1 += (unsigned)__builtin_popcount(mc1);
                }
            }
            }
        }
        if (!(XF & 2) && ch + 1 < nch) { const int bo = ((ch + 1) & 1) * 4 * 18944; *(LAS u32x4*)(lds + sdst + bo) = stg0; *(LAS u32x4*)(lds + sdst + bo + 2 * 18944) = stg1; }
        if (!(XF & 4)) __syncthreads();
    }
    if (XF & 4) __syncthreads();
#undef DSA_LD
}

__device__ __forceinline__ void dsa_phase(const Args& a, LAS unsigned char* lds, int G, int wave_s) {
    int lane_o = (int)__builtin_amdgcn_mbcnt_hi(~0u, __builtin_amdgcn_mbcnt_lo(~0u, 0u)); asm volatile("" : "+v"(lane_o)); const int lane = lane_o, wave = wave_s, tid_o = wave_s * 64 + lane_o;
    unsigned char* ws = a.ws; const bf16* proj = (const bf16*)(ws + WS_PROJ); const bf16* kvn = (const bf16*)(ws + WS_KVN);
    bf16* ycat = (bf16*)(ws + WS_YCAT);
    constexpr int WREG = 18944;
    LAS unsigned char* wl = lds + wave * WREG;
    LAS unsigned* hist = (LAS unsigned*)wl; LAS int* sel = (LAS int*)(wl + 16896);
    const int l31 = lane & 31, hh = lane >> 5, fr = lane & 15, fq = lane >> 4;
    for (int un = blockIdx.x; un < 512; un += G) {
        __syncthreads();
        const int unit = (un < 256) ? un : 767 - un;
        const int t0 = unit * 16, tq = t0 + 2 * wave;
        const int nadm = ((t0 >> 6) + 1) * 64;
        if (nadm > 256) {
            bf16x8 qa[4];
            { const int r = l31, qq = (r >> 2) & 1, head = (r & 3) + 4 * (r >> 3);
              const bf16* qp = proj + (size_t)(tq + qq) * NIN + C_QI + head * 64 + 8 * hh;
#pragma unroll
              for (int ks = 0; ks < 4; ++ks) qa[ks] = *(const bf16x8*)(qp + 16 * ks); }
            float wv[16];
            { const u32x4 w0 = *(const u32x4*)(proj + (size_t)(tq + hh) * NIN + C_WI), w1 = *(const u32x4*)(proj + (size_t)(tq + hh) * NIN + C_WI + 8);
              const float sc = 1.0f / 32.0f;
              wv[0] = bflo(w0.x) * sc; wv[1] = bfhi(w0.x) * sc; wv[2] = bflo(w0.y) * sc; wv[3] = bfhi(w0.y) * sc; wv[4] = bflo(w0.z) * sc; wv[5] = bfhi(w0.z) * sc; wv[6] = bflo(w0.w) * sc; wv[7] = bfhi(w0.w) * sc;
              wv[8] = bflo(w1.x) * sc; wv[9] = bfhi(w1.x) * sc; wv[10] = bflo(w1.y) * sc; wv[11] = bfhi(w1.y) * sc; wv[12] = bflo(w1.z) * sc; wv[13] = bfhi(w1.z) * sc; wv[14] = bflo(w1.w) * sc; wv[15] = bfhi(w1.w) * sc; }
            unsigned ns0 = 0, ns1 = 0, nc0 = 0, nc1 = 0;
#if DSA_REP_P1 > 1
            for (int rp1 = 0, np1 = opaque_int(DSA_REP_P1); rp1 < np1; ++rp1)
#endif
            {
                for (int i = lane; i < 2048; i += 64) hist[i] = 0u;
                dsa_pass<1>(proj, lds, wl, nadm, tid_o, lane, qa, wv, 0u, ns0, ns1, nc0, nc1);
            }
#if DSA_XREP > 0
            for (int rx = 0, nx = opaque_int(DSA_XREP); rx < nx; ++rx) dsa_pass<3, DSA_XF>(proj, lds, wl, nadm, tid_o, lane, qa, wv, 0u, ns0, ns1, nc0, nc1);
#endif
            int b1[2]; unsigned ab1[2];
            hist_search<2048, true>(hist, 0, 256u, lane, b1[0], ab1[0]);
            hist_search<2048, true>(hist, 1, 256u, lane, b1[1], ab1[1]);
            asm volatile("" ::: "memory");
            LAS unsigned* cok = (LAS unsigned*)wl; LAS int* cix = (LAS int*)(wl + 4096);
            const unsigned myb = (unsigned)(hh ? b1[1] : b1[0]);
#if DSA_REP_P2 > 1
            for (int rp2 = 0, np2 = opaque_int(DSA_REP_P2); rp2 < np2; ++rp2)
#endif
            {
                ns0 = 0; ns1 = 0; nc0 = 0; nc1 = 0;
                dsa_pass<2>(proj, lds, wl, nadm, tid_o, lane, qa, wv, myb, ns0, ns1, nc0, nc1);
            }
            LDS_WAIT(); asm volatile("" ::: "memory");
#pragma unroll 1
            for (int qq = 0; qq < 2; ++qq) {
                const unsigned nsq = qq ? ns1 : ns0; unsigned C = qq ? nc1 : nc0; C = C > 512u ? 512u : C;
                const unsigned need = nsq < 256u ? 256u - nsq : 0u;
                const unsigned C4 = (C + 3u) & ~3u;
                for (unsigned i = C + lane; i < C4; i += 64) cok[qq * 512 + i] = 0u;
                LDS_WAIT(); asm volatile("" ::: "memory");
                for (unsigned i0 = 0; i0 < C; i0 += 64) {
                    const unsigned i = i0 + lane; const bool act = i < C;
                    const unsigned mk = act ? cok[qq * 512 + i] : 0u;
                    unsigned rank = 0;
                    for (unsigned j = 0; j < C4; j += 4) { const u32x4 o = *(const LAS u32x4*)(cok + qq * 512 + j);
                        rank += (o.x > mk || (o.x == mk && j + 0 < i)) ? 1u : 0u; rank += (o.y > mk || (o.y == mk && j + 1 < i)) ? 1u : 0u;
                        rank += (o.z > mk || (o.z == mk && j + 2 < i)) ? 1u : 0u; rank += (o.w > mk || (o.w == mk && j + 3 < i)) ? 1u : 0u; }
                    if (act && rank < need) sel[qq * 256 + nsq + rank] = cix[qq * 512 + i];
                }
                const unsigned filled = nsq + (need < C ? need : C);
                for (unsigned i = filled + lane; i < 256u; i += 64) sel[qq * 256 + i] = -1;
            }
            LDS_WAIT(); asm volatile("" ::: "memory");
        } else {
            for (int i = lane; i < 512; i += 64) { const int k = i & 255; sel[i] = k < nadm ? k : -1; }
            LDS_WAIT(); asm volatile("" ::: "memory");
        }
#pragma unroll 1
        for (int qq = 0; qq < 2 * DSA_REP_ATT; ++qq) {
            const int t = tq + (qq & 1); const int head = fr & 7;
            const float slope = fast_exp2(-(float)(head + 1));
            bf16x8 qf[8];
            { const bf16* qp = proj + (size_t)t * NIN + C_QT + head * 256 + 8 * fq;
#pragma unroll
              for (int ks = 0; ks < 8; ++ks) qf[ks] = *(const bf16x8*)(qp + 32 * ks); }
            f32x4 oacc[16];
#pragma unroll
            for (int i = 0; i < 16; ++i) oacc[i] = (f32x4){0.f, 0.f, 0.f, 0.f};
            float mrun = -1e30f, lrun = 0.f;
            for (int kt = 0; kt < 8; ++kt) {
                asm volatile("" ::: "memory");
#pragma unroll
                for (int i = 0; i < 16; ++i) { const int row = hh + 2 * i; int s = sel[(qq & 1) * 256 + 32 * kt + row]; s = s < 0 ? 0 : s;
                    const u32x4 v = *(const u32x4*)(kvn + (size_t)s * 256 + 8 * l31); *(LAS u32x4*)(wl + row * 528 + 16 * l31) = v; }
                LDS_WAIT(); asm volatile("" ::: "memory");
                f32x4 sacc[2];
#pragma unroll
                for (int sb = 0; sb < 2; ++sb) { f32x4 c4 = (f32x4){0.f, 0.f, 0.f, 0.f};
#pragma unroll
                    for (int ks = 0; ks < 8; ++ks) { const bf16x8 af = *(const LAS bf16x8*)(wl + (16 * sb + fr) * 528 + 64 * ks + 16 * fq); c4 = __builtin_amdgcn_mfma_f32_16x16x32_bf16(af, qf[ks], c4, 0, 0, 0); }
                    sacc[sb] = c4; }
                float lg[8]; float mx = -1e30f;
#pragma unroll
                for (int sb = 0; sb < 2; ++sb) { const LAS int* sp = sel + (qq & 1) * 256 + 32 * kt + 16 * sb + 4 * fq;
#pragma unroll
                    for (int r = 0; r < 4; ++r) { const int s = sp[r]; const float d = (float)(t - s); float v = sacc[sb][r] - slope * fabsf(d); v = s < 0 ? -1e30f : v; lg[4 * sb + r] = v; mx = fmaxf(mx, v); } }
                mx = fmaxf(mx, __shfl_xor(mx, 16)); mx = fmaxf(mx, __shfl_xor(mx, 32));
                const float mnew = fmaxf(mrun, mx); const float alpha = fast_exp2((mrun - mnew) * 1.4426950408889634f);
                float ps = 0.f; float p[8];
#pragma unroll
                for (int i = 0; i < 8; ++i) { p[i] = lg[i] <= -1e29f ? 0.f : fast_exp2((lg[i] - mnew) * 1.4426950408889634f); ps += p[i]; }
                lrun = lrun * alpha + ps; mrun = mnew;
#pragma unroll
                for (int i = 0; i < 16; ++i) oacc[i] = oacc[i] * alpha;
                u32x4 pw; pw.x = pk2(p[0], p[1]); pw.y = pk2(p[2], p[3]); pw.z = pk2(p[4], p[5]); pw.w = pk2(p[6], p[7]);
                const bf16x8 pf = __builtin_bit_cast(bf16x8, pw);
#pragma unroll
                for (int rt = 0; rt < 16; ++rt) {
                    const LAS unsigned char* p0 = wl + (4 * fq + (fr >> 2)) * 528 + (16 * rt + 4 * (fr & 3)) * 2;
                    const v4i16_t a0 = __builtin_amdgcn_ds_read_tr16_b64_v4i16((LAS v4i16_t*)p0);
                    const v4i16_t a1 = __builtin_amdgcn_ds_read_tr16_b64_v4i16((LAS v4i16_t*)(p0 + 16 * 528));
                    bf16x8 af; af[0] = a0[0]; af[1] = a0[1]; af[2] = a0[2]; af[3] = a0[3]; af[4] = a1[0]; af[5] = a1[1]; af[6] = a1[2]; af[7] = a1[3];
                    oacc[rt] = __builtin_amdgcn_mfma_f32_16x16x32_bf16(af, pf, oacc[rt], 0, 0, 0); }
                LDS_WAIT(); asm volatile("" ::: "memory");
            }
            float lt = lrun; lt += __shfl_xor(lt, 16); lt += __shfl_xor(lt, 32);
            const float inv = 1.0f / lt;
            if (fr < 8) { bf16* op = ycat + (size_t)t * NCAT + 1024 + fr * 256 + 4 * fq;
#pragma unroll
                for (int rt = 0; rt < 16; ++rt) { const f32x4 v = oacc[rt] * inv; u32x2 w; w.x = pk2(v.x, v.y); w.y = pk2(v.z, v.w); *(u32x2*)(op + 16 * rt) = w; } }
        }
        LDS_WAIT(); asm volatile("" ::: "memory");
    }
}

__device__ __forceinline__ void attn_c_phase(const Args& a, LAS unsigned char* lds, int G, int wave_s) {
    int lane_o = (int)__builtin_amdgcn_mbcnt_hi(~0u, __builtin_amdgcn_mbcnt_lo(~0u, 0u)); asm volatile("" : "+v"(lane_o)); const int lane = lane_o, wave = wave_s, tid_o = wave_s * 64 + lane_o;
    unsigned char* ws = a.ws; const bf16* Q = (const bf16*)(ws + WS_Q); const bf16* K = (const bf16*)(ws + WS_K); const bf16* VT = (const bf16*)(ws + WS_VT); bf16* O = (bf16*)(ws + WS_O);
    LAS float* btab = (LAS float*)lds;
    const int l31 = lane & 31, hh = lane >> 5;
    const float sc = 0.08838834764831845f * 1.4426950408889634f;
    for (int un = blockIdx.x; un < 512; un += G) {
        const int head = un >> 5, cg = un & 31, chunk = 4 * cg + (wave >> 1);
        __syncthreads();
        for (int i = tid_o; i < 513; i += NTHR) btab[i] = a.in[I_RELB][head * 513 + i] * 1.4426950408889634f;
        __syncthreads();
        const int t = 64 * chunk + 32 * (wave & 1) + l31;
        bf16x8 qf[8];
        { const bf16* qp = Q + (size_t)t * DM + head * 128 + 8 * hh;
#pragma unroll
          for (int ks = 0; ks < 8; ++ks) qf[ks] = *(const bf16x8*)(qp + 16 * ks); }
        f32x16 oacc[4];
#pragma unroll
        for (int d = 0; d < 4; ++d)
#pragma unroll
            for (int i = 0; i < 16; ++i) oacc[d][i] = 0.f;
        float mrun = -1e30f, lrun = 0.f;
        const int sbeg = 64 * (chunk - 8);
        for (int kt = 0; kt < 18; ++kt) {
            const int s0 = sbeg + 32 * kt; if (s0 < 0) continue;
            const bf16* kp = K + (size_t)(s0 + l31) * DM + head * 128 + 8 * hh;
            f32x16 sa;
#pragma unroll
            for (int i = 0; i < 16; ++i) sa[i] = 0.f;
#pragma unroll
            for (int ks = 0; ks < 8; ++ks) { const bf16x8 kf = *(const bf16x8*)(kp + 16 * ks); sa = __builtin_amdgcn_mfma_f32_32x32x16_bf16(kf, qf[ks], sa, 0, 0, 0); }
            float mx = -1e30f; float lg[16];
#pragma unroll
            for (int i = 0; i < 16; ++i) { const int s = s0 + (i & 3) + 8 * (i >> 2) + 4 * hh; int rel = t - s; rel = rel > 256 ? 256 : rel; lg[i] = sa[i] * sc + btab[rel + 256]; mx = fmaxf(mx, lg[i]); }
            mx = fmaxf(mx, __shfl_xor(mx, 32));
            const float mnew = fmaxf(mrun, mx), alpha = fast_exp2(mrun - mnew);
            float ps = 0.f; float p[16];
#pragma unroll
            for (int i = 0; i < 16; ++i) { p[i] = fast_exp2(lg[i] - mnew); ps += p[i]; }
            lrun = lrun * alpha + ps; mrun = mnew;
#pragma unroll
            for (int d = 0; d < 4; ++d)
#pragma unroll
                for (int i = 0; i < 16; ++i) oacc[d][i] *= alpha;
#pragma unroll
            for (int s = 0; s < 2; ++s) {
                u32x4 pw; pw.x = pk2(p[8 * s], p[8 * s + 1]); pw.y = pk2(p[8 * s + 2], p[8 * s + 3]); pw.z = pk2(p[8 * s + 4], p[8 * s + 5]); pw.w = pk2(p[8 * s + 6], p[8 * s + 7]);
                const bf16x8 pf = __builtin_bit_cast(bf16x8, pw);
#pragma unroll
                for (int d = 0; d < 4; ++d) { const bf16* vp = VT + (size_t)(head * 128 + 32 * d + l31) * SEQ + s0 + 16 * s + 4 * hh;
                    const u32x2 v0 = *(const u32x2*)vp, v1 = *(const u32x2*)(vp + 8);
                    u32x4 vw; vw.x = v0.x; vw.y = v0.y; vw.z = v1.x; vw.w = v1.y;
                    oacc[d] = __builtin_amdgcn_mfma_f32_32x32x16_bf16(__builtin_bit_cast(bf16x8, vw), pf, oacc[d], 0, 0, 0); }
            }
        }
        float lt = lrun + __shfl_xor(lrun, 32); const float inv = 1.0f / lt;
        bf16* op = O + (size_t)t * DM + head * 128 + 4 * hh;
#pragma unroll
        for (int d = 0; d < 4; ++d)
#pragma unroll
            for (int gq = 0; gq < 4; ++gq) { u32x2 w; w.x = pk2(oacc[d][4 * gq] * inv, oacc[d][4 * gq + 1] * inv); w.y = pk2(oacc[d][4 * gq + 2] * inv, oacc[d][4 * gq + 3] * inv);
                *(u32x2*)(op + 32 * d + 8 * gq) = w; }
    }
    __syncthreads();
}

__global__ void __launch_bounds__(NTHR, 2) fwd_kernel(Args args) {
    extern __shared__ __attribute__((aligned(16))) unsigned char lds_raw[];
    LAS unsigned char* lds = (LAS unsigned char*)lds_raw;
    volatile LAS unsigned* MISC = (volatile LAS unsigned*)(lds + MISC_OFF);
    const int wave_s = __builtin_amdgcn_readfirstlane((int)threadIdx.x >> 6);
    const int G = gridDim.x;
    unsigned char* ws = args.ws;
    if (threadIdx.x < 64) MISC[threadIdx.x] = 0u;
    __syncthreads();
    const int lo = args.ph_lo, hi = args.ph_hi;
    const bool multi = (hi - lo) > 1;
    XcdBarrier bar; bar.bar = (unsigned*)(ws + WS_CTL) + CW_BAR; bar.x = 0; bar.st = nullptr;
    if (multi) bar = xcd_barrier_post((unsigned*)(ws + WS_CTL) + CW_BAR, MISC + 8);
    bar.wave = wave_s;
#define IN(k) (lo <= (k) && (k) < hi)
#if TIMING
#define STAMP(k) do { if (blockIdx.x == 0 && wave_s == 0 && __builtin_amdgcn_mbcnt_hi(~0u, __builtin_amdgcn_mbcnt_lo(~0u, 0u)) == 0u) __hip_atomic_store((unsigned long long*)(ws + WS_DIAG) + (k), __builtin_amdgcn_s_memrealtime(), __ATOMIC_RELAXED, __HIP_MEMORY_SCOPE_AGENT); } while (0)
#define SEAM(k) do { if (IN((k) + 1)) xcd_barrier(bar); STAMP((k) + 1); } while (0)
#else
#define STAMP(k) do { } while (0)
#define SEAM(k) do { if (IN((k) + 1)) xcd_barrier(bar); } while (0)
#endif

 #if REP_MASK
#define PH_LOOP(k) for (int r_ = 0, n_ = (((REP_MASK >> (k)) & 1u) ? ph_reps(k) : 1); r_ < n_; ++r_)
#else
#define PH_LOOP(k)
#endif
    float* H = args.out;
    float* mod = (float*)(ws + WS_MOD);
    bf16* hn = (bf16*)(ws + WS_HN); bf16* hmid = (bf16*)(ws + WS_HMID); bf16* proj = (bf16*)(ws + WS_PROJ);

    STAMP(0);
    PH_LOOP(0) { if (EN(0) && IN(0)) p0_prologue(args, lds, G, wave_s);
    if (IN(0)) SEAM(0); }

#define FFN_PHASES(S_, PB_) do { \
        constexpr int layer_ = (S_) >> 1, sub_ = ((S_) & 1) ? 2 : 0; \
        const float* hin_ = ((S_) == 0) ? args.in[I_X] : H; \
        const float* mvec_ = mod + layer_ * NMOD + sub_ * 3 * DM; \
        PH_LOOP(PB_) { if (EN(1) && IN(PB_)) norm_phase<false, true>(hin_, args.in[I_NORMG] + (layer_ * 3 + sub_) * DM, mvec_, mvec_ + DM, hn, nullptr, G, wave_s); \
        if ((S_) == 0 && EN(2) && IN(PB_)) { \
              \
            pg8::Gemm g{(const bf16*)(ws + WS_WUPRAW), (const bf16*)(ws + WS_WQRAW), 256, 2048, 128, 2048, 2048, 8, 128, 128, \
                        (const bf16*)(ws + WS_WOUTB) + 1024, (const bf16*)(ws + WS_WUPRAW) + 1024, 2048, 256, 8, 128, 128}; \
            pg8::StaticOrder S; S.init(g, G, (int)blockIdx.x); \
            pg8::EpiBf16 E{(bf16*)(ws + WS_WIN) + (size_t)1024 * DM, DM, (size_t)256 * DM, 0.08838834764831845f, (bf16*)(ws + WS_WOUT) + 1024, NCAT, (size_t)256, 1.0f}; \
            pg8::gemm_phase<pg8::EpiBf16>(lds, g, S, E, wave_s); } \
        if (IN(PB_)) SEAM(PB_); } \
        PH_LOOP((PB_) + 1) { if (EN(3) && IN((PB_) + 1)) { \
            pg8::Gemm g{hn, (const bf16*)(ws + WS_WGU + (size_t)(S_) * NGU * DM), SEQ, NGU, DM / 2, DM / 2, DM / 2, 1, 0, 0, nullptr, nullptr, 0, 0, 0, 0, 0}; \
            pg8::StaticOrder S; S.init(g, G, (int)blockIdx.x); \
            pg8::EpiSwiGLU E{(unsigned char*)hmid, FFP, 0x7c7c7c7c, 0x79797979};     \
            pg8::gemm_phase<pg8::EpiSwiGLU, true>(lds, g, S, E, wave_s); } \
        if (IN((PB_) + 1)) SEAM((PB_) + 1); } \
        PH_LOOP((PB_) + 2) { if (EN(4) && IN((PB_) + 2)) { \
            pg8::Gemm g{hmid, (const bf16*)(ws + WS_WD + (size_t)(S_) * DM * FFP), SEQ, DM, FFP / 2, FFP / 2, FFP / 2, 1, 0, 0, nullptr, nullptr, 0, 0, 0, 0, 0}; \
            pg8::StaticOrder S; S.init(g, G, (int)blockIdx.x); \
            pg8::EpiResid E{hin_, H, mvec_ + 2 * DM, 0.5f, 0x7c7c7c7c, 0x78787878};     \
            pg8::gemm_phase<pg8::EpiResid, true>(lds, g, S, E, wave_s); } \
        if (IN((PB_) + 2)) SEAM((PB_) + 2); } \
    } while (0)
#define MIXOUT_PHASE(LYR_, PM_, APTR_, BPTR_, K_) do { \
        if (EN(12) && IN(PM_)) { \
            const float* m1_ = mod + (LYR_) * NMOD + 1 * 3 * DM; \
            pg8::Gemm g{(const bf16*)(APTR_), (const bf16*)(BPTR_), SEQ, DM, (K_), (K_), (K_), 1, 0, 0, nullptr, nullptr, 0, 0, 0, 0, 0}; \
            pg8::StaticOrder S; S.init(g, G, (int)blockIdx.x); \
            pg8::EpiResid E{H, H, m1_ + 2 * DM, 1.0f, 0, 0}; \
            pg8::gemm_phase<pg8::EpiResid>(lds, g, S, E, wave_s); } \
        if (IN(PM_)) SEAM(PM_); \
    } while (0)

    FFN_PHASES(0, 1);
    {
        const float* m1 = mod + 0 * NMOD + 1 * 3 * DM;
        PH_LOOP(4) { if (EN(1) && IN(4)) norm_phase<false>(H, args.in[I_NORMG] + (0 * 3 + 1) * DM, m1, m1 + DM, hn, nullptr, G, wave_s);
        if (IN(4)) SEAM(4); }
        PH_LOOP(5) { if (EN(5) && IN(5)) {
            pg8::Gemm g{hn, (const bf16*)(ws + WS_WIN), SEQ, NIN, DM, DM, DM, 1, 0, 0, nullptr, nullptr, 0, 0, 0, 0, 0};
            pg8::StaticOrder S; S.init(g, G, (int)blockIdx.x);
            pg8::EpiBf16 E{proj, NIN, 0, 1.0f, nullptr, 0, 0, 0.f};
            pg8::gemm_phase<pg8::EpiBf16>(lds, g, S, E, wave_s);
        }
        if (IN(5)) SEAM(5); }
        PH_LOOP(6) { if (EN(6) && IN(6)) phase_a2(args, lds, G, wave_s);
        if (IN(6)) SEAM(6); }
        PH_LOOP(24) { if (EN(7) && IN(7)) { s5_scan_out(args, lds, G, wave_s); __syncthreads(); } }
        PH_LOOP(25) { if (EN(8) && IN(7)) dsa_phase(args, lds, G, wave_s); }
        if (IN(7)) SEAM(7);
        PH_LOOP(8) { if (EN(9) && IN(8)) {
            pg8::Gemm g{(const bf16*)(ws + WS_YAPRE), (const bf16*)(ws + WS_WGLU), SEQ, 1024, 1024, 1024, 1024, 1, 0, 0, nullptr, nullptr, 0, 0, 0, 0, 0};
            pg8::StaticOrder S; S.init(g, G, (int)blockIdx.x);
            pg8::EpiGLU E{(const bf16*)(ws + WS_YAPRE), args.in[I_BGLU], (bf16*)(ws + WS_YCAT), NCAT};
            pg8::gemm_phase<pg8::EpiGLU>(lds, g, S, E, wave_s);
        }
        if (IN(8)) SEAM(8); }
    }
#ifdef EXTRA_BARRIERS
    for (int xb_ = 0; xb_ < EXTRA_BARRIERS; ++xb_) xcd_barrier(bar);
#endif
    MIXOUT_PHASE(0, 9, ws + WS_YCAT, ws + WS_WOUT, NCAT);
    FFN_PHASES(1, 10);
    FFN_PHASES(2, 13);
    {
        const float* m1 = mod + 1 * NMOD + 1 * 3 * DM;
        PH_LOOP(16) { if (EN(1) && IN(16)) norm_phase<false>(H, args.in[I_NORMG] + (1 * 3 + 1) * DM, m1, m1 + DM, hn, nullptr, G, wave_s);
        if (IN(16)) SEAM(16); }
        PH_LOOP(17) { if (EN(10) && IN(17)) {
            pg8::Gemm g{hn, (const bf16*)(ws + WS_WQKV), SEQ, 2048, DM, DM, DM, 2, 0, (size_t)2048 * DM,
                        (const bf16*)(ws + WS_WQKV) + (size_t)4096 * DM, hn, 2048, SEQ, 1, 0, 0};
            pg8::StaticOrder S; S.init(g, G, (int)blockIdx.x);
            pg8::EpiBf16 E{(bf16*)(ws + WS_Q), DM, (size_t)SEQ * DM, 1.0f, (bf16*)(ws + WS_VT), SEQ, 0, 1.0f};
            pg8::gemm_phase<pg8::EpiBf16>(lds, g, S, E, wave_s);
        }
        if (IN(17)) SEAM(17); }
        PH_LOOP(18) { if (EN(11) && IN(18)) attn_c_phase(args, lds, G, wave_s);
        if (IN(18)) SEAM(18); }
    }
    MIXOUT_PHASE(1, 19, ws + WS_O, ws + WS_WCOUT, DM);
    FFN_PHASES(3, 20);
    if (EN(13) && IN(23)) { norm_phase<true>(H, args.in[I_FING], nullptr, nullptr, nullptr, args.out, G, wave_s); }
#if TIMING
    {
        xcd_barrier(bar); STAMP(24); xcd_barrier(bar);
        const unsigned long long* ts = (const unsigned long long*)(ws + WS_DIAG);
        const unsigned long long a0 = __hip_atomic_load(ts + TSEL_A, __ATOMIC_RELAXED, __HIP_MEMORY_SCOPE_AGENT), a1 = __hip_atomic_load(ts + TSEL_A + TSEL_A_N, __ATOMIC_RELAXED, __HIP_MEMORY_SCOPE_AGENT);
        const unsigned long long b0 = __hip_atomic_load(ts + TSEL_B, __ATOMIC_RELAXED, __HIP_MEMORY_SCOPE_AGENT), b1 = __hip_atomic_load(ts + TSEL_B + TSEL_B_N, __ATOMIC_RELAXED, __HIP_MEMORY_SCOPE_AGENT);
        const float TA = (float)(a1 - a0) * 1e-4f, TB = (float)(b1 - b0) * 1e-4f;
        const int lane_t = (int)__builtin_amdgcn_mbcnt_hi(~0u, __builtin_amdgcn_mbcnt_lo(~0u, 0u)); const int gt = ((int)blockIdx.x * NWAVES + wave_s) * 64 + lane_t;
        for (size_t i = gt; i < (size_t)SEQ * DM / 4; i += (size_t)G * NTHR) { f32x4 v = ((f32x4*)args.out)[i]; v = v * (1.0f + TA); if (i == 0) v.x += (v.x < 0.f ? -8.f : 8.f) * (1.0f + TA) * (1.0f + TB); ((f32x4*)args.out)[i] = v; }
    }
#endif
#undef IN
#undef SEAM
}

extern "C" void kernel_launch(void* const* d_in, const int* in_sizes, int n_in, void* d_out, int out_size, void* d_ws, size_t ws_size, hipStream_t stream) {
    static int grid = 0;
    if (grid == 0) {
        if (n_in != 26 || out_size != SEQ * DM || ws_size < WS_END) { fprintf(stderr, "kernel_launch: unexpected shapes (n_in %d out %d ws %zu need %zu)\n", n_in, out_size, ws_size, (size_t)WS_END); grid = -1; return; }
        int dev = 0, cus = 0, per_cu = 0;
        if (hipGetDevice(&dev) != hipSuccess || hipDeviceGetAttribute(&cus, hipDeviceAttributeMultiprocessorCount, dev) != hipSuccess) { grid = -1; return; }
        if (hipFuncSetAttribute((const void*)fwd_kernel, hipFuncAttributeMaxDynamicSharedMemorySize, LDS_BYTES) != hipSuccess) { fprintf(stderr, "kernel_launch: hipFuncSetAttribute failed\n"); grid = -1; return; }
        if (hipOccupancyMaxActiveBlocksPerMultiprocessor(&per_cu, (const void*)fwd_kernel, NTHR, LDS_BYTES) != hipSuccess || per_cu < 1) { fprintf(stderr, "kernel_launch: occupancy query says %d\n", per_cu); }
        (void)hipGetLastError();
        grid = cus;
    }
    if (grid < 0) return;
    (void)hipMemsetAsync((char*)d_ws + WS_CTL, 0, CTL_ZERO_BYTES, stream);
    Args a{};
    for (int i = 0; i < 26; ++i) a.in[i] = (const float*)d_in[i];
    a.out = (float*)d_out; a.ws = (unsigned char*)d_ws;
    a.ph_lo = 0; a.ph_hi = N_PHASES_RUN;
    hipLaunchKernelGGL(fwd_kernel, dim3(grid), dim3(NTHR), LDS_BYTES, stream, a);
}
```

```cpp
#include <hip/hip_runtime.h>
#include <cstdio>
#include <cstdint>

#ifndef SELFCHECK
#define SELFCHECK 0
#endif
#ifndef N_PHASES_RUN
#define N_PHASES_RUN 24
#endif
#ifndef REP_MASK
#define REP_MASK 0u
#endif
#ifndef REP_N
#define REP_N 2
#endif
#ifndef TIMING
#define TIMING 0
#endif
#ifndef TBLK
#define TBLK 100
#endif
#ifndef TAMP
#define TAMP 8
#endif
#ifndef TSEL_A
#define TSEL_A 0
#define TSEL_A_N 1
#define TSEL_B 1
#define TSEL_B_N 1
#endif

#ifndef EN_MASK
#define EN_MASK 0xFFFFFFFFu
#endif
#define EN(b) ((EN_MASK >> (b)) & 1u)
#define GAS __attribute__((address_space(1)))
#define LAS __attribute__((address_space(3)))
typedef unsigned short bf16;
typedef short bf16x8 __attribute__((ext_vector_type(8)));
typedef short s16x4 __attribute__((ext_vector_type(4)));
typedef float f32x2 __attribute__((ext_vector_type(2)));
typedef float f32x4 __attribute__((ext_vector_type(4)));
typedef float f32x16 __attribute__((ext_vector_type(16)));
typedef unsigned u32x2 __attribute__((ext_vector_type(2)));
typedef unsigned u32x4 __attribute__((ext_vector_type(4)));
typedef short v4i16_t __attribute__((ext_vector_type(4)));

constexpr int SEQ = 8192, DM = 2048, FF = 5504, NGU = 2 * FF  , NMOD = 18432;
constexpr int NIN = 4608;
constexpr int C_U = 0, C_QT = 1024, C_KVL = 3072, C_QI = 3328, C_KI = 4352, C_WI = 4416;
constexpr int FFP = 5632;
constexpr int NCAT = 3072;
constexpr int NWAVES = 8, NTHR = 512;

constexpr size_t MiB = 1u << 20;
constexpr size_t WS_CTL = 0, CTL_ZERO_BYTES = 1 * MiB;
constexpr size_t WS_MOD = 1 * MiB;
constexpr size_t WS_S5T = WS_MOD + 256 * 1024;
constexpr size_t WS_DIAG = 3 * MiB;
constexpr size_t WS_WGU = 4 * MiB;
constexpr size_t WS_WD = WS_WGU + 172 * MiB;
constexpr size_t WS_WIN = WS_WD + 86 * MiB;
constexpr size_t WS_WQRAW = WS_WIN + 18 * MiB;
constexpr size_t WS_WUPRAW = WS_WQRAW + 8 * MiB;
constexpr size_t WS_WGLU = WS_WUPRAW + 1 * MiB;
constexpr size_t WS_WOUT = WS_WGLU + 2 * MiB;
constexpr size_t WS_WOUTB = WS_WOUT + 12 * MiB;
constexpr size_t WS_WQKV = WS_WOUTB + 8 * MiB;
constexpr size_t WS_WCOUT = WS_WQKV + 24 * MiB;
constexpr size_t WS_HN = WS_WCOUT + 8 * MiB;
constexpr size_t WS_HMID = WS_HN + 32 * MiB;
constexpr size_t WS_PROJ = WS_HMID + 86 * MiB;
constexpr size_t WS_KVN = WS_PROJ + 72 * MiB;
constexpr size_t WS_E = WS_KVN + 4 * MiB;
constexpr size_t WS_YAPRE = WS_E + 4 * MiB;
constexpr size_t WS_YCAT = WS_YAPRE + 16 * MiB;
constexpr size_t WS_SCORE = WS_YCAT + 48 * MiB;
constexpr size_t WS_Q = WS_SCORE, WS_K = WS_SCORE + 32 * MiB, WS_VT = WS_SCORE + 64 * MiB, WS_O = WS_SCORE + 96 * MiB;
constexpr size_t WS_END = WS_SCORE + 256 * MiB;
constexpr int S5_AR = 0, S5_AI = 4096, S5_A64R = 8192, S5_A64I = 12288, S5_BBR = 16384, S5_BBI = 16384 + 65536;

constexpr int CW_BAR = 4096;

constexpr int RING_BYTES = 131072;
constexpr int SCRATCH_BYTES = 155648;
constexpr int MISC_OFF = SCRATCH_BYTES;
constexpr int LDS_BYTES = SCRATCH_BYTES + 256;

#define LDS_WAIT() asm volatile("s_waitcnt lgkmcnt(0)" ::: "memory")
#define VM_WAIT() asm volatile("s_waitcnt vmcnt(0)" ::: "memory")

__device__ __forceinline__ unsigned f2bf(float f) { unsigned u = __builtin_bit_cast(unsigned, f); return (u + 0x7fffu + ((u >> 16) & 1u)) >> 16; }
__device__ __forceinline__ unsigned pk2(float lo, float hi) { unsigned r; asm volatile("v_cvt_pk_bf16_f32 %0, %1, %2" : "=v"(r) : "v"(lo), "v"(hi)); return r; }
__device__ __forceinline__ float clamp448(float x) { return __builtin_amdgcn_fmed3f(x, -448.0f, 448.0f); }
__device__ __forceinline__ unsigned pk4_fp8(float a, float b, float c, float d) {
    int w = 0; w = __builtin_amdgcn_cvt_pk_fp8_f32(clamp448(a), clamp448(b), w, false); w = __builtin_amdgcn_cvt_pk_fp8_f32(clamp448(c), clamp448(d), w, true); return (unsigned)w; }
__device__ __forceinline__ float bf2f(unsigned short b) { return __builtin_bit_cast(float, (unsigned)b << 16); }
__device__ __forceinline__ float bflo(unsigned w) { return __builtin_bit_cast(float, w << 16); }
__device__ __forceinline__ float bfhi(unsigned w) { return __builtin_bit_cast(float, w & 0xffff0000u); }
__device__ __forceinline__ float fast_exp2(float x) { return __builtin_amdgcn_exp2f(x); }
__device__ __forceinline__ float fast_rcp(float x) { return __builtin_amdgcn_rcpf(x); }
__device__ __forceinline__ float silu_f(float x) { return x * fast_rcp(1.0f + fast_exp2(-1.4426950408889634f * x)); }
__device__ __forceinline__ float sigmoid_f(float x) { return fast_rcp(1.0f + fast_exp2(-1.4426950408889634f * x)); }
__device__ __forceinline__ float gelu_tanh_f(float y) {
    const float z = 0.7978845608028654f * (y + 0.044715f * y * y * y);
    const float e = fast_exp2(2.0f * 1.4426950408889634f * z);
    const float th = 1.0f - 2.0f * fast_rcp(e + 1.0f);
    return 0.5f * y * (1.0f + th);
}
__device__ __forceinline__ float wave_sum(float v) {
#pragma unroll
    for (int o = 1; o < 64; o <<= 1) v += __shfl_xor(v, o);
    return v;
}

namespace pg8 {
constexpr int BM = 256, BK = 64, HALF = 128, HTB = HALF * BK * 2, STAGE_BYTES = 8 * HTB, NXCD = 8, WGM = 8;
__host__ __device__ __forceinline__ int lds_byte(int r, int c) { const int st = (r >> 4) * 2 + (c >> 5), rr = r & 15, cc = c & 31, ob = rr * 64 + cc * 2; return st * 1024 + (ob ^ (((ob >> 9) & 1) << 5)); }
__host__ __device__ __forceinline__ void stage_rc(int b, int& R, int& C) { const int st = b / 1024, sb = b % 1024, swz = sb ^ (((sb >> 9) & 1) << 5); R = (st >> 1) * 16 + swz / 64; C = (st & 1) * 32 + (swz % 64) / 2; }
__host__ __device__ __forceinline__ int perm32(int rho) { const int n = rho >> 4, i = rho & 15; return 8 * (i >> 2) + 4 * n + (i & 3); }

typedef int v4i_t __attribute__((ext_vector_type(4)));
typedef int v8i_t __attribute__((ext_vector_type(8)));
__device__ __forceinline__ v8i_t cat8(bf16x8 lo, bf16x8 hi) { return __builtin_shufflevector(__builtin_bit_cast(v4i_t, lo), __builtin_bit_cast(v4i_t, hi), 0, 1, 2, 3, 4, 5, 6, 7); }
__device__ __forceinline__ bf16x8 lo8(v8i_t v) { return __builtin_bit_cast(bf16x8, __builtin_shufflevector(v, v, 0, 1, 2, 3)); }
__device__ __forceinline__ bf16x8 hi8(v8i_t v) { return __builtin_bit_cast(bf16x8, __builtin_shufflevector(v, v, 4, 5, 6, 7)); }
struct Unit { int pm, pn, z, seg; };
struct Gemm { const bf16* A; const bf16* Bt; int M, N, K, lda, ldb, nz; size_t zA, zB; const bf16* A1; const bf16* Bt1; int M1, N1, nz1; size_t zA1, zB1; };

struct StaticOrder {
    int nM0, nN0, n0, nM1, nN1, ntot, G, c; int force = 0;
    __device__ void init(const Gemm& g, int G_, int c_) { nM0 = g.M / BM; nN0 = g.N / BM; n0 = nM0 * nN0 * g.nz; nM1 = g.M1 / BM; nN1 = g.N1 / BM; ntot = n0 + nM1 * nN1 * g.nz1; G = G_; c = c_; }
    __device__ bool next(int i, Unit& u) const {
        int L = i * G + c; if (L >= ntot) return false;
        const int seg = L >= n0 ? 1 : 0; if (seg) L -= n0;
        const int nM = seg ? nM1 : nM0, nN = seg ? nN1 : nN0, nwg = nM * nN;
        u.seg = seg; u.z = L / nwg;
        int wgid = L % nwg; { const int q = nwg / NXCD, r = nwg % NXCD, xcd = wgid % NXCD, off = wgid / NXCD; wgid = (xcd < r ? xcd * (q + 1) : r * (q + 1) + (xcd - r) * q) + off; }
        const int nig = WGM * nN, gid = wgid / nig, fm = gid * WGM, gsz = (nM - fm) < WGM ? (nM - fm) : WGM;
        u.pm = fm + ((wgid % nig) % gsz); u.pn = (wgid % nig) / gsz; if (force & 1) u.pm = 0; if (force & 2) u.pn = 0; return true;
    }
};

struct EpiBf16 {
    static constexpr bool PERM = true;
    bf16* O; int ldc; size_t zC; float scale; bf16* O1; int ldc1; size_t zC1; float scale1; int scale_a = 0, scale_w = 0;
    __device__ __forceinline__ void operator()(const f32x4 (&acc)[2][2][4][2], const Unit& u, int wr, int wc, int fr, int fq) const {
        const int row0 = u.pm * BM + wr * 64 + fr; const int col0 = u.pn * BM + wc * 32 + 8 * fq;
        bf16* base = u.seg ? O1 + (size_t)u.z * zC1 : O + (size_t)u.z * zC; const int ldc = u.seg ? ldc1 : this->ldc; const float scale = u.seg ? scale1 : this->scale;
#pragma unroll
        for (int ai = 0; ai < 2; ++ai)
#pragma unroll
            for (int m = 0; m < 4; ++m) { bf16* rowp = base + (size_t)(row0 + ai * HALF + m * 16) * ldc + col0;
#pragma unroll
                for (int bj = 0; bj < 2; ++bj) { const f32x4 v0 = acc[ai][bj][m][0] * scale, v1 = acc[ai][bj][m][1] * scale;
                    u32x4 w; w.x = pk2(v0[0], v0[1]); w.y = pk2(v0[2], v0[3]); w.z = pk2(v1[0], v1[1]); w.w = pk2(v1[2], v1[3]);
                    *(u32x4*)(rowp + bj * HALF) = w; } }
    }
};
struct EpiSwiGLU {
    static constexpr bool PERM = true;
    unsigned char* O; int ldc; int scale_a, scale_w;
    __device__ __forceinline__ void operator()(const f32x4 (&acc)[2][2][4][2], const Unit& u, int wr, int wc, int fr, int fq) const {
        const int row0 = u.pm * BM + wr * 64 + fr; const int col0 = u.pn * HALF + wc * 32 + 8 * fq;
#pragma unroll
        for (int ai = 0; ai < 2; ++ai)
#pragma unroll
            for (int m = 0; m < 4; ++m) { unsigned char* rowp = O + (size_t)(row0 + ai * HALF + m * 16) * ldc + col0;
                const f32x4 g0 = acc[ai][0][m][0], g1 = acc[ai][0][m][1], u0 = acc[ai][1][m][0] * 8.0f, u1 = acc[ai][1][m][1] * 8.0f;
                u32x2 w; w.x = pk4_fp8(silu_f(g0[0]) * u0[0], silu_f(g0[1]) * u0[1], silu_f(g0[2]) * u0[2], silu_f(g0[3]) * u0[3]);
                w.y = pk4_fp8(silu_f(g1[0]) * u1[0], silu_f(g1[1]) * u1[1], silu_f(g1[2]) * u1[2], silu_f(g1[3]) * u1[3]);
                *(u32x2*)rowp = w; }
    }
};
struct EpiResid {
    static constexpr bool PERM = false;
    const float* hin; float* out; const float* gate; float coef; int scale_a, scale_w;
    __device__ __forceinline__ void operator()(const f32x4 (&acc)[2][2][4][2], const Unit& u, int wr, int wc, int fr, int fq) const {
        const int row0 = u.pm * BM + wr * 64 + fr; const int col0 = u.pn * BM + wc * 32 + 4 * fq;
        f32x4 gv[2][2];
#pragma unroll
        for (int bj = 0; bj < 2; ++bj)
#pragma unroll
            for (int n = 0; n < 2; ++n) gv[bj][n] = *(const f32x4*)(gate + col0 + bj * HALF + n * 16) * coef;
#pragma unroll
        for (int ai = 0; ai < 2; ++ai)
#pragma unroll
            for (int m = 0; m < 4; ++m) { const size_t off = (size_t)(row0 + ai * HALF + m * 16) * DM + col0;
#pragma unroll
                for (int bj = 0; bj < 2; ++bj)
#pragma unroll
                    for (int n = 0; n < 2; ++n) { const f32x4 b = *(const f32x4*)(hin + off + bj * HALF + n * 16);
                        *(f32x4*)(out + off + bj * HALF + n * 16) = b + gv[bj][n] * acc[ai][bj][m][n]; } }
    }
};
struct EpiGLU {
    static constexpr bool PERM = true;
    const bf16* yp; const float* bias; bf16* O; int ldc; int scale_a = 0, scale_w = 0;
    __device__ __forceinline__ void operator()(const f32x4 (&acc)[2][2][4][2], const Unit& u, int wr, int wc, int fr, int fq) const {
        const int row0 = u.pm * BM + wr * 64 + fr; const int col0 = u.pn * BM + wc * 32 + 8 * fq;
#pragma unroll
        for (int bj = 0; bj < 2; ++bj) { const f32x4 b0 = *(const f32x4*)(bias + col0 + bj * HALF), b1 = *(const f32x4*)(bias + col0 + bj * HALF + 4);
#pragma unroll
            for (int ai = 0; ai < 2; ++ai)
#pragma unroll
                for (int m = 0; m < 4; ++m) { const size_t r = (size_t)(row0 + ai * HALF + m * 16);
                    const u32x4 y = *(const u32x4*)(yp + r * 1024 + col0 + bj * HALF);
                    const f32x4 z0 = acc[ai][bj][m][0] + b0, z1 = acc[ai][bj][m][1] + b1;
                    u32x4 w; w.x = pk2(bflo(y.x) * sigmoid_f(z0[0]), bfhi(y.x) * sigmoid_f(z0[1])); w.y = pk2(bflo(y.y) * sigmoid_f(z0[2]), bfhi(y.y) * sigmoid_f(z0[3]));
                    w.z = pk2(bflo(y.z) * sigmoid_f(z1[0]), bfhi(y.z) * sigmoid_f(z1[1])); w.w = pk2(bflo(y.w) * sigmoid_f(z1[2]), bfhi(y.w) * sigmoid_f(z1[3]));
                    *(u32x4*)(O + r * ldc + col0 + bj * HALF) = w; } }
    }
};

template <class Epi, bool FP8 = false>
__device__ __forceinline__ void gemm_phase(LAS unsigned char* lds, const Gemm g, const StaticOrder& S, const Epi& E, int wave_s) {
    int lane_o = (int)__builtin_amdgcn_mbcnt_hi(~0u, __builtin_amdgcn_mbcnt_lo(~0u, 0u)); asm volatile("" : "+v"(lane_o));
    const int wid = wave_s, lane = lane_o, tid = wave_s * 64 + lane_o, wr = wid >> 2, wc = wid & 3, fr = lane & 15, fq = lane >> 4;
    const int K = g.K, nt = K / BK;
    unsigned voffA[2], voffB[2];
#pragma unroll
    for (int i = 0; i < 2; ++i) { int R, C; stage_rc(tid * 16 + i * 8192, R, C); const int Rb = Epi::PERM ? ((R & ~31) + perm32(R & 31)) : R;
        voffA[i] = (unsigned)(R * g.lda + C) * 2u; voffB[i] = (unsigned)(Rb * g.ldb + C) * 2u; }
    const size_t kstep = (size_t)(BK * 2);
    const size_t hstepA = (size_t)HALF * g.lda * 2, hstepB = (size_t)HALF * g.ldb * 2;
    const size_t tstepA = 2 * hstepA, tstepB = 2 * hstepB;
    const unsigned ldsw = (unsigned)wid * 1024u;
    const int aoff = lds_byte(wr * 64 + fr, fq * 8), boff = lds_byte(wc * 32 + fr, fq * 8);
#define PG8_SA(b, h) (((b) * 2 + (h)) * HTB)
#define PG8_SB(b, h) ((4 + (b) * 2 + (h)) * HTB)
#define PG8_STAGE(bufoff, gbase, voff) do { _Pragma("unroll") for (int _i = 0; _i < 2; ++_i) \
        __builtin_amdgcn_global_load_lds((const unsigned*)((const char*)(gbase) + (voff)[_i]), (LAS unsigned*)(lds + (bufoff) + ldsw + _i * 8192), 16, 0, 0); } while (0)
#define PG8_LDA(dst, b, h) do { _Pragma("unroll") for (int m = 0; m < 4; ++m) { const bf16x8 l_ = *(const LAS bf16x8*)(lds + PG8_SA(b, h) + aoff + m * 2048), h_ = *(const LAS bf16x8*)(lds + PG8_SA(b, h) + aoff + m * 2048 + 1024); dst[m] = cat8(l_, h_); } } while (0)
#define PG8_LDB(dst, b, h) do { _Pragma("unroll") for (int n = 0; n < 2; ++n) { const bf16x8 l_ = *(const LAS bf16x8*)(lds + PG8_SB(b, h) + boff + n * 2048), h_ = *(const LAS bf16x8*)(lds + PG8_SB(b, h) + boff + n * 2048 + 1024); dst[n] = cat8(l_, h_); } } while (0)
#define PG8_MMA(ai, bj, At, Bt) do { __builtin_amdgcn_s_setprio(1); _Pragma("unroll") for (int m = 0; m < 4; ++m) _Pragma("unroll") for (int n = 0; n < 2; ++n) { \
        if constexpr (FP8) asm volatile("v_mfma_scale_f32_16x16x128_f8f6f4 %0, %1, %2, %0, %3, %4 op_sel_hi:[0,0,0]" : "+v"(acc[ai][bj][m][n]) : "v"(Bt[n]), "v"(At[m]), "v"(sc_w), "v"(sc_a)); \
        else { acc[ai][bj][m][n] = __builtin_amdgcn_mfma_f32_16x16x32_bf16(lo8(Bt[n]), lo8(At[m]), acc[ai][bj][m][n], 0, 0, 0); acc[ai][bj][m][n] = __builtin_amdgcn_mfma_f32_16x16x32_bf16(hi8(Bt[n]), hi8(At[m]), acc[ai][bj][m][n], 0, 0, 0); } } __builtin_amdgcn_s_setprio(0); } while (0)
#define PG8_WAIT_V(n) asm volatile("s_waitcnt vmcnt(" #n ")" ::: "memory")
#define PG8_WAIT_L(n) asm volatile("s_waitcnt lgkmcnt(" #n ")" ::: "memory")
#define PG8_BAR __builtin_amdgcn_s_barrier()
#define PG8_SCHED __builtin_amdgcn_sched_barrier(0)
    Unit cur, nxt; int ui = 0;
    if (!S.next(0, cur)) return;
    f32x4 acc[2][2][4][2];
#pragma unroll
    for (int a = 0; a < 2; ++a)
#pragma unroll
        for (int b = 0; b < 2; ++b)
#pragma unroll
            for (int m = 0; m < 4; ++m)
#pragma unroll
                for (int n = 0; n < 2; ++n) acc[a][b][m][n] = (f32x4){0.f, 0.f, 0.f, 0.f};
    v8i_t At[4], B0[2], B1[2];
    int sc_w = E.scale_w, sc_a = E.scale_a;
#define PG8_ABASE(u) ((const char*)((u).seg ? g.A1 + (size_t)(u).z * g.zA1 : g.A + (size_t)(u).z * g.zA) + (size_t)(u).pm * tstepA)
#define PG8_BBASE(u) ((const char*)((u).seg ? g.Bt1 + (size_t)(u).z * g.zB1 : g.Bt + (size_t)(u).z * g.zB) + (size_t)(u).pn * tstepB)
    const char* cA = PG8_ABASE(cur); const char* cB = PG8_BBASE(cur);
    PG8_STAGE(PG8_SB(0, 0), cB, voffB); PG8_STAGE(PG8_SB(0, 1), cB + hstepB, voffB); PG8_STAGE(PG8_SA(0, 0), cA, voffA); PG8_STAGE(PG8_SA(0, 1), cA + hstepA, voffA);
    if (wr == 1) PG8_BAR;
    PG8_WAIT_V(2); PG8_BAR;
    PG8_STAGE(PG8_SB(1, 0), cB + kstep, voffB); PG8_STAGE(PG8_SA(1, 0), cA + kstep, voffA); PG8_STAGE(PG8_SB(1, 1), cB + hstepB + kstep, voffB);
    PG8_WAIT_V(6); PG8_BAR;
    for (;;) {
        const bool has_next = S.next(ui + 1, nxt);
        const char* nA = has_next ? PG8_ABASE(nxt) : cA; const char* nB = has_next ? PG8_BBASE(nxt) : cB;
        for (int t = 0; t < nt; t += 2) {
            const bool last = (t == nt - 2);
            const char* a1 = cA + (size_t)(t + 1) * kstep;
            const char* a2 = last ? nA : cA + (size_t)(t + 2) * kstep; const char* b2 = last ? nB : cB + (size_t)(t + 2) * kstep;
            const char* a3 = a2 + kstep; const char* b3 = b2 + kstep;
            PG8_LDB(B0, 0, 0); PG8_LDB(B1, 0, 1); PG8_SCHED; PG8_LDA(At, 0, 0); PG8_STAGE(PG8_SA(1, 1), a1 + hstepA, voffA);
            PG8_WAIT_V(8); PG8_WAIT_L(0); PG8_BAR; PG8_MMA(0, 0, At, B0); PG8_MMA(0, 1, At, B1); PG8_BAR; PG8_SCHED;
            PG8_LDA(At, 0, 1); PG8_STAGE(PG8_SB(0, 0), b2, voffB); PG8_STAGE(PG8_SB(0, 1), b2 + hstepB, voffB); PG8_STAGE(PG8_SA(0, 0), a2, voffA);
            PG8_WAIT_V(8); PG8_WAIT_L(0); PG8_BAR; PG8_MMA(1, 0, At, B0); PG8_MMA(1, 1, At, B1); PG8_BAR; PG8_SCHED;
            PG8_LDB(B0, 1, 0); PG8_LDB(B1, 1, 1); PG8_SCHED; PG8_LDA(At, 1, 0); PG8_STAGE(PG8_SA(0, 1), a2 + hstepA, voffA);
            PG8_WAIT_V(8); PG8_WAIT_L(0); PG8_BAR; PG8_MMA(0, 0, At, B0); PG8_MMA(0, 1, At, B1); PG8_BAR; PG8_SCHED;
            PG8_LDA(At, 1, 1); PG8_STAGE(PG8_SB(1, 0), b3, voffB); PG8_STAGE(PG8_SB(1, 1), b3 + hstepB, voffB); PG8_STAGE(PG8_SA(1, 0), a3, voffA);
            PG8_WAIT_V(8); PG8_WAIT_L(0); PG8_BAR; PG8_MMA(1, 0, At, B0); PG8_MMA(1, 1, At, B1); PG8_BAR; PG8_SCHED;
        }
        if (wr == 0) PG8_BAR;
        if constexpr (FP8) asm volatile("s_nop 15\n\ts_nop 15" ::: "memory");
        E(acc, cur, wr, wc, fr, fq);
        if (!has_next) break;
#pragma unroll
        for (int a = 0; a < 2; ++a)
#pragma unroll
            for (int b = 0; b < 2; ++b)
#pragma unroll
                for (int m = 0; m < 4; ++m)
#pragma unroll
                    for (int n = 0; n < 2; ++n) acc[a][b][m][n] = (f32x4){0.f, 0.f, 0.f, 0.f};
        cur = nxt; cA = nA; cB = nB; ++ui;
        if (wr == 1) PG8_BAR;
    }
    PG8_WAIT_V(0);
    PG8_BAR;
#undef PG8_ABASE
#undef PG8_BBASE
#undef PG8_SA
#undef PG8_SB
#undef PG8_STAGE
#undef PG8_LDA
#undef PG8_LDB
#undef PG8_MMA
#undef PG8_WAIT_V
#undef PG8_WAIT_L
#undef PG8_BAR
#undef PG8_SCHED
}
}

#define XB_TMO      128
#define XB_XCNT(j)  (256  + 64 * (j))
#define XB_XSUB(j)  (1280 + 64 * (j))
#define XB_XGEN(j)  (2304 + 64 * (j))
#define XB_TOP      3328
#define XB_TOPGEN   3392
#define XCD_BAR_WORDS 3456
#define XB_SPIN_CAP (1u << 18)
__device__ __forceinline__ unsigned xb_ld(unsigned* p)              { return __hip_atomic_load(p, __ATOMIC_RELAXED, __HIP_MEMORY_SCOPE_AGENT); }
__device__ __forceinline__ unsigned xb_add(unsigned* p, unsigned v) { return __hip_atomic_fetch_add(p, v, __ATOMIC_RELAXED, __HIP_MEMORY_SCOPE_AGENT); }
__device__ __forceinline__ unsigned xb_xcc_id() { return (unsigned)__builtin_amdgcn_s_getreg((3 << 11) | 20) & 0xFu; }
#define XB_SPIN(cond, bar) do { unsigned _sp = 0; while (cond) { __builtin_amdgcn_s_sleep(1); \
    if ((++_sp & 255u) == 0u) { if (xb_ld(&(bar)[XB_TMO])) break; if (_sp > XB_SPIN_CAP) { atomicAdd(&(bar)[XB_TMO], 1u); break; } } } } while (0)
struct XcdBarrier { unsigned* bar; unsigned x; volatile LAS unsigned* st; int wave; };
__device__ __forceinline__ XcdBarrier xcd_barrier_post(unsigned* bar, volatile LAS unsigned* st) {
    XcdBarrier b; b.bar = bar; b.x = xb_xcc_id(); b.st = st;
    if (threadIdx.x == 0) (void)xb_add(&bar[XB_XCNT(b.x)], 1u);
    return b;
}
__device__ __forceinline__ void xcd_barrier_complete(unsigned* bar, unsigned x, unsigned& nloc, unsigned& nx) {
    const unsigned G = gridDim.x * gridDim.y * gridDim.z;
    unsigned sum, cnt, mine, sp = 0u;
    for (;;) {
        sum = 0u; cnt = 0u; mine = 0u;
#pragma unroll
        for (unsigned j = 0; j < 16; ++j) { const unsigned c = xb_ld(&bar[XB_XCNT(j)]); sum += c; cnt += (c > 0u) ? 1u : 0u; mine = (j == x) ? c : mine; }
        if (sum == G) break;
        __builtin_amdgcn_s_sleep(1);
        if ((++sp & 255u) == 0u) { if (xb_ld(&bar[XB_TMO])) break; if (sp > XB_SPIN_CAP) { atomicAdd(&bar[XB_TMO], 1u); break; } }
    }
    nloc = mine > 0u ? mine : 1u; nx = cnt > 0u ? cnt : 1u;
}
__device__ __forceinline__ void xcd_barrier(const XcdBarrier& b) {
    asm volatile("s_waitcnt vmcnt(0)" ::: "memory");
    __syncthreads();
    if (b.wave == 0 && __builtin_amdgcn_mbcnt_hi(~0u, __builtin_amdgcn_mbcnt_lo(~0u, 0u)) == 0u) {
        unsigned* bar = b.bar;
        __builtin_amdgcn_s_waitcnt(0);
        unsigned nloc = b.st[0], nx = b.st[1];
        if (nloc == 0u) { xcd_barrier_complete(bar, b.x, nloc, nx); b.st[0] = nloc; b.st[1] = nx; }
        const unsigned old = xb_add(&bar[XB_XSUB(b.x)], 1u);
        const unsigned gen = old / nloc;
        if (old + 1u == (gen + 1u) * nloc) {
            __builtin_amdgcn_fence(__ATOMIC_RELEASE, "agent");
            asm volatile("s_waitcnt vmcnt(0)" ::: "memory");
            const unsigned og = xb_add(&bar[XB_TOP], 1u);
            const unsigned tg = og / nx;
            if (og + 1u == (tg + 1u) * nx) xb_add(&bar[XB_TOPGEN], 1u);
            else XB_SPIN(xb_ld(&bar[XB_TOPGEN]) == tg, bar);
            __builtin_amdgcn_fence(__ATOMIC_ACQUIRE, "agent");
            xb_add(&bar[XB_XGEN(b.x)], 1u);
            asm volatile("s_waitcnt vmcnt(0)" ::: "memory");
        } else {
            XB_SPIN(xb_ld(&bar[XB_XGEN(b.x)]) == gen, bar);
            __builtin_amdgcn_fence(__ATOMIC_ACQUIRE, "agent");
            asm volatile("s_waitcnt vmcnt(0)" ::: "memory");
        }
    }
    __syncthreads();
}

#ifndef DSA_XREP
#define DSA_XREP 0
#define DSA_XF 0
#endif
#ifndef DSA_REP_P1
#define DSA_REP_P1 1
#endif
#ifndef DSA_REP_P2
#define DSA_REP_P2 1
#endif
#ifndef DSA_REP_ATT
#define DSA_REP_ATT 1
#endif
__device__ __forceinline__ int opaque_int(int n) { asm volatile("" : "+s"(n)); return n; }
__device__ __forceinline__ int ph_reps(int k) { int n = ((REP_MASK >> k) & 1u) ? REP_N : 1; asm volatile("" : "+s"(n)); return n; }
struct Args { const float* in[26]; float* out; unsigned char* ws; int ph_lo, ph_hi; };
enum { I_X = 0, I_C, I_ADAW, I_ADAB, I_NORMG, I_WG, I_WU, I_WDN, I_ABWIN, I_LRE, I_LIM, I_LOGDT, I_BRE, I_BIM, I_CRE, I_CIM, I_S5D, I_WGLU, I_BGLU, I_KVG, I_WKVUP, I_ABWOUT,
       I_CWQKV, I_RELB, I_CWOUT, I_FING };

__device__ __forceinline__ void tr_item(const float* src, int ldsrc, int nvalid, int k0, int n0, bf16* dst, int lddst, LAS float* scr, int lane) {
    const int nn = n0 + (lane & 31); const bool ok = nn < nvalid;
#pragma unroll 8
    for (int i = 0; i < 32; ++i) { const int kk = 2 * i + (lane >> 5); scr[kk * 33 + (lane & 31)] = ok ? src[(size_t)(k0 + kk) * ldsrc + nn] : 0.f; }
    LDS_WAIT(); asm volatile("" ::: "memory");
    const int c = lane & 7;
#pragma unroll
    for (int j = 0; j < 4; ++j) { const int n = (lane >> 3) + 8 * j; const LAS float* s = scr + (8 * c) * 33 + n;
        u32x4 o; o.x = pk2(s[0 * 33], s[1 * 33]); o.y = pk2(s[2 * 33], s[3 * 33]); o.z = pk2(s[4 * 33], s[5 * 33]); o.w = pk2(s[6 * 33], s[7 * 33]);
        if (n0 + n < nvalid) *(u32x4*)(dst + (size_t)n * lddst + 8 * c) = o; }
    LDS_WAIT(); asm volatile("" ::: "memory");
}

__device__ __forceinline__ void tr_item8(const float* src, int ldsrc, int k0, int n0, unsigned char* dst, int lddst, float scale, LAS float* scr, int lane) {
    const int nn = n0 + (lane & 31);
#pragma unroll 8
    for (int i = 0; i < 32; ++i) { const int kk = 2 * i + (lane >> 5); scr[kk * 33 + (lane & 31)] = src[(size_t)(k0 + kk) * ldsrc + nn] * scale; }
    LDS_WAIT(); asm volatile("" ::: "memory");
    const int n = lane & 31, kh = lane >> 5; const LAS float* sp = scr + (32 * kh) * 33 + n;
    u32x4 o0, o1;
    o0.x = pk4_fp8(sp[0 * 33], sp[1 * 33], sp[2 * 33], sp[3 * 33]); o0.y = pk4_fp8(sp[4 * 33], sp[5 * 33], sp[6 * 33], sp[7 * 33]);
    o0.z = pk4_fp8(sp[8 * 33], sp[9 * 33], sp[10 * 33], sp[11 * 33]); o0.w = pk4_fp8(sp[12 * 33], sp[13 * 33], sp[14 * 33], sp[15 * 33]);
    o1.x = pk4_fp8(sp[16 * 33], sp[17 * 33], sp[18 * 33], sp[19 * 33]); o1.y = pk4_fp8(sp[20 * 33], sp[21 * 33], sp[22 * 33], sp[23 * 33]);
    o1.z = pk4_fp8(sp[24 * 33], sp[25 * 33], sp[26 * 33], sp[27 * 33]); o1.w = pk4_fp8(sp[28 * 33], sp[29 * 33], sp[30 * 33], sp[31 * 33]);
    unsigned char* d = dst + (size_t)n * lddst + 32 * kh;
    *(u32x4*)d = o0; *(u32x4*)(d + 16) = o1;
    LDS_WAIT(); asm volatile("" ::: "memory");
}

template <bool FP8>
__device__ __forceinline__ void tr_item64(const float* src, int ldsrc, int k0, int n0, void* dst, int lddst, float scale, LAS float* scr, int lane) {
    const float* sp = src + (size_t)(k0 + (lane >> 4)) * ldsrc + n0 + 4 * (lane & 15);
    f32x4 v[16];
#pragma unroll
    for (int i = 0; i < 16; ++i) v[i] = *(const f32x4*)(sp + (size_t)(4 * i) * ldsrc);
#pragma unroll
    for (int i = 0; i < 16; ++i) { LAS float* w = scr + (4 * i + (lane >> 4)) * 65 + 4 * (lane & 15); w[0] = v[i].x * scale; w[1] = v[i].y * scale; w[2] = v[i].z * scale; w[3] = v[i].w * scale; }
    LDS_WAIT(); asm volatile("" ::: "memory");
    if (FP8) {
        const int c = lane & 3;
#pragma unroll
        for (int j = 0; j < 4; ++j) { const int n = 16 * j + (lane >> 2); const LAS float* r = scr + (16 * c) * 65 + n;
            u32x4 o; o.x = pk4_fp8(r[0], r[65], r[130], r[195]); o.y = pk4_fp8(r[260], r[325], r[390], r[455]); o.z = pk4_fp8(r[520], r[585], r[650], r[715]); o.w = pk4_fp8(r[780], r[845], r[910], r[975]);
            *(u32x4*)((unsigned char*)dst + (size_t)n * lddst + 16 * c) = o; }
    } else {
        const int c = lane & 7;
#pragma unroll
        for (int j = 0; j < 8; ++j) { const int n = 8 * j + (lane >> 3); const LAS float* r = scr + (8 * c) * 65 + n;
            u32x4 o; o.x = pk2(r[0], r[65]); o.y = pk2(r[130], r[195]); o.z = pk2(r[260], r[325]); o.w = pk2(r[390], r[455]);
            *(u32x4*)((bf16*)dst + (size_t)n * lddst + 8 * c) = o; }
    }
    LDS_WAIT(); asm volatile("" ::: "memory");
}

__device__ __forceinline__ void p0_prologue(const Args& a, LAS unsigned char* lds, int G, int wave_s) {
    int lane_o = (int)__builtin_amdgcn_mbcnt_hi(~0u, __builtin_amdgcn_mbcnt_lo(~0u, 0u)); asm volatile("" : "+v"(lane_o)); const int lane = lane_o, wave = wave_s, tid_o = wave_s * 64 + lane_o;
    unsigned char* ws = a.ws;
    const int tid = tid_o;
    {
        LAS float* cond = (LAS float*)(lds + 131072); LAS float* red = (LAS float*)(lds + 131072 + 8192);
        for (int k = tid; k < DM; k += NTHR) cond[k] = silu_f(a.in[I_C][k]);
        __syncthreads();
        float* mod = (float*)(ws + WS_MOD);
        for (int u = blockIdx.x; u < 144; u += G) {
            const int layer = u / 72, col0 = (u % 72) * 256 + 4 * lane;
            const float* w = a.in[I_ADAW] + (size_t)layer * DM * NMOD + (size_t)(wave * 256) * NMOD + col0;
            f32x4 s4 = (f32x4){0.f, 0.f, 0.f, 0.f};
#pragma unroll 16
            for (int k = 0; k < 256; ++k) { const f32x4 v = *(const f32x4*)(w + (size_t)k * NMOD); s4 += v * cond[wave * 256 + k]; }
            *(LAS f32x4*)(red + wave * 256 + 4 * lane) = s4;
            __syncthreads();
            if (tid < 256) { float s = 0.f;
#pragma unroll
                for (int w8 = 0; w8 < 8; ++w8) s += red[w8 * 256 + tid];
                const int n = (u % 72) * 256 + tid; mod[layer * NMOD + n] = s + a.in[I_ADAB][layer * NMOD + n]; }
            __syncthreads();
        }
    }
    LAS float* scr = (LAS float*)(lds + wave * 16640);
    const int gw = blockIdx.x * NWAVES + wave, NGW = G * NWAVES;
    unsigned char* Wgu = ws + WS_WGU; unsigned char* Wd = ws + WS_WD; bf16* Win = (bf16*)(ws + WS_WIN); bf16* Wglu = (bf16*)(ws + WS_WGLU);
    bf16* Wout = (bf16*)(ws + WS_WOUT); bf16* Woutb = (bf16*)(ws + WS_WOUTB); bf16* Wqkv = (bf16*)(ws + WS_WQKV); bf16* Wcout = (bf16*)(ws + WS_WCOUT);
    constexpr int I_FFN = 4 * 3 * 2752, I_IN = 32 * 107, I_GLU = 16 * 16, I_OUT = 32 * 32, I_QKV = 32 * 96, I_CO = 32 * 32;
    constexpr int NITEMS = I_FFN + I_IN + I_GLU + I_OUT + I_QKV + I_CO;
    for (int it = gw; it < NITEMS; it += NGW) {
        int r = it;
        if (r < I_FFN) {
            const int f = r / 8256, rr = r % 8256, which = rr / 2752, q = rr % 2752;
            if (which < 2) { const int kb = q / 86, nb = q % 86, n0 = 64 * nb, k0 = 64 * kb;
                const float* src = a.in[which ? I_WU : I_WG] + (size_t)f * DM * FF;
                const int row = 256 * (n0 / 128) + (n0 % 128) + 128 * which;
                tr_item64<true>(src, FF, k0, n0, Wgu + (size_t)f * NGU * DM + (size_t)row * DM + k0, DM, 64.0f, scr, lane);
            } else { const int kb = q / 32, nb = q % 32, n0 = 64 * nb, k0 = 64 * kb;
                const float* src = a.in[I_WDN] + (size_t)f * FF * DM;
                tr_item64<true>(src, DM, k0, n0, Wd + (size_t)f * DM * FFP + (size_t)n0 * FFP + k0, FFP, 128.0f, scr, lane); }
            continue; }
        r -= I_FFN;
        if (r < I_IN) { const int kb = r / 107, nb = r % 107, n0 = 32 * nb, k0 = 64 * kb;
            if (n0 >= 1024 && n0 < 2048) continue;
            const int row = n0 + (n0 >= 2048 ? 1024 : 0);
            tr_item(a.in[I_ABWIN], 3408, 3408, k0, n0, Win + (size_t)row * DM + k0, DM, scr, lane); continue; }
        r -= I_IN;
        if (r < I_GLU) { const int kb = r / 16, nb = r % 16, n0 = 64 * nb, k0 = 64 * kb;
            tr_item64<false>(a.in[I_WGLU], 1024, k0, n0, Wglu + (size_t)n0 * 1024 + k0, 1024, 1.0f, scr, lane); continue; }
        r -= I_GLU;
        if (r < I_OUT) { const int kb = r / 32, nb = r % 32, n0 = 64 * nb, k0 = 64 * kb;
            if (k0 < 1024) tr_item64<false>(a.in[I_ABWOUT], DM, k0, n0, Wout + (size_t)n0 * NCAT + k0, NCAT, 1.0f, scr, lane);
            else           tr_item64<false>(a.in[I_ABWOUT], DM, k0, n0, Woutb + (size_t)n0 * DM + k0, DM, 1.0f, scr, lane);
            continue; }
        r -= I_OUT;
        if (r < I_QKV) { const int kb = r / 96, nb = r % 96, n0 = 64 * nb, k0 = 64 * kb;
            tr_item64<false>(a.in[I_CWQKV], 6144, k0, n0, Wqkv + (size_t)n0 * DM + k0, DM, 1.0f, scr, lane); continue; }
        r -= I_QKV;
        { const int kb = r / 32, nb = r % 32, n0 = 64 * nb, k0 = 64 * kb;
            tr_item64<false>(a.in[I_CWOUT], DM, k0, n0, Wcout + (size_t)n0 * DM + k0, DM, 1.0f, scr, lane); }
    }
    {
        const int gt = blockIdx.x * NTHR + tid, NGT = G * NTHR;
        bf16* Wqraw = (bf16*)(ws + WS_WQRAW); bf16* Wupraw = (bf16*)(ws + WS_WUPRAW);
        for (int i = gt; i < 2048 * 256; i += NGT) { const int k = i >> 8, d4 = (i & 255) * 4; const f32x4 v = *(const f32x4*)(a.in[I_ABWIN] + (size_t)k * 3408 + 1024 + d4);
            u32x2 o; o.x = pk2(v.x, v.y); o.y = pk2(v.z, v.w); *(u32x2*)(Wqraw + (size_t)k * DM + d4) = o; }
        for (int i = gt; i < 256 * 512; i += NGT) { const f32x4 v = *(const f32x4*)(a.in[I_WKVUP] + (size_t)i * 4);
            u32x2 o; o.x = pk2(v.x, v.y); o.y = pk2(v.z, v.w); *(u32x2*)(Wupraw + (size_t)i * 4) = o; }
        for (int i = gt; i < (NIN - 4432) * DM / 8; i += NGT) *(u32x4*)(Win + (size_t)4432 * DM + (size_t)i * 8) = (u32x4){0u, 0u, 0u, 0u};
        for (int i = gt; i < 4 * DM * 8; i += NGT) *(u32x4*)(Wd + (size_t)(i >> 3) * FFP + FF + 16 * (i & 7)) = (u32x4){0u, 0u, 0u, 0u};
        for (int i = gt; i < SEQ * 8; i += NGT) *(u32x4*)(ws + WS_HMID + (size_t)(i >> 3) * FFP + FF + 16 * (i & 7)) = (u32x4){0u, 0u, 0u, 0u};
        if (gt < 4096) { const int g = gt >> 6;
            const double dt = exp((double)a.in[I_LOGDT][g]); const double lr = a.in[I_LRE][gt], li = a.in[I_LIM][gt];
            const double mag = exp(lr * dt), ar = mag * cos(li * dt), ai = mag * sin(li * dt);
            const double den = lr * lr + li * li, nr = ar - 1.0, fre = (nr * lr + ai * li) / den, fim = (ai * lr - nr * li) / den;
            const double m64 = exp(64.0 * lr * dt), a64r = m64 * cos(64.0 * li * dt), a64i = m64 * sin(64.0 * li * dt);
            float* T = (float*)(ws + WS_S5T);
            T[S5_AR + gt] = (float)ar; T[S5_AI + gt] = (float)ai; T[S5_A64R + gt] = (float)a64r; T[S5_A64I + gt] = (float)a64i;
            for (int c = 0; c < 16; ++c) { const double br = a.in[I_BRE][gt * 16 + c], bi = a.in[I_BIM][gt * 16 + c];
                T[S5_BBR + gt * 16 + c] = (float)(fre * br - fim * bi); T[S5_BBI + gt * 16 + c] = (float)(fre * bi + fim * br); }
        }
    }
}

template <bool FINAL, bool OUT8 = false>
__device__ __forceinline__ void norm_phase(const float* hin, const float* gvec, const float* shift, const float* scale, bf16* hn, float* fout, int G, int wave_s) {
    int lane_o = (int)__builtin_amdgcn_mbcnt_hi(~0u, __builtin_amdgcn_mbcnt_lo(~0u, 0u)); asm volatile("" : "+v"(lane_o)); const int lane = lane_o, wave = wave_s, tid_o = wave_s * 64 + lane_o;
    const int gw = blockIdx.x * NWAVES + wave, NGW = G * NWAVES;
    f32x4 gs[8], sh[8];
#pragma unroll
    for (int j = 0; j < 8; ++j) { const int c = 4 * lane + 256 * j; const f32x4 gg = *(const f32x4*)(gvec + c);
        if (FINAL) { gs[j] = gg; sh[j] = (f32x4){0.f, 0.f, 0.f, 0.f}; }
        else { const f32x4 sc = *(const f32x4*)(scale + c); gs[j] = gg * (sc + 1.0f); sh[j] = *(const f32x4*)(shift + c); } }
    for (int m = gw; m < SEQ; m += NGW) {
        const f32x4* xr = (const f32x4*)(hin + (size_t)m * DM) + lane;
        f32x4 v[8]; float s = 0.f;
#pragma unroll
        for (int j = 0; j < 8; ++j) { v[j] = xr[64 * j]; s += (v[j].x * v[j].x + v[j].y * v[j].y) + (v[j].z * v[j].z + v[j].w * v[j].w); }
        const float rstd = 1.0f / sqrtf(wave_sum(s) * (1.0f / DM) + 1e-6f);
        if (FINAL) { f32x4* o = (f32x4*)(fout + (size_t)m * DM) + lane;
#pragma unroll
            for (int j = 0; j < 8; ++j) o[64 * j] = v[j] * rstd * gs[j];
        } else if (OUT8) { unsigned* o = (unsigned*)((unsigned char*)hn + (size_t)m * DM) + lane;
#pragma unroll
            for (int j = 0; j < 8; ++j) { const f32x4 y = (v[j] * rstd * gs[j] + sh[j]) * 8.0f; o[64 * j] = pk4_fp8(y.x, y.y, y.z, y.w); }
        } else { u32x2* o = (u32x2*)(hn + (size_t)m * DM) + lane;
#pragma unroll
            for (int j = 0; j < 8; ++j) { const f32x4 y = v[j] * rstd * gs[j] + sh[j]; u32x2 w; w.x = pk2(y.x, y.y); w.y = pk2(y.z, y.w); o[64 * j] = w; } }
    }
}

__device__ __forceinline__ void s5_stage_u(const bf16* proj, int g, int j, LAS float* ut, int lane) {
    const u32x4* p = (const u32x4*)(proj + (size_t)(64 * j + lane) * NIN + C_U + 16 * g);
    const u32x4 a = p[0], b = p[1];
    LAS f32x4* o = (LAS f32x4*)(ut + lane * 16);
    o[0] = (f32x4){bflo(a.x), bfhi(a.x), bflo(a.y), bfhi(a.y)}; o[1] = (f32x4){bflo(a.z), bfhi(a.z), bflo(a.w), bfhi(a.w)};
    o[2] = (f32x4){bflo(b.x), bfhi(b.x), bflo(b.y), bfhi(b.y)}; o[3] = (f32x4){bflo(b.z), bfhi(b.z), bflo(b.w), bfhi(b.w)};
    LDS_WAIT(); asm volatile("" ::: "memory");
}
__device__ __forceinline__ void phase_a2(const Args& a, LAS unsigned char* lds, int G, int wave_s) {
    int lane_o = (int)__builtin_amdgcn_mbcnt_hi(~0u, __builtin_amdgcn_mbcnt_lo(~0u, 0u)); asm volatile("" : "+v"(lane_o)); const int lane = lane_o, wave = wave_s, tid_o = wave_s * 64 + lane_o;
    unsigned char* ws = a.ws; const bf16* proj = (const bf16*)(ws + WS_PROJ);
    const int gw = blockIdx.x * NWAVES + wave, NGW = G * NWAVES;
    { bf16* kvn = (bf16*)(ws + WS_KVN); const f32x4 gg = *(const f32x4*)(a.in[I_KVG] + 4 * lane);
      for (int m = gw; m < SEQ; m += NGW) { const u32x2 w = *(const u32x2*)(proj + (size_t)m * NIN + C_KVL + 4 * lane);
          const f32x4 v = (f32x4){bflo(w.x), bfhi(w.x), bflo(w.y), bfhi(w.y)};
          const float s = wave_sum((v.x * v.x + v.y * v.y) + (v.z * v.z + v.w * v.w)); const float rstd = 1.0f / sqrtf(s * (1.0f / 256.0f) + 1e-6f);
          const f32x4 y = v * rstd * gg; u32x2 o; o.x = pk2(y.x, y.y); o.y = pk2(y.z, y.w); *(u32x2*)(kvn + (size_t)m * 256 + 4 * lane) = o; } }
    const float* T = (const float*)(ws + WS_S5T); float* E = (float*)(ws + WS_E);
    LAS float* ut = (LAS float*)(lds + wave * 8192);
    for (int u = gw; u < 64 * 128; u += NGW) { const int g = u & 63, j = u >> 6, sp = g * 64 + lane;
        s5_stage_u(proj, g, j, ut, lane);
        const float ar = T[S5_AR + sp], ai = T[S5_AI + sp];
        float bbr[16], bbi[16];
#pragma unroll
        for (int c4 = 0; c4 < 4; ++c4) { const f32x4 r = *(const f32x4*)(T + S5_BBR + sp * 16 + 4 * c4), i = *(const f32x4*)(T + S5_BBI + sp * 16 + 4 * c4);
            bbr[4 * c4] = r.x; bbr[4 * c4 + 1] = r.y; bbr[4 * c4 + 2] = r.z; bbr[4 * c4 + 3] = r.w; bbi[4 * c4] = i.x; bbi[4 * c4 + 1] = i.y; bbi[4 * c4 + 2] = i.z; bbi[4 * c4 + 3] = i.w; }
        float xr = 0.f, xi = 0.f;
        for (int t = 0; t < 64; ++t) { const LAS f32x4* up = (const LAS f32x4*)(ut + t * 16); float bur = 0.f, bui = 0.f;
#pragma unroll
            for (int c4 = 0; c4 < 4; ++c4) { const f32x4 uv = up[c4];
                bur += bbr[4 * c4] * uv.x + bbr[4 * c4 + 1] * uv.y + bbr[4 * c4 + 2] * uv.z + bbr[4 * c4 + 3] * uv.w;
                bui += bbi[4 * c4] * uv.x + bbi[4 * c4 + 1] * uv.y + bbi[4 * c4 + 2] * uv.z + bbi[4 * c4 + 3] * uv.w; }
            const float nr = ar * xr - ai * xi + bur, ni = ar * xi + ai * xr + bui; xr = nr; xi = ni; }
        E[(size_t)(g * 128 + j) * 64 + lane] = xr; E[(size_t)(64 * 128 * 64) + (size_t)(g * 128 + j) * 64 + lane] = xi;
        LDS_WAIT(); asm volatile("" ::: "memory");
    }
}

__device__ __forceinline__ void s5_scan_out(const Args& a, LAS unsigned char* lds, int G, int wave_s) {
    int lane_o = (int)__builtin_amdgcn_mbcnt_hi(~0u, __builtin_amdgcn_mbcnt_lo(~0u, 0u)); asm volatile("" : "+v"(lane_o)); const int lane = lane_o, wave = wave_s, tid_o = wave_s * 64 + lane_o;
    unsigned char* ws = a.ws; const bf16* proj = (const bf16*)(ws + WS_PROJ);
    const int gw = blockIdx.x * NWAVES + wave, NGW = G * NWAVES;
    const float* T = (const float*)(ws + WS_S5T); const float* E = (const float*)(ws + WS_E); bf16* yap = (bf16*)(ws + WS_YAPRE);
    LAS float* ut = (LAS float*)(lds + wave * 16384);
    LAS unsigned char* X = lds + wave * 16384 + 4096;
    const int fr = lane & 15, fq = lane >> 4;
    for (int wu = gw; wu < 2048; wu += NGW) { const int g = wu & 63, jb = (wu >> 6) * 4, sp = g * 64 + lane;
        const float ar = T[S5_AR + sp], ai = T[S5_AI + sp], a64r = T[S5_A64R + sp], a64i = T[S5_A64I + sp];
        float bbr[16], bbi[16];
#pragma unroll
        for (int c4 = 0; c4 < 4; ++c4) { const f32x4 r = *(const f32x4*)(T + S5_BBR + sp * 16 + 4 * c4), i = *(const f32x4*)(T + S5_BBI + sp * 16 + 4 * c4);
            bbr[4 * c4] = r.x; bbr[4 * c4 + 1] = r.y; bbr[4 * c4 + 2] = r.z; bbr[4 * c4 + 3] = r.w; bbi[4 * c4] = i.x; bbi[4 * c4 + 1] = i.y; bbi[4 * c4 + 2] = i.z; bbi[4 * c4 + 3] = i.w; }
        bf16x8 cf[4];
#pragma unroll
        for (int ks = 0; ks < 4; ++ks) { const int k0 = 32 * ks + 8 * fq; const bool im = k0 >= 64; const float* src = a.in[im ? I_CIM : I_CRE] + (size_t)(g * 16 + fr) * 64 + (k0 & 63);
            const f32x4 v0 = *(const f32x4*)src, v1 = *(const f32x4*)(src + 4); const float sg = im ? -1.f : 1.f;
            u32x4 w; w.x = pk2(sg * v0.x, sg * v0.y); w.y = pk2(sg * v0.z, sg * v0.w); w.z = pk2(sg * v1.x, sg * v1.y); w.w = pk2(sg * v1.z, sg * v1.w);
            cf[ks] = __builtin_bit_cast(bf16x8, w); }
        const float dsk = a.in[I_S5D][g * 16 + fr];
        float xr = 0.f, xi = 0.f;
        for (int i = 0; i < jb; i += 4) { float er[4], ei[4];
#pragma unroll
            for (int q = 0; q < 4; ++q) { er[q] = E[(size_t)(g * 128 + i + q) * 64 + lane]; ei[q] = E[(size_t)(64 * 128 * 64) + (size_t)(g * 128 + i + q) * 64 + lane]; }
#pragma unroll
            for (int q = 0; q < 4; ++q) { const float nr = a64r * xr - a64i * xi + er[q], ni = a64r * xi + a64i * xr + ei[q]; xr = nr; xi = ni; } }
#pragma unroll 1
        for (int jj = 0; jj < 4; ++jj) { const int j = jb + jj;
        s5_stage_u(proj, g, j, ut, lane);
        for (int tt = 0; tt < 4; ++tt) {
            for (int t16 = 0; t16 < 16; ++t16) { const LAS f32x4* up = (const LAS f32x4*)(ut + (16 * tt + t16) * 16); float bur = 0.f, bui = 0.f;
#pragma unroll
                for (int c4 = 0; c4 < 4; ++c4) { const f32x4 uv = up[c4];
                    bur += bbr[4 * c4] * uv.x + bbr[4 * c4 + 1] * uv.y + bbr[4 * c4 + 2] * uv.z + bbr[4 * c4 + 3] * uv.w;
                    bui += bbi[4 * c4] * uv.x + bbi[4 * c4 + 1] * uv.y + bbi[4 * c4 + 2] * uv.z + bbi[4 * c4 + 3] * uv.w; }
                const float nr = ar * xr - ai * xi + bur, ni = ar * xi + ai * xr + bui; xr = nr; xi = ni;
                *(LAS unsigned short*)(X + t16 * 272 + 2 * lane) = (unsigned short)f2bf(xr); *(LAS unsigned short*)(X + t16 * 272 + 128 + 2 * lane) = (unsigned short)f2bf(xi); }
            LDS_WAIT(); asm volatile("" ::: "memory");
            f32x4 acc = (f32x4){0.f, 0.f, 0.f, 0.f};
#pragma unroll
            for (int ks = 0; ks < 4; ++ks) { const bf16x8 af = *(const LAS bf16x8*)(X + fr * 272 + 64 * ks + 16 * fq); acc = __builtin_amdgcn_mfma_f32_16x16x32_bf16(af, cf[ks], acc, 0, 0, 0); }
#pragma unroll
            for (int r = 0; r < 4; ++r) { const int tl = 16 * tt + 4 * fq + r; const float y = acc[r] + dsk * ut[tl * 16 + fr];
                yap[(size_t)(64 * j + tl) * 1024 + 16 * g + fr] = (bf16)f2bf(gelu_tanh_f(y)); }
            LDS_WAIT(); asm volatile("" ::: "memory");
        }
        }
    }
}

__device__ __forceinline__ void lds_add(LAS unsigned* p, unsigned v) { (void)__hip_atomic_fetch_add(p, v, __ATOMIC_RELAXED, __HIP_MEMORY_SCOPE_WORKGROUP); }
__device__ __forceinline__ float relu_i(float x) { int xi = __builtin_bit_cast(int, x); xi = xi > 0 ? xi : 0; return __builtin_bit_cast(float, xi); }
__device__ __forceinline__ unsigned ord_key(float s) { const unsigned u = __builtin_bit_cast(unsigned, s); return u ^ ((u >> 31) ? 0xFFFFFFFFu : 0x80000000u); }
template <int NB, bool PACKED>
__device__ __forceinline__ void hist_search(const LAS unsigned* hist, int field, unsigned need, int lane, int& bstar, unsigned& above) {
    constexpr int PER = NB / 64;
    const int sh = PACKED ? 16 * field : 0; const unsigned fm = PACKED ? 0xffffu : 0xffffffffu;
    unsigned tot = 0;
#pragma unroll 4
    for (int i = 0; i < PER; i += 4) { const u32x4 h = *(const LAS u32x4*)(hist + lane * PER + i); tot += ((h.x >> sh) & fm) + ((h.y >> sh) & fm) + ((h.z >> sh) & fm) + ((h.w >> sh) & fm); }
    unsigned incl = tot;
#pragma unroll
    for (int o = 1; o < 64; o <<= 1) { const unsigned v = __shfl_down(incl, o); if (lane + o < 64) incl += v; }
    const unsigned excl = incl - tot;
    const unsigned long long mask = __ballot(incl >= need);
    const int lstar = 63 - __builtin_clzll(mask | 1ull);
    unsigned cum = excl; int b = -1; unsigned ab = 0;
#pragma unroll 1
    for (int i = PER - 4; i >= 0; i -= 4) { const u32x4 h = *(const LAS u32x4*)(hist + lane * PER + i);
        const unsigned c3 = (h.w >> sh) & fm, c2 = (h.z >> sh) & fm, c1 = (h.y >> sh) & fm, c0 = (h.x >> sh) & fm;
        if (b < 0) { if (cum + c3 >= need) { b = lane * PER + i + 3; ab = cum; } else cum += c3; }
        if (b < 0) { if (cum + c2 >= need) { b = lane * PER + i + 2; ab = cum; } else cum += c2; }
        if (b < 0) { if (cum + c1 >= need) { b = lane * PER + i + 1; ab = cum; } else cum += c1; }
        if (b < 0) { if (cum + c0 >= need) { b = lane * PER + i + 0; ab = cum; } else cum += c0; } }
    bstar = __shfl(b, lstar); above = __shfl(ab, lstar);
}

template <int MODE, int XF = 0>
__device__ __forceinline__ void dsa_pass(const bf16* proj, LAS unsigned char* lds, LAS unsigned char* wl, int nadm, int tid, int lane, const bf16x8 (&qa)[4], const float (&wv)[16],
                                         unsigned myb, unsigned& ns0, unsigned& ns1, unsigned& nc0, unsigned& nc1, float* srow = nullptr) {
    const int l31 = lane & 31, hh = lane >> 5;
    LAS unsigned* hist = (LAS unsigned*)wl; LAS unsigned* cok = (LAS unsigned*)wl; LAS int* cix = (LAS int*)(wl + 4096); LAS int* sel = (LAS int*)(wl + 16896);
    const int skey = tid >> 3, ssub = tid & 7;
    const bf16* gsrc = proj + (size_t)skey * NIN + C_KI + 8 * ssub;
    const int sdst = ((skey >> 5) * 18944) + 8192 + (skey & 31) * 128 + ((ssub ^ (skey & 7)) * 16);
    const int nch = (nadm + 127) / 128;
#define DSA_LD(c_, r0_, r1_) do { const int cc_ = (c_) < nch ? (c_) : nch - 1; r0_ = *(const u32x4*)(gsrc + (size_t)(128 * cc_) * NIN); r1_ = *(const u32x4*)(gsrc + (size_t)(128 * cc_ + 64) * NIN); } while (0)
    u32x4 stg0, stg1, sA0, sA1, sB0, sB1, sC0, sC1;
    DSA_LD(0, stg0, stg1); DSA_LD(1, sA0, sA1); DSA_LD(2, sB0, sB1); DSA_LD(3, sC0, sC1);
    if (!(XF & 2)) { *(LAS u32x4*)(lds + sdst) = stg0; *(LAS u32x4*)(lds + sdst + 2 * 18944) = stg1; }
    __syncthreads();
    for (int ch = 0; ch < nch; ++ch) {
        if (!(XF & 2)) { stg0 = sA0; stg1 = sA1; sA0 = sB0; sA1 = sB1; sB0 = sC0; sB1 = sC1; DSA_LD(ch + 4, sC0, sC1); }
        {
            const bool full = 128 * ch + 64 < nadm;
            const LAS unsigned char* tb = lds + ((ch & 1) * 4) * 18944 + 8192 + l31 * 128;
            f32x16 acc[4];
#pragma unroll
            for (int tl = 0; tl < 4; ++tl)
#pragma unroll
                for (int i = 0; i < 16; ++i) acc[tl][i] = 0.f;
#pragma unroll
            for (int tl = 0; tl < 4; ++tl) { if (tl < 2 || full) {
#pragma unroll
                for (int ks = 0; ks < 4; ++ks) { const bf16x8 kf = *(const LAS bf16x8*)(tb + tl * 18944 + (((2 * ks + hh) ^ (l31 & 7)) * 16));
                    if (!(XF & 8)) acc[tl] = __builtin_amdgcn_mfma_f32_32x32x16_bf16(qa[ks], kf, acc[tl], 0, 0, 0); else acc[tl][ks] += __builtin_bit_cast(float, (int)kf[0] << 16); } } }
#pragma unroll
            for (int tl = 0; tl < 4; ++tl) { if (tl < 2 || full) {
                float s0 = 0.f, s1 = 0.f;
#pragma unroll
                for (int i = 0; i < ((XF & 16) ? 2 : 16); i += 2) { s0 += wv[i] * relu_i(acc[tl][i]); s1 += wv[i + 1] * relu_i(acc[tl][i + 1]); }
                const unsigned ok = ord_key(s0 + s1), bin = ok >> 21;
                if (MODE == 1) { lds_add(&hist[bin], 1u << (16 * hh)); __builtin_nontemporal_store(s0 + s1, srow + 128 * ch + 32 * tl + l31); }
                else if (MODE == 3) { if (!(XF & 1)) lds_add(&hist[bin], 0u); else asm volatile("" :: "v"(bin)); }
                else {
                    const int key = 128 * ch + 32 * tl + l31;
                    const bool isel = bin > myb, icand = bin == myb;
                    const unsigned long long ms = __ballot(isel), mc = __ballot(icand);
                    const unsigned ms0 = (unsigned)ms, ms1 = (unsigned)(ms >> 32), mc0 = (unsigned)mc, mc1 = (unsigned)(mc >> 32);
                    const unsigned lowm = (1u << l31) - 1u;
                    const unsigned ps = (hh ? ns1 + (unsigned)__builtin_popcount(ms1 & lowm) : ns0 + (unsigned)__builtin_popcount(ms0 & lowm));
                    const unsigned pc = (hh ? nc1 + (unsigned)__builtin_popcount(mc1 & lowm) : nc0 + (unsigned)__builtin_popcount(mc0 & lowm));
                    if (isel && ps < 256u) sel[hh * 256 + ps] = key;
                    if (icand && pc < 512u) { cok[hh * 512 + pc] = ok; cix[hh * 512 + pc] = key; }
                    ns0 += (unsigned)__builtin_popcount(ms0); ns1 += (unsigned)__builtin_popcount(ms1); nc0 += (unsigned)__builtin_popcount(mc0); nc1 += (unsigned)__builtin_popcount(mc1);
                }
            } }
        }
        if (!(XF & 2) && ch + 1 < nch) { const int bo = ((ch + 1) & 1) * 4 * 18944; *(LAS u32x4*)(lds + sdst + bo) = stg0; *(LAS u32x4*)(lds + sdst + bo + 2 * 18944) = stg1; }
        if (!(XF & 4)) __syncthreads();
    }
    if (XF & 4) __syncthreads();
#undef DSA_LD
}

__device__ __forceinline__ void dsa_phase(const Args& a, LAS unsigned char* lds, int G, int wave_s) {
    int lane_o = (int)__builtin_amdgcn_mbcnt_hi(~0u, __builtin_amdgcn_mbcnt_lo(~0u, 0u)); asm volatile("" : "+v"(lane_o)); const int lane = lane_o, wave = wave_s, tid_o = wave_s * 64 + lane_o;
    unsigned char* ws = a.ws; const bf16* proj = (const bf16*)(ws + WS_PROJ); const bf16* kvn = (const bf16*)(ws + WS_KVN);
    bf16* ycat = (bf16*)(ws + WS_YCAT);
    constexpr int WREG = 18944;
    LAS unsigned char* wl = lds + wave * WREG;
    LAS unsigned* hist = (LAS unsigned*)wl; LAS int* sel = (LAS int*)(wl + 16896);
    const int l31 = lane & 31, hh = lane >> 5, fr = lane & 15, fq = lane >> 4;
#if TIMING
    unsigned long long tseg[6] = {0, 0, 0, 0, 0, 0}, tlast = __builtin_amdgcn_s_memrealtime();
#define DSA_SEG(i_) do { const unsigned long long n_ = __builtin_amdgcn_s_memrealtime(); tseg[i_] += n_ - tlast; tlast = n_; } while (0)
#else
#define DSA_SEG(i_) do { } while (0)
#endif
    for (int un = blockIdx.x; un < 512; un += G) {
        __syncthreads();
        const int unit = (un < 256) ? un : 767 - un;
        const int t0 = unit * 16, tq = t0 + 2 * wave;
        const int nadm = ((t0 >> 6) + 1) * 64;
        if (nadm > 256) {
            bf16x8 qa[4];
            { const int r = l31, qq = (r >> 2) & 1, head = (r & 3) + 4 * (r >> 3);
              const bf16* qp = proj + (size_t)(tq + qq) * NIN + C_QI + head * 64 + 8 * hh;
#pragma unroll
              for (int ks = 0; ks < 4; ++ks) qa[ks] = *(const bf16x8*)(qp + 16 * ks); }
            float wv[16];
            { const u32x4 w0 = *(const u32x4*)(proj + (size_t)(tq + hh) * NIN + C_WI), w1 = *(const u32x4*)(proj + (size_t)(tq + hh) * NIN + C_WI + 8);
              const float sc = 1.0f / 32.0f;
              wv[0] = bflo(w0.x) * sc; wv[1] = bfhi(w0.x) * sc; wv[2] = bflo(w0.y) * sc; wv[3] = bfhi(w0.y) * sc; wv[4] = bflo(w0.z) * sc; wv[5] = bfhi(w0.z) * sc; wv[6] = bflo(w0.w) * sc; wv[7] = bfhi(w0.w) * sc;
              wv[8] = bflo(w1.x) * sc; wv[9] = bfhi(w1.x) * sc; wv[10] = bflo(w1.y) * sc; wv[11] = bfhi(w1.y) * sc; wv[12] = bflo(w1.z) * sc; wv[13] = bfhi(w1.z) * sc; wv[14] = bflo(w1.w) * sc; wv[15] = bfhi(w1.w) * sc; }
            unsigned ns0 = 0, ns1 = 0, nc0 = 0, nc1 = 0;
#if DSA_REP_P1 > 1
            for (int rp1 = 0, np1 = opaque_int(DSA_REP_P1); rp1 < np1; ++rp1)
#endif
            {
                for (int i = lane; i < 2048; i += 64) hist[i] = 0u;
                dsa_pass<1>(proj, lds, wl, nadm, tid_o, lane, qa, wv, 0u, ns0, ns1, nc0, nc1, (float*)(ws + WS_SCORE) + (size_t)(tq + hh) * SEQ);
            }
#if DSA_XREP > 0
            for (int rx = 0, nx = opaque_int(DSA_XREP); rx < nx; ++rx) dsa_pass<3, DSA_XF>(proj, lds, wl, nadm, tid_o, lane, qa, wv, 0u, ns0, ns1, nc0, nc1);
#endif
            DSA_SEG(1);
            int b1[2]; unsigned ab1[2];
            hist_search<2048, true>(hist, 0, 256u, lane, b1[0], ab1[0]);
            hist_search<2048, true>(hist, 1, 256u, lane, b1[1], ab1[1]);
            asm volatile("" ::: "memory");
            DSA_SEG(2);
            LAS unsigned* cok = (LAS unsigned*)wl; LAS int* cix = (LAS int*)(wl + 4096);
            VM_WAIT();
#if DSA_REP_P2 > 1
            for (int rp2 = 0, np2 = opaque_int(DSA_REP_P2); rp2 < np2; ++rp2)
#endif
            {
                ns0 = 0; ns1 = 0; nc0 = 0; nc1 = 0;
#pragma unroll 1
                for (int qq = 0; qq < 2; ++qq) {
                    const float* sr = (const float*)(ws + WS_SCORE) + (size_t)(tq + qq) * SEQ + lane;
                    const unsigned bq = (unsigned)(qq ? b1[1] : b1[0]); unsigned ns = 0, nc = 0;
                    const unsigned long long lowm = (1ull << lane) - 1ull;
                    for (int k0 = 0; k0 < nadm; k0 += 256) {
                        float v[4];
#pragma unroll
                        for (int u = 0; u < 4; ++u) v[u] = (k0 + 64 * u < nadm) ? __builtin_nontemporal_load(sr + k0 + 64 * u) : 0.f;
#pragma unroll
                        for (int u = 0; u < 4; ++u) { if (k0 + 64 * u < nadm) {
                            const unsigned ok = ord_key(v[u]), bin = ok >> 21; const bool isel = bin > bq, icand = bin == bq;
                            const unsigned long long ms = __ballot(isel), mc = __ballot(icand);
                            const unsigned ps = ns + (unsigned)__builtin_popcountll(ms & lowm), pc = nc + (unsigned)__builtin_popcountll(mc & lowm);
                            if (isel && ps < 256u) sel[qq * 256 + ps] = k0 + 64 * u + lane;
                            if (icand && pc < 512u) { cok[qq * 512 + pc] = ok; cix[qq * 512 + pc] = k0 + 64 * u + lane; }
                            ns += (unsigned)__builtin_popcountll(ms); nc += (unsigned)__builtin_popcountll(mc); } }
                    }
                    if (qq) { ns1 = ns; nc1 = nc; } else { ns0 = ns; nc0 = nc; }
                }
            }
            LDS_WAIT(); asm volatile("" ::: "memory");
            DSA_SEG(3);
#pragma unroll 1
            for (int qq = 0; qq < 2; ++qq) {
                const unsigned nsq = qq ? ns1 : ns0; unsigned C = qq ? nc1 : nc0; C = C > 512u ? 512u : C;
                const unsigned need = nsq < 256u ? 256u - nsq : 0u;
                const unsigned C4 = (C + 3u) & ~3u;
                for (unsigned i = C + lane; i < C4; i += 64) cok[qq * 512 + i] = 0u;
                LDS_WAIT(); asm volatile("" ::: "memory");
                for (unsigned i0 = 0; i0 < C; i0 += 64) {
                    const unsigned i = i0 + lane; const bool act = i < C;
                    const unsigned mk = act ? cok[qq * 512 + i] : 0u;
                    unsigned rank = 0;
                    for (unsigned j = 0; j < C4; j += 4) { const u32x4 o = *(const LAS u32x4*)(cok + qq * 512 + j);
                        rank += (o.x > mk || (o.x == mk && j + 0 < i)) ? 1u : 0u; rank += (o.y > mk || (o.y == mk && j + 1 < i)) ? 1u : 0u;
                        rank += (o.z > mk || (o.z == mk && j + 2 < i)) ? 1u : 0u; rank += (o.w > mk || (o.w == mk && j + 3 < i)) ? 1u : 0u; }
                    if (act && rank < need) sel[qq * 256 + nsq + rank] = cix[qq * 512 + i];
                }
                const unsigned filled = nsq + (need < C ? need : C);
                for (unsigned i = filled + lane; i < 256u; i += 64) sel[qq * 256 + i] = -1;
            }
            LDS_WAIT(); asm volatile("" ::: "memory");
        } else {
            for (int i = lane; i < 512; i += 64) { const int k = i & 255; sel[i] = k < nadm ? k : -1; }
            LDS_WAIT(); asm volatile("" ::: "memory");
        }
        DSA_SEG(4);
#pragma unroll 1
        for (int qq = 0; qq < 2 * DSA_REP_ATT; ++qq) {
            const int t = tq + (qq & 1); const int head = fr & 7;
            const float slope = fast_exp2(-(float)(head + 1));
            bf16x8 qf[8];
            { const bf16* qp = proj + (size_t)t * NIN + C_QT + head * 256 + 8 * fq;
#pragma unroll
              for (int ks = 0; ks < 8; ++ks) qf[ks] = *(const bf16x8*)(qp + 32 * ks); }
            f32x4 oacc[16];
#pragma unroll
            for (int i = 0; i < 16; ++i) oacc[i] = (f32x4){0.f, 0.f, 0.f, 0.f};
            float mrun = -1e30f, lrun = 0.f;
            u32x4 gr[16];
#pragma unroll
            for (int i = 0; i < 16; ++i) { int s = sel[(qq & 1) * 256 + hh + 2 * i]; s = s < 0 ? 0 : s; gr[i] = *(const u32x4*)(kvn + (size_t)s * 256 + 8 * l31); }
            for (int kt = 0; kt < 8; ++kt) {
                asm volatile("" ::: "memory");
#pragma unroll
                for (int i = 0; i < 16; ++i) *(LAS u32x4*)(wl + (hh + 2 * i) * 528 + 16 * l31) = gr[i];
                if (kt + 1 < 8) {
#pragma unroll
                    for (int i = 0; i < 16; ++i) { int s = sel[(qq & 1) * 256 + 32 * (kt + 1) + hh + 2 * i]; s = s < 0 ? 0 : s; gr[i] = *(const u32x4*)(kvn + (size_t)s * 256 + 8 * l31); } }
                LDS_WAIT(); asm volatile("" ::: "memory");
                f32x4 sacc[2];
#pragma unroll
                for (int sb = 0; sb < 2; ++sb) { f32x4 c4 = (f32x4){0.f, 0.f, 0.f, 0.f};
#pragma unroll
                    for (int ks = 0; ks < 8; ++ks) { const bf16x8 af = *(const LAS bf16x8*)(wl + (16 * sb + fr) * 528 + 64 * ks + 16 * fq); c4 = __builtin_amdgcn_mfma_f32_16x16x32_bf16(af, qf[ks], c4, 0, 0, 0); }
                    sacc[sb] = c4; }
                float lg[8]; float mx = -1e30f;
#pragma unroll
                for (int sb = 0; sb < 2; ++sb) { const LAS int* sp = sel + (qq & 1) * 256 + 32 * kt + 16 * sb + 4 * fq;
#pragma unroll
                    for (int r = 0; r < 4; ++r) { const int s = sp[r]; const float d = (float)(t - s); float v = sacc[sb][r] - slope * fabsf(d); v = s < 0 ? -1e30f : v; lg[4 * sb + r] = v; mx = fmaxf(mx, v); } }
                mx = fmaxf(mx, __shfl_xor(mx, 16)); mx = fmaxf(mx, __shfl_xor(mx, 32));
                const float mnew = fmaxf(mrun, mx); const float alpha = fast_exp2((mrun - mnew) * 1.4426950408889634f);
                float ps = 0.f; float p[8];
#pragma unroll
                for (int i = 0; i < 8; ++i) { p[i] = lg[i] <= -1e29f ? 0.f : fast_exp2((lg[i] - mnew) * 1.4426950408889634f); ps += p[i]; }
                lrun = lrun * alpha + ps; mrun = mnew;
#pragma unroll
                for (int i = 0; i < 16; ++i) oacc[i] = oacc[i] * alpha;
                u32x4 pw; pw.x = pk2(p[0], p[1]); pw.y = pk2(p[2], p[3]); pw.z = pk2(p[4], p[5]); pw.w = pk2(p[6], p[7]);
                const bf16x8 pf = __builtin_bit_cast(bf16x8, pw);
#pragma unroll
                for (int rt = 0; rt < 16; ++rt) {
                    const LAS unsigned char* p0 = wl + (4 * fq + (fr >> 2)) * 528 + (16 * rt + 4 * (fr & 3)) * 2;
                    const v4i16_t a0 = __builtin_amdgcn_ds_read_tr16_b64_v4i16((LAS v4i16_t*)p0);
                    const v4i16_t a1 = __builtin_amdgcn_ds_read_tr16_b64_v4i16((LAS v4i16_t*)(p0 + 16 * 528));
                    bf16x8 af; af[0] = a0[0]; af[1] = a0[1]; af[2] = a0[2]; af[3] = a0[3]; af[4] = a1[0]; af[5] = a1[1]; af[6] = a1[2]; af[7] = a1[3];
                    oacc[rt] = __builtin_amdgcn_mfma_f32_16x16x32_bf16(af, pf, oacc[rt], 0, 0, 0); }
                LDS_WAIT(); asm volatile("" ::: "memory");
            }
            float lt = lrun; lt += __shfl_xor(lt, 16); lt += __shfl_xor(lt, 32);
            const float inv = 1.0f / lt;
            if (fr < 8) { bf16* op = ycat + (size_t)t * NCAT + 1024 + fr * 256 + 4 * fq;
#pragma unroll
                for (int rt = 0; rt < 16; ++rt) { const f32x4 v = oacc[rt] * inv; u32x2 w; w.x = pk2(v.x, v.y); w.y = pk2(v.z, v.w); *(u32x2*)(op + 16 * rt) = w; } }
        }
        LDS_WAIT(); asm volatile("" ::: "memory");
        DSA_SEG(5);
    }
#if TIMING
    if (blockIdx.x == TBLK && wave_s == 0 && lane == 0) { unsigned long long* ts = (unsigned long long*)(ws + WS_DIAG) + 32; unsigned long long c = 0; ts[0] = 0;
        for (int i = 0; i < 6; ++i) { c += tseg[i]; ts[1 + i] = c; } }
#endif
#undef DSA_SEG
}

__device__ __forceinline__ void attn_c_phase(const Args& a, LAS unsigned char* lds, int G, int wave_s) {
    int lane_o = (int)__builtin_amdgcn_mbcnt_hi(~0u, __builtin_amdgcn_mbcnt_lo(~0u, 0u)); asm volatile("" : "+v"(lane_o)); const int lane = lane_o, wave = wave_s, tid_o = wave_s * 64 + lane_o;
    unsigned char* ws = a.ws; const bf16* Q = (const bf16*)(ws + WS_Q); const bf16* K = (const bf16*)(ws + WS_K); const bf16* VT = (const bf16*)(ws + WS_VT); bf16* O = (bf16*)(ws + WS_O);
    LAS float* btab = (LAS float*)(lds + 65536);
    const int l31 = lane & 31, hh = lane >> 5;
    const float sc = 0.08838834764831845f * 1.4426950408889634f;
    const int kkey = tid_o >> 4, kc = tid_o & 15, vd = tid_o >> 3, vc = tid_o & 7;
    for (int un = blockIdx.x; un < 512; un += G) {
        const int head = un >> 5, cg = un & 31, ci = wave >> 1, chunk = 4 * cg + ci;
        __syncthreads();
        for (int i = tid_o; i < 513; i += NTHR) btab[i] = a.in[I_RELB][head * 513 + i] * 1.4426950408889634f;
        const int t = 64 * chunk + 32 * (wave & 1) + l31;
        bf16x8 qf[8];
        { const bf16* qp = Q + (size_t)t * DM + head * 128 + 8 * hh;
#pragma unroll
          for (int ks = 0; ks < 8; ++ks) qf[ks] = *(const bf16x8*)(qp + 16 * ks); }
        f32x16 oacc[4];
#pragma unroll
        for (int d = 0; d < 4; ++d)
#pragma unroll
            for (int i = 0; i < 16; ++i) oacc[d][i] = 0.f;
        float mrun = -1e30f, lrun = 0.f;
        const int cb0 = 4 * cg - 8;
        const int j0 = cb0 < 0 ? -cb0 : 0;
        const bf16* kg = K + (size_t)kkey * DM + head * 128 + kc * 8; const bf16* vg = VT + (size_t)(head * 128 + vd) * SEQ + vc * 8;
        const int kdst = kkey * 256 + ((kc ^ (kkey & 15)) * 16), vdst = 16384 + vd * 128 + ((vc ^ ((vd >> 1) & 7)) * 16);
        u32x4 sk0, sk1, sv0, sv1;
#define ATC_LD(j_) do { const size_t s0_ = (size_t)(64 * (cb0 + (j_))); sk0 = *(const u32x4*)(kg + s0_ * DM); sk1 = *(const u32x4*)(kg + (s0_ + 32) * DM); sv0 = *(const u32x4*)(vg + s0_); sv1 = *(const u32x4*)(vg + s0_ + (size_t)64 * SEQ); } while (0)
#define ATC_ST(b_) do { LAS unsigned char* d_ = lds + (b_) * 32768; *(LAS u32x4*)(d_ + kdst) = sk0; *(LAS u32x4*)(d_ + kdst + 32 * 256) = sk1; *(LAS u32x4*)(d_ + vdst) = sv0; *(LAS u32x4*)(d_ + vdst + 64 * 128) = sv1; } while (0)
        ATC_LD(j0); ATC_ST(j0 & 1);
        __syncthreads();
        for (int j = j0; j < 12; ++j) {
            if (j + 1 < 12) ATC_LD(j + 1);
            if (j >= ci && j <= ci + 8) {
                const LAS unsigned char* kb = lds + (j & 1) * 32768; const LAS unsigned char* vb = kb + 16384;
                const int s0 = 64 * (cb0 + j);
#pragma unroll
                for (int sub = 0; sub < 2; ++sub) {
                    f32x16 sa;
#pragma unroll
                    for (int i = 0; i < 16; ++i) sa[i] = 0.f;
                    const int krow = 32 * sub + l31;
#pragma unroll
                    for (int ks = 0; ks < 8; ++ks) { const bf16x8 kf = *(const LAS bf16x8*)(kb + krow * 256 + (((2 * ks + hh) ^ (krow & 15)) * 16)); sa = __builtin_amdgcn_mfma_f32_32x32x16_bf16(kf, qf[ks], sa, 0, 0, 0); }
                    float mx = -1e30f; float lg[16];
#pragma unroll
                    for (int i = 0; i < 16; ++i) { const int s = s0 + 32 * sub + (i & 3) + 8 * (i >> 2) + 4 * hh; int rel = t - s; rel = rel > 256 ? 256 : rel; lg[i] = sa[i] * sc + btab[rel + 256]; mx = fmaxf(mx, lg[i]); }
                    mx = fmaxf(mx, __shfl_xor(mx, 32));
                    const float mnew = fmaxf(mrun, mx), alpha = fast_exp2(mrun - mnew);
                    float ps = 0.f; float p[16];
#pragma unroll
                    for (int i = 0; i < 16; ++i) { p[i] = fast_exp2(lg[i] - mnew); ps += p[i]; }
                    lrun = lrun * alpha + ps; mrun = mnew;
#pragma unroll
                    for (int d = 0; d < 4; ++d)
#pragma unroll
                        for (int i = 0; i < 16; ++i) oacc[d][i] *= alpha;
#pragma unroll
                    for (int s = 0; s < 2; ++s) {
                        u32x4 pw; pw.x = pk2(p[8 * s], p[8 * s + 1]); pw.y = pk2(p[8 * s + 2], p[8 * s + 3]); pw.z = pk2(p[8 * s + 4], p[8 * s + 5]); pw.w = pk2(p[8 * s + 6], p[8 * s + 7]);
                        const bf16x8 pf = __builtin_bit_cast(bf16x8, pw);
                        const int q0 = 8 * sub + 4 * s + hh;
#pragma unroll
                        for (int d = 0; d < 4; ++d) { const int dr = 32 * d + l31; const LAS unsigned char* vr = vb + dr * 128 + (q0 & 1) * 8; const int sw = (dr >> 1) & 7;
                            const u32x2 v0 = *(const LAS u32x2*)(vr + (((q0 >> 1) ^ sw) * 16)), v1 = *(const LAS u32x2*)(vr + ((((q0 >> 1) + 1) ^ sw) * 16));
                            u32x4 vw; vw.x = v0.x; vw.y = v0.y; vw.z = v1.x; vw.w = v1.y;
                            oacc[d] = __builtin_amdgcn_mfma_f32_32x32x16_bf16(__builtin_bit_cast(bf16x8, vw), pf, oacc[d], 0, 0, 0); }
                    }
                }
            }
            if (j + 1 < 12) ATC_ST((j + 1) & 1);
            __syncthreads();
        }
#undef ATC_LD
#undef ATC_ST
        float lt = lrun + __shfl_xor(lrun, 32); const float inv = 1.0f / lt;
        bf16* op = O + (size_t)t * DM + head * 128 + 4 * hh;
#pragma unroll
        for (int d = 0; d < 4; ++d)
#pragma unroll
            for (int gq = 0; gq < 4; ++gq) { u32x2 w; w.x = pk2(oacc[d][4 * gq] * inv, oacc[d][4 * gq + 1] * inv); w.y = pk2(oacc[d][4 * gq + 2] * inv, oacc[d][4 * gq + 3] * inv);
                *(u32x2*)(op + 32 * d + 8 * gq) = w; }
    }
    __syncthreads();
}

__global__ void __launch_bounds__(NTHR, 2) fwd_kernel(Args args) {
    extern __shared__ __attribute__((aligned(16))) unsigned char lds_raw[];
    LAS unsigned char* lds = (LAS unsigned char*)lds_raw;
    volatile LAS unsigned* MISC = (volatile LAS unsigned*)(lds + MISC_OFF);
    const int wave_s = __builtin_amdgcn_readfirstlane((int)threadIdx.x >> 6);
    const int G = gridDim.x;
    unsigned char* ws = args.ws;
    if (threadIdx.x < 64) MISC[threadIdx.x] = 0u;
    __syncthreads();
    const int lo = args.ph_lo, hi = args.ph_hi;
    const bool multi = (hi - lo) > 1;
    XcdBarrier bar; bar.bar = (unsigned*)(ws + WS_CTL) + CW_BAR; bar.x = 0; bar.st = nullptr;
    if (multi) bar = xcd_barrier_post((unsigned*)(ws + WS_CTL) + CW_BAR, MISC + 8);
    bar.wave = wave_s;
#define IN(k) (lo <= (k) && (k) < hi)
#if TIMING
#define STAMP(k) do { if (blockIdx.x == 0 && wave_s == 0 && __builtin_amdgcn_mbcnt_hi(~0u, __builtin_amdgcn_mbcnt_lo(~0u, 0u)) == 0u) __hip_atomic_store((unsigned long long*)(ws + WS_DIAG) + (k), __builtin_amdgcn_s_memrealtime(), __ATOMIC_RELAXED, __HIP_MEMORY_SCOPE_AGENT); } while (0)
#define SEAM(k) do { if (IN((k) + 1)) xcd_barrier(bar); STAMP((k) + 1); } while (0)
#else
#define STAMP(k) do { } while (0)
#define SEAM(k) do { if (IN((k) + 1)) xcd_barrier(bar); } while (0)
#endif

 #if REP_MASK
#define PH_LOOP(k) _Pragma("unroll") for (int r_ = 0; r_ < ((((REP_MASK) >> (k)) & 1u) ? REP_N : 1); ++r_)
#else
#define PH_LOOP(k)
#endif
    float* H = args.out;
    float* mod = (float*)(ws + WS_MOD);
    bf16* hn = (bf16*)(ws + WS_HN); bf16* hmid = (bf16*)(ws + WS_HMID); bf16* proj = (bf16*)(ws + WS_PROJ);

    STAMP(0);
    PH_LOOP(0) { if (EN(0) && IN(0)) p0_prologue(args, lds, G, wave_s);
    if (IN(0)) SEAM(0); }

#define FFN_PHASES(S_, PB_) do { \
        constexpr int layer_ = (S_) >> 1, sub_ = ((S_) & 1) ? 2 : 0; \
        const float* hin_ = ((S_) == 0) ? args.in[I_X] : H; \
        const float* mvec_ = mod + layer_ * NMOD + sub_ * 3 * DM; \
        PH_LOOP(PB_) { if (EN(1) && IN(PB_)) norm_phase<false, true>(hin_, args.in[I_NORMG] + (layer_ * 3 + sub_) * DM, mvec_, mvec_ + DM, hn, nullptr, G, wave_s); \
        if ((S_) == 0 && EN(2) && IN(PB_)) { \
              \
            pg8::Gemm g{(const bf16*)(ws + WS_WUPRAW), (const bf16*)(ws + WS_WQRAW), 256, 2048, 128, 2048, 2048, 8, 128, 128, \
                        (const bf16*)(ws + WS_WOUTB) + 1024, (const bf16*)(ws + WS_WUPRAW) + 1024, 2048, 256, 8, 128, 128}; \
            pg8::StaticOrder S; S.init(g, G, (int)blockIdx.x); \
            pg8::EpiBf16 E{(bf16*)(ws + WS_WIN) + (size_t)1024 * DM, DM, (size_t)256 * DM, 0.08838834764831845f, (bf16*)(ws + WS_WOUT) + 1024, NCAT, (size_t)256, 1.0f}; \
            pg8::gemm_phase<pg8::EpiBf16>(lds, g, S, E, wave_s); } \
        if (IN(PB_)) SEAM(PB_); } \
        PH_LOOP((PB_) + 1) { if (EN(3) && IN((PB_) + 1)) { \
            pg8::Gemm g{hn, (const bf16*)(ws + WS_WGU + (size_t)(S_) * NGU * DM), SEQ, NGU, DM / 2, DM / 2, DM / 2, 1, 0, 0, nullptr, nullptr, 0, 0, 0, 0, 0}; \
            pg8::StaticOrder S; S.init(g, G, (int)blockIdx.x); \
            pg8::EpiSwiGLU E{(unsigned char*)hmid, FFP, 0x7c7c7c7c, 0x79797979};     \
            pg8::gemm_phase<pg8::EpiSwiGLU, true>(lds, g, S, E, wave_s); } \
        if (IN((PB_) + 1)) SEAM((PB_) + 1); } \
        PH_LOOP((PB_) + 2) { if (EN(4) && IN((PB_) + 2)) { \
            pg8::Gemm g{hmid, (const bf16*)(ws + WS_WD + (size_t)(S_) * DM * FFP), SEQ, DM, FFP / 2, FFP / 2, FFP / 2, 1, 0, 0, nullptr, nullptr, 0, 0, 0, 0, 0}; \
            pg8::StaticOrder S; S.init(g, G, (int)blockIdx.x); \
            pg8::EpiResid E{hin_, H, mvec_ + 2 * DM, 0.5f, 0x7c7c7c7c, 0x78787878};     \
            pg8::gemm_phase<pg8::EpiResid, true>(lds, g, S, E, wave_s); } \
        if (IN((PB_) + 2)) SEAM((PB_) + 2); } \
    } while (0)
#define MIXOUT_PHASE(LYR_, PM_, APTR_, BPTR_, K_) do { \
        if (EN(12) && IN(PM_)) { \
            const float* m1_ = mod + (LYR_) * NMOD + 1 * 3 * DM; \
            pg8::Gemm g{(const bf16*)(APTR_), (const bf16*)(BPTR_), SEQ, DM, (K_), (K_), (K_), 1, 0, 0, nullptr, nullptr, 0, 0, 0, 0, 0}; \
            pg8::StaticOrder S; S.init(g, G, (int)blockIdx.x); \
            pg8::EpiResid E{H, H, m1_ + 2 * DM, 1.0f, 0, 0}; \
            pg8::gemm_phase<pg8::EpiResid>(lds, g, S, E, wave_s); } \
        if (IN(PM_)) SEAM(PM_); \
    } while (0)

    FFN_PHASES(0, 1);
    {
        const float* m1 = mod + 0 * NMOD + 1 * 3 * DM;
        PH_LOOP(4) { if (EN(1) && IN(4)) norm_phase<false>(H, args.in[I_NORMG] + (0 * 3 + 1) * DM, m1, m1 + DM, hn, nullptr, G, wave_s);
        if (IN(4)) SEAM(4); }
        PH_LOOP(5) { if (EN(5) && IN(5)) {
            pg8::Gemm g{hn, (const bf16*)(ws + WS_WIN), SEQ, NIN, DM, DM, DM, 1, 0, 0, nullptr, nullptr, 0, 0, 0, 0, 0};
            pg8::StaticOrder S; S.init(g, G, (int)blockIdx.x);
            pg8::EpiBf16 E{proj, NIN, 0, 1.0f, nullptr, 0, 0, 0.f};
            pg8::gemm_phase<pg8::EpiBf16>(lds, g, S, E, wave_s);
        }
        if (IN(5)) SEAM(5); }
        PH_LOOP(6) { if (EN(6) && IN(6)) phase_a2(args, lds, G, wave_s);
        if (IN(6)) SEAM(6); }
        PH_LOOP(24) { if (EN(7) && IN(7)) { s5_scan_out(args, lds, G, wave_s); __syncthreads(); } }
        STAMP(25);
        PH_LOOP(25) { if (EN(8) && IN(7)) dsa_phase(args, lds, G, wave_s); }
        if (IN(7)) SEAM(7);
        PH_LOOP(8) { if (EN(9) && IN(8)) {
            pg8::Gemm g{(const bf16*)(ws + WS_YAPRE), (const bf16*)(ws + WS_WGLU), SEQ, 1024, 1024, 1024, 1024, 1, 0, 0, nullptr, nullptr, 0, 0, 0, 0, 0};
            pg8::StaticOrder S; S.init(g, G, (int)blockIdx.x);
            pg8::EpiGLU E{(const bf16*)(ws + WS_YAPRE), args.in[I_BGLU], (bf16*)(ws + WS_YCAT), NCAT};
            pg8::gemm_phase<pg8::EpiGLU>(lds, g, S, E, wave_s);
        }
        if (IN(8)) SEAM(8); }
    }
#ifdef EXTRA_BARRIERS
    for (int xb_ = 0; xb_ < EXTRA_BARRIERS; ++xb_) xcd_barrier(bar);
#endif
#ifdef EXP_GEMM
    {
        xcd_barrier(bar);
#if EXP_GEMM == 1
        pg8::Gemm g{hmid, (const bf16*)(ws + WS_WD), SEQ, DM, FFP / 2, FFP / 2, FFP / 2, 1, 0, 0, nullptr, nullptr, 0, 0, 0, 0, 0};
        pg8::StaticOrder S; S.init(g, G, (int)blockIdx.x); S.force = EXP_FORCE;
        pg8::EpiBf16 E{(bf16*)(ws + WS_SCORE), DM, 0, 1.0f, nullptr, 0, 0, 0.f, 0x7c7c7c7c, 0x78787878};
        pg8::gemm_phase<pg8::EpiBf16, true>(lds, g, S, E, wave_s);
#elif EXP_GEMM == 3
        pg8::Gemm g{hmid, (const bf16*)(ws + WS_WD), SEQ, DM, FFP / 2, FFP / 2, FFP / 2, 1, 0, 0, nullptr, nullptr, 0, 0, 0, 0, 0};
        pg8::StaticOrder S; S.init(g, G, (int)blockIdx.x); S.force = EXP_FORCE;
        pg8::EpiResid E{H, (float*)(ws + WS_SCORE), mod + 2 * DM, 0.5f, 0x7c7c7c7c, 0x78787878};
        pg8::gemm_phase<pg8::EpiResid, true>(lds, g, S, E, wave_s);
#elif EXP_GEMM == 2
        pg8::Gemm g{hn, (const bf16*)(ws + WS_WGU), SEQ, NGU, DM / 2, DM / 2, DM / 2, 1, 0, 0, nullptr, nullptr, 0, 0, 0, 0, 0};
        pg8::StaticOrder S; S.init(g, G, (int)blockIdx.x); S.force = EXP_FORCE;
        pg8::EpiBf16 E{(bf16*)(ws + WS_SCORE), NGU, 0, 1.0f, nullptr, 0, 0, 0.f, 0x7c7c7c7c, 0x79797979};
        pg8::gemm_phase<pg8::EpiBf16, true>(lds, g, S, E, wave_s);
#endif
        xcd_barrier(bar);
    }
#endif
    MIXOUT_PHASE(0, 9, ws + WS_YCAT, ws + WS_WOUT, NCAT);
    FFN_PHASES(1, 10);
    FFN_PHASES(2, 13);
    {
        const float* m1 = mod + 1 * NMOD + 1 * 3 * DM;
        PH_LOOP(16) { if (EN(1) && IN(16)) norm_phase<false>(H, args.in[I_NORMG] + (1 * 3 + 1) * DM, m1, m1 + DM, hn, nullptr, G, wave_s);
        if (IN(16)) SEAM(16); }
        PH_LOOP(17) { if (EN(10) && IN(17)) {
            pg8::Gemm g{hn, (const bf16*)(ws + WS_WQKV), SEQ, 2048, DM, DM, DM, 2, 0, (size_t)2048 * DM,
                        (const bf16*)(ws + WS_WQKV) + (size_t)4096 * DM, hn, 2048, SEQ, 1, 0, 0};
            pg8::StaticOrder S; S.init(g, G, (int)blockIdx.x);
            pg8::EpiBf16 E{(bf16*)(ws + WS_Q), DM, (size_t)SEQ * DM, 1.0f, (bf16*)(ws + WS_VT), SEQ, 0, 1.0f};
            pg8::gemm_phase<pg8::EpiBf16>(lds, g, S, E, wave_s);
        }
        if (IN(17)) SEAM(17); }
        PH_LOOP(18) { if (EN(11) && IN(18)) attn_c_phase(args, lds, G, wave_s);
        if (IN(18)) SEAM(18); }
    }
    MIXOUT_PHASE(1, 19, ws + WS_O, ws + WS_WCOUT, DM);
    FFN_PHASES(3, 20);
    if (EN(13) && IN(23)) { norm_phase<true>(H, args.in[I_FING], nullptr, nullptr, nullptr, args.out, G, wave_s); }
#if TIMING
    {
        xcd_barrier(bar); STAMP(24);
        if (blockIdx.x == 0 && wave_s == 0) {
            const unsigned long long* ts = (const unsigned long long*)(ws + WS_DIAG);
            const unsigned long long a0 = __hip_atomic_load(ts + TSEL_A, __ATOMIC_RELAXED, __HIP_MEMORY_SCOPE_AGENT), a1 = __hip_atomic_load(ts + TSEL_A + TSEL_A_N, __ATOMIC_RELAXED, __HIP_MEMORY_SCOPE_AGENT);
            const unsigned long long want = (a1 - a0) * TAMP, t0 = __builtin_amdgcn_s_memrealtime();
            while (__builtin_amdgcn_s_memrealtime() - t0 < want) __builtin_amdgcn_s_sleep(32);
        }
    }
#endif
#undef IN
#undef SEAM
}

extern "C" void kernel_launch(void* const* d_in, const int* in_sizes, int n_in, void* d_out, int out_size, void* d_ws, size_t ws_size, hipStream_t stream) {
    static int grid = 0;
    if (grid == 0) {
        if (n_in != 26 || out_size != SEQ * DM || ws_size < WS_END) { fprintf(stderr, "kernel_launch: unexpected shapes (n_in %d out %d ws %zu need %zu)\n", n_in, out_size, ws_size, (size_t)WS_END); grid = -1; return; }
        int dev = 0, cus = 0, per_cu = 0;
        if (hipGetDevice(&dev) != hipSuccess || hipDeviceGetAttribute(&cus, hipDeviceAttributeMultiprocessorCount, dev) != hipSuccess) { grid = -1; return; }
        if (hipFuncSetAttribute((const void*)fwd_kernel, hipFuncAttributeMaxDynamicSharedMemorySize, LDS_BYTES) != hipSuccess) { fprintf(stderr, "kernel_launch: hipFuncSetAttribute failed\n"); grid = -1; return; }
        if (hipOccupancyMaxActiveBlocksPerMultiprocessor(&per_cu, (const void*)fwd_kernel, NTHR, LDS_BYTES) != hipSuccess || per_cu < 1) { fprintf(stderr, "kernel_launch: occupancy query says %d\n", per_cu); }
        (void)hipGetLastError();
        grid = cus;
    }
    if (grid < 0) return;
    (void)hipMemsetAsync((char*)d_ws + WS_CTL, 0, CTL_ZERO_BYTES, stream);
    Args a{};
    for (int i = 0; i < 26; ++i) a.in[i] = (const float*)d_in[i];
    a.out = (float*)d_out; a.ws = (unsigned char*)d_ws;
    a.ph_lo = 0; a.ph_hi = N_PHASES_RUN;
    hipLaunchKernelGGL(fwd_kernel, dim3(grid), dim3(NTHR), LDS_BYTES, stream, a);
}
```

```cpp
#include <hip/hip_runtime.h>
#include <cstdio>
#include <cstdint>

#ifndef SELFCHECK
#define SELFCHECK 0
#endif
#ifndef N_PHASES_RUN
#define N_PHASES_RUN 24
#endif
#ifndef REP_MASK
#define REP_MASK 0u
#endif
#ifndef REP_N
#define REP_N 2
#endif
#ifndef FP8_QKV
#define FP8_QKV 1
#endif
#ifndef FP8_MIXOUT
#define FP8_MIXOUT 1
#endif
#ifndef TIMING
#define TIMING 0
#endif
#ifndef TBLK
#define TBLK 100
#endif
#ifndef TAMP
#define TAMP 8
#endif
#ifndef TSEL_A
#define TSEL_A 0
#define TSEL_A_N 1
#define TSEL_B 1
#define TSEL_B_N 1
#endif

#ifndef EN_MASK
#define EN_MASK 0xFFFFFFFFu
#endif
#define EN(b) ((EN_MASK >> (b)) & 1u)
#define GAS __attribute__((address_space(1)))
#define LAS __attribute__((address_space(3)))
typedef unsigned short bf16;
typedef short bf16x8 __attribute__((ext_vector_type(8)));
typedef short s16x4 __attribute__((ext_vector_type(4)));
typedef float f32x2 __attribute__((ext_vector_type(2)));
typedef float f32x4 __attribute__((ext_vector_type(4)));
typedef float f32x16 __attribute__((ext_vector_type(16)));
typedef unsigned u32x2 __attribute__((ext_vector_type(2)));
typedef unsigned u32x4 __attribute__((ext_vector_type(4)));
typedef short v4i16_t __attribute__((ext_vector_type(4)));

constexpr int SEQ = 8192, DM = 2048, FF = 5504, NGU = 2 * FF  , NMOD = 18432;
constexpr int NIN = 4608;
constexpr int C_U = 0, C_QT = 1024, C_KVL = 3072, C_QI = 3328, C_KI = 4352, C_WI = 4416;
constexpr int FFP = 5632;
constexpr int NCAT = 3072;
constexpr int NWAVES = 8, NTHR = 512;

constexpr size_t MiB = 1u << 20;
constexpr size_t WS_CTL = 0, CTL_ZERO_BYTES = 1 * MiB;
constexpr size_t WS_MOD = 1 * MiB;
constexpr size_t WS_S5T = WS_MOD + 256 * 1024;
constexpr size_t WS_DIAG = 3 * MiB;
constexpr size_t WS_WGU = 4 * MiB;
constexpr size_t WS_WD = WS_WGU + 172 * MiB;
constexpr size_t WS_WIN = WS_WD + 86 * MiB;
constexpr size_t WS_WQRAW = WS_WIN + 18 * MiB;
constexpr size_t WS_WUPRAW = WS_WQRAW + 8 * MiB;
constexpr size_t WS_WGLU = WS_WUPRAW + 1 * MiB;
constexpr size_t WS_WOUT = WS_WGLU + 2 * MiB;
constexpr size_t WS_WOUTB = WS_WOUT + 12 * MiB;
constexpr size_t WS_WQKV = WS_WOUTB + 8 * MiB;
constexpr size_t WS_WCOUT = WS_WQKV + 24 * MiB;
constexpr size_t WS_HN = WS_WCOUT + 8 * MiB;
constexpr size_t WS_HMID = WS_HN + 32 * MiB;
constexpr size_t WS_PROJ = WS_HMID + 86 * MiB;
constexpr size_t WS_KVN = WS_PROJ + 72 * MiB;
constexpr size_t WS_E = WS_KVN + 4 * MiB;
constexpr size_t WS_YAPRE = WS_E + 4 * MiB;
constexpr size_t WS_YCAT = WS_YAPRE + 16 * MiB;
constexpr size_t WS_SCORE = WS_YCAT + 48 * MiB;
constexpr size_t WS_Q = WS_SCORE, WS_K = WS_SCORE + 32 * MiB, WS_VT = WS_SCORE + 64 * MiB, WS_O = WS_SCORE + 96 * MiB;
constexpr size_t WS_END = WS_SCORE + 256 * MiB;
constexpr int S5_AR = 0, S5_AI = 4096, S5_A64R = 8192, S5_A64I = 12288, S5_BBR = 16384, S5_BBI = 16384 + 65536;

constexpr int CW_BAR = 4096;

constexpr int RING_BYTES = 131072;
constexpr int SCRATCH_BYTES = 155648;
constexpr int MISC_OFF = SCRATCH_BYTES;
constexpr int LDS_BYTES = SCRATCH_BYTES + 256;

#define LDS_WAIT() asm volatile("s_waitcnt lgkmcnt(0)" ::: "memory")
#define VM_WAIT() asm volatile("s_waitcnt vmcnt(0)" ::: "memory")

__device__ __forceinline__ unsigned f2bf(float f) { unsigned u = __builtin_bit_cast(unsigned, f); return (u + 0x7fffu + ((u >> 16) & 1u)) >> 16; }
__device__ __forceinline__ unsigned pk2(float lo, float hi) { unsigned r; asm volatile("v_cvt_pk_bf16_f32 %0, %1, %2" : "=v"(r) : "v"(lo), "v"(hi)); return r; }
__device__ __forceinline__ float clamp448(float x) { return __builtin_amdgcn_fmed3f(x, -448.0f, 448.0f); }
__device__ __forceinline__ unsigned pk4_fp8(float a, float b, float c, float d) {
    int w = 0; w = __builtin_amdgcn_cvt_pk_fp8_f32(clamp448(a), clamp448(b), w, false); w = __builtin_amdgcn_cvt_pk_fp8_f32(clamp448(c), clamp448(d), w, true); return (unsigned)w; }
__device__ __forceinline__ float bf2f(unsigned short b) { return __builtin_bit_cast(float, (unsigned)b << 16); }
__device__ __forceinline__ float bflo(unsigned w) { return __builtin_bit_cast(float, w << 16); }
__device__ __forceinline__ float bfhi(unsigned w) { return __builtin_bit_cast(float, w & 0xffff0000u); }
__device__ __forceinline__ float fast_exp2(float x) { return __builtin_amdgcn_exp2f(x); }
__device__ __forceinline__ float fast_rcp(float x) { return __builtin_amdgcn_rcpf(x); }
__device__ __forceinline__ float silu_f(float x) { return x * fast_rcp(1.0f + fast_exp2(-1.4426950408889634f * x)); }
__device__ __forceinline__ float sigmoid_f(float x) { return fast_rcp(1.0f + fast_exp2(-1.4426950408889634f * x)); }
__device__ __forceinline__ float gelu_tanh_f(float y) {
    const float z = 0.7978845608028654f * (y + 0.044715f * y * y * y);
    const float e = fast_exp2(2.0f * 1.4426950408889634f * z);
    const float th = 1.0f - 2.0f * fast_rcp(e + 1.0f);
    return 0.5f * y * (1.0f + th);
}
__device__ __forceinline__ float wave_sum(float v) {
#pragma unroll
    for (int o = 1; o < 64; o <<= 1) v += __shfl_xor(v, o);
    return v;
}

namespace pg8 {
constexpr int BM = 256, BK = 64, HALF = 128, HTB = HALF * BK * 2, STAGE_BYTES = 8 * HTB, NXCD = 8, WGM = 8;
__host__ __device__ __forceinline__ int lds_byte(int r, int c) { const int st = (r >> 4) * 2 + (c >> 5), rr = r & 15, cc = c & 31, ob = rr * 64 + cc * 2; return st * 1024 + (ob ^ (((ob >> 9) & 1) << 5)); }
__host__ __device__ __forceinline__ void stage_rc(int b, int& R, int& C) { const int st = b / 1024, sb = b % 1024, swz = sb ^ (((sb >> 9) & 1) << 5); R = (st >> 1) * 16 + swz / 64; C = (st & 1) * 32 + (swz % 64) / 2; }
__host__ __device__ __forceinline__ int perm32(int rho) { const int n = rho >> 4, i = rho & 15; return 8 * (i >> 2) + 4 * n + (i & 3); }

typedef int v4i_t __attribute__((ext_vector_type(4)));
typedef int v8i_t __attribute__((ext_vector_type(8)));
__device__ __forceinline__ v8i_t cat8(bf16x8 lo, bf16x8 hi) { return __builtin_shufflevector(__builtin_bit_cast(v4i_t, lo), __builtin_bit_cast(v4i_t, hi), 0, 1, 2, 3, 4, 5, 6, 7); }
__device__ __forceinline__ bf16x8 lo8(v8i_t v) { return __builtin_bit_cast(bf16x8, __builtin_shufflevector(v, v, 0, 1, 2, 3)); }
__device__ __forceinline__ bf16x8 hi8(v8i_t v) { return __builtin_bit_cast(bf16x8, __builtin_shufflevector(v, v, 4, 5, 6, 7)); }
struct Unit { int pm, pn, z, seg; };
struct Gemm { const bf16* A; const bf16* Bt; int M, N, K, lda, ldb, nz; size_t zA, zB; const bf16* A1; const bf16* Bt1; int M1, N1, nz1; size_t zA1, zB1; };

struct StaticOrder {
    int nM0, nN0, n0, nM1, nN1, ntot, G, c; int force = 0;
    __device__ void init(const Gemm& g, int G_, int c_) { nM0 = g.M / BM; nN0 = g.N / BM; n0 = nM0 * nN0 * g.nz; nM1 = g.M1 / BM; nN1 = g.N1 / BM; ntot = n0 + nM1 * nN1 * g.nz1; G = G_; c = c_; }
    __device__ bool next(int i, Unit& u) const {
        int L = i * G + c; if (L >= ntot) return false;
        const int seg = L >= n0 ? 1 : 0; if (seg) L -= n0;
        const int nM = seg ? nM1 : nM0, nN = seg ? nN1 : nN0, nwg = nM * nN;
        u.seg = seg; u.z = L / nwg;
        int wgid = L % nwg; { const int q = nwg / NXCD, r = nwg % NXCD, xcd = wgid % NXCD, off = wgid / NXCD; wgid = (xcd < r ? xcd * (q + 1) : r * (q + 1) + (xcd - r) * q) + off; }
        const int nig = WGM * nN, gid = wgid / nig, fm = gid * WGM, gsz = (nM - fm) < WGM ? (nM - fm) : WGM;
        u.pm = fm + ((wgid % nig) % gsz); u.pn = (wgid % nig) / gsz; if (force & 1) u.pm = 0; if (force & 2) u.pn = 0; return true;
    }
};

struct EpiBf16 {
    static constexpr bool PERM = true;
    bf16* O; int ldc; size_t zC; float scale; bf16* O1; int ldc1; size_t zC1; float scale1; int scale_a = 0, scale_w = 0; int fp8_1 = 0;
    __device__ __forceinline__ void operator()(const f32x4 (&acc)[2][2][4][2], const Unit& u, int wr, int wc, int fr, int fq) const {
        const int row0 = u.pm * BM + wr * 64 + fr; const int col0 = u.pn * BM + wc * 32 + 8 * fq;
        bf16* base = u.seg ? O1 + (size_t)u.z * zC1 : O + (size_t)u.z * zC; const int ldc = u.seg ? ldc1 : this->ldc; const float scale = u.seg ? scale1 : this->scale;
#pragma unroll
        for (int ai = 0; ai < 2; ++ai)
#pragma unroll
            for (int m = 0; m < 4; ++m) { bf16* rowp = base + (size_t)(row0 + ai * HALF + m * 16) * ldc + col0;
#pragma unroll
                for (int bj = 0; bj < 2; ++bj) { const f32x4 v0 = acc[ai][bj][m][0] * scale, v1 = acc[ai][bj][m][1] * scale;
                    if (u.seg && fp8_1) { u32x2 w8; w8.x = pk4_fp8(v0[0], v0[1], v0[2], v0[3]); w8.y = pk4_fp8(v1[0], v1[1], v1[2], v1[3]);
                        *(u32x2*)((unsigned char*)O1 + (size_t)u.z * zC1 + (size_t)(row0 + ai * HALF + m * 16) * ldc1 + col0 + bj * HALF) = w8; }
                    else { u32x4 w; w.x = pk2(v0[0], v0[1]); w.y = pk2(v0[2], v0[3]); w.z = pk2(v1[0], v1[1]); w.w = pk2(v1[2], v1[3]);
                    *(u32x4*)(rowp + bj * HALF) = w; } } }
    }
};
struct EpiSwiGLU {
    static constexpr bool PERM = true;
    unsigned char* O; int ldc; int scale_a, scale_w;
    __device__ __forceinline__ void operator()(const f32x4 (&acc)[2][2][4][2], const Unit& u, int wr, int wc, int fr, int fq) const {
        const int row0 = u.pm * BM + wr * 64 + fr; const int col0 = u.pn * HALF + wc * 32 + 8 * fq;
#pragma unroll
        for (int ai = 0; ai < 2; ++ai)
#pragma unroll
            for (int m = 0; m < 4; ++m) { unsigned char* rowp = O + (size_t)(row0 + ai * HALF + m * 16) * ldc + col0;
                const f32x4 g0 = acc[ai][0][m][0], g1 = acc[ai][0][m][1], u0 = acc[ai][1][m][0] * 8.0f, u1 = acc[ai][1][m][1] * 8.0f;
                u32x2 w; w.x = pk4_fp8(silu_f(g0[0]) * u0[0], silu_f(g0[1]) * u0[1], silu_f(g0[2]) * u0[2], silu_f(g0[3]) * u0[3]);
                w.y = pk4_fp8(silu_f(g1[0]) * u1[0], silu_f(g1[1]) * u1[1], silu_f(g1[2]) * u1[2], silu_f(g1[3]) * u1[3]);
                *(u32x2*)rowp = w; }
    }
};
struct EpiResid {
    static constexpr bool PERM = false;
    const float* hin; float* out; const float* gate; float coef; int scale_a, scale_w;
    __device__ __forceinline__ void operator()(const f32x4 (&acc)[2][2][4][2], const Unit& u, int wr, int wc, int fr, int fq) const {
        const int row0 = u.pm * BM + wr * 64 + fr; const int col0 = u.pn * BM + wc * 32 + 4 * fq;
        f32x4 gv[2][2];
#pragma unroll
        for (int bj = 0; bj < 2; ++bj)
#pragma unroll
            for (int n = 0; n < 2; ++n) gv[bj][n] = *(const f32x4*)(gate + col0 + bj * HALF + n * 16) * coef;
#pragma unroll
        for (int ai = 0; ai < 2; ++ai)
#pragma unroll
            for (int m = 0; m < 4; ++m) { const size_t off = (size_t)(row0 + ai * HALF + m * 16) * DM + col0;
#pragma unroll
                for (int bj = 0; bj < 2; ++bj)
#pragma unroll
                    for (int n = 0; n < 2; ++n) { const f32x4 b = *(const f32x4*)(hin + off + bj * HALF + n * 16);
                        *(f32x4*)(out + off + bj * HALF + n * 16) = b + gv[bj][n] * acc[ai][bj][m][n]; } }
    }
};
struct EpiGLU {
    static constexpr bool PERM = true;
    const bf16* yp; const float* bias; bf16* O; int ldc; int scale_a = 0, scale_w = 0;
    __device__ __forceinline__ void operator()(const f32x4 (&acc)[2][2][4][2], const Unit& u, int wr, int wc, int fr, int fq) const {
        const int row0 = u.pm * BM + wr * 64 + fr; const int col0 = u.pn * BM + wc * 32 + 8 * fq;
#pragma unroll
        for (int bj = 0; bj < 2; ++bj) { const f32x4 b0 = *(const f32x4*)(bias + col0 + bj * HALF), b1 = *(const f32x4*)(bias + col0 + bj * HALF + 4);
#pragma unroll
            for (int ai = 0; ai < 2; ++ai)
#pragma unroll
                for (int m = 0; m < 4; ++m) { const size_t r = (size_t)(row0 + ai * HALF + m * 16);
                    const u32x4 y = *(const u32x4*)(yp + r * 1024 + col0 + bj * HALF);
                    const f32x4 z0 = acc[ai][bj][m][0] + b0, z1 = acc[ai][bj][m][1] + b1;
#if FP8_MIXOUT
                    u32x2 w8; w8.x = pk4_fp8(8.f * bflo(y.x) * sigmoid_f(z0[0]), 8.f * bfhi(y.x) * sigmoid_f(z0[1]), 8.f * bflo(y.y) * sigmoid_f(z0[2]), 8.f * bfhi(y.y) * sigmoid_f(z0[3]));
                    w8.y = pk4_fp8(8.f * bflo(y.z) * sigmoid_f(z1[0]), 8.f * bfhi(y.z) * sigmoid_f(z1[1]), 8.f * bflo(y.w) * sigmoid_f(z1[2]), 8.f * bfhi(y.w) * sigmoid_f(z1[3]));
                    *(u32x2*)((unsigned char*)O + r * ldc + col0 + bj * HALF) = w8; } }
#else
                    u32x4 w; w.x = pk2(bflo(y.x) * sigmoid_f(z0[0]), bfhi(y.x) * sigmoid_f(z0[1])); w.y = pk2(bflo(y.y) * sigmoid_f(z0[2]), bfhi(y.y) * sigmoid_f(z0[3]));
                    w.z = pk2(bflo(y.z) * sigmoid_f(z1[0]), bfhi(y.z) * sigmoid_f(z1[1])); w.w = pk2(bflo(y.w) * sigmoid_f(z1[2]), bfhi(y.w) * sigmoid_f(z1[3]));
                    *(u32x4*)(O + r * ldc + col0 + bj * HALF) = w; } }
#endif
    }
};

template <class Epi, bool FP8 = false>
__device__ __forceinline__ void gemm_phase(LAS unsigned char* lds, const Gemm g, const StaticOrder& S, const Epi& E, int wave_s) {
    int lane_o = (int)__builtin_amdgcn_mbcnt_hi(~0u, __builtin_amdgcn_mbcnt_lo(~0u, 0u)); asm volatile("" : "+v"(lane_o));
    const int wid = wave_s, lane = lane_o, tid = wave_s * 64 + lane_o, wr = wid >> 2, wc = wid & 3, fr = lane & 15, fq = lane >> 4;
    const int K = g.K, nt = K / BK;
    unsigned voffA[2], voffB[2];
#pragma unroll
    for (int i = 0; i < 2; ++i) { int R, C; stage_rc(tid * 16 + i * 8192, R, C); const int Rb = Epi::PERM ? ((R & ~31) + perm32(R & 31)) : R;
        voffA[i] = (unsigned)(R * g.lda + C) * 2u; voffB[i] = (unsigned)(Rb * g.ldb + C) * 2u; }
    const size_t kstep = (size_t)(BK * 2);
    const size_t hstepA = (size_t)HALF * g.lda * 2, hstepB = (size_t)HALF * g.ldb * 2;
    const size_t tstepA = 2 * hstepA, tstepB = 2 * hstepB;
    const unsigned ldsw = (unsigned)wid * 1024u;
    const int aoff = lds_byte(wr * 64 + fr, fq * 8), boff = lds_byte(wc * 32 + fr, fq * 8);
#define PG8_SA(b, h) (((b) * 2 + (h)) * HTB)
#define PG8_SB(b, h) ((4 + (b) * 2 + (h)) * HTB)
#define PG8_STAGE(bufoff, gbase, voff) do { _Pragma("unroll") for (int _i = 0; _i < 2; ++_i) \
        __builtin_amdgcn_global_load_lds((const unsigned*)((const char*)(gbase) + (voff)[_i]), (LAS unsigned*)(lds + (bufoff) + ldsw + _i * 8192), 16, 0, 0); } while (0)
#define PG8_LDA(dst, b, h) do { _Pragma("unroll") for (int m = 0; m < 4; ++m) { const bf16x8 l_ = *(const LAS bf16x8*)(lds + PG8_SA(b, h) + aoff + m * 2048), h_ = *(const LAS bf16x8*)(lds + PG8_SA(b, h) + aoff + m * 2048 + 1024); dst[m] = cat8(l_, h_); } } while (0)
#define PG8_LDB(dst, b, h) do { _Pragma("unroll") for (int n = 0; n < 2; ++n) { const bf16x8 l_ = *(const LAS bf16x8*)(lds + PG8_SB(b, h) + boff + n * 2048), h_ = *(const LAS bf16x8*)(lds + PG8_SB(b, h) + boff + n * 2048 + 1024); dst[n] = cat8(l_, h_); } } while (0)
#define PG8_MMA(ai, bj, At, Bt) do { __builtin_amdgcn_s_setprio(1); _Pragma("unroll") for (int m = 0; m < 4; ++m) _Pragma("unroll") for (int n = 0; n < 2; ++n) { \
        if constexpr (FP8) asm volatile("v_mfma_scale_f32_16x16x128_f8f6f4 %0, %1, %2, %0, %3, %4 op_sel_hi:[0,0,0]" : "+v"(acc[ai][bj][m][n]) : "v"(Bt[n]), "v"(At[m]), "v"(sc_w), "v"(sc_a)); \
        else { acc[ai][bj][m][n] = __builtin_amdgcn_mfma_f32_16x16x32_bf16(lo8(Bt[n]), lo8(At[m]), acc[ai][bj][m][n], 0, 0, 0); acc[ai][bj][m][n] = __builtin_amdgcn_mfma_f32_16x16x32_bf16(hi8(Bt[n]), hi8(At[m]), acc[ai][bj][m][n], 0, 0, 0); } } __builtin_amdgcn_s_setprio(0); } while (0)
#define PG8_WAIT_V(n) asm volatile("s_waitcnt vmcnt(" #n ")" ::: "memory")
#define PG8_WAIT_L(n) asm volatile("s_waitcnt lgkmcnt(" #n ")" ::: "memory")
#define PG8_BAR __builtin_amdgcn_s_barrier()
#define PG8_SCHED __builtin_amdgcn_sched_barrier(0)
    Unit cur, nxt; int ui = 0;
    if (!S.next(0, cur)) return;
    f32x4 acc[2][2][4][2];
#pragma unroll
    for (int a = 0; a < 2; ++a)
#pragma unroll
        for (int b = 0; b < 2; ++b)
#pragma unroll
            for (int m = 0; m < 4; ++m)
#pragma unroll
                for (int n = 0; n < 2; ++n) acc[a][b][m][n] = (f32x4){0.f, 0.f, 0.f, 0.f};
    v8i_t At[4], B0[2], B1[2];
    int sc_w = E.scale_w, sc_a = E.scale_a;
#define PG8_ABASE(u) ((const char*)((u).seg ? g.A1 + (size_t)(u).z * g.zA1 : g.A + (size_t)(u).z * g.zA) + (size_t)(u).pm * tstepA)
#define PG8_BBASE(u) ((const char*)((u).seg ? g.Bt1 + (size_t)(u).z * g.zB1 : g.Bt + (size_t)(u).z * g.zB) + (size_t)(u).pn * tstepB)
    const char* cA = PG8_ABASE(cur); const char* cB = PG8_BBASE(cur);
    PG8_STAGE(PG8_SB(0, 0), cB, voffB); PG8_STAGE(PG8_SB(0, 1), cB + hstepB, voffB); PG8_STAGE(PG8_SA(0, 0), cA, voffA); PG8_STAGE(PG8_SA(0, 1), cA + hstepA, voffA);
    if (wr == 1) PG8_BAR;
    PG8_WAIT_V(2); PG8_BAR;
    PG8_STAGE(PG8_SB(1, 0), cB + kstep, voffB); PG8_STAGE(PG8_SA(1, 0), cA + kstep, voffA); PG8_STAGE(PG8_SB(1, 1), cB + hstepB + kstep, voffB);
    PG8_WAIT_V(6); PG8_BAR;
    for (;;) {
        const bool has_next = S.next(ui + 1, nxt);
        const char* nA = has_next ? PG8_ABASE(nxt) : cA; const char* nB = has_next ? PG8_BBASE(nxt) : cB;
        for (int t = 0; t < nt; t += 2) {
            const bool last = (t == nt - 2);
            const char* a1 = cA + (size_t)(t + 1) * kstep;
            const char* a2 = last ? nA : cA + (size_t)(t + 2) * kstep; const char* b2 = last ? nB : cB + (size_t)(t + 2) * kstep;
            const char* a3 = a2 + kstep; const char* b3 = b2 + kstep;
            PG8_LDB(B0, 0, 0); PG8_LDB(B1, 0, 1); PG8_SCHED; PG8_LDA(At, 0, 0); PG8_STAGE(PG8_SA(1, 1), a1 + hstepA, voffA);
            PG8_WAIT_V(8); PG8_WAIT_L(0); PG8_BAR; PG8_MMA(0, 0, At, B0); PG8_MMA(0, 1, At, B1); PG8_BAR; PG8_SCHED;
            PG8_LDA(At, 0, 1); PG8_STAGE(PG8_SB(0, 0), b2, voffB); PG8_STAGE(PG8_SB(0, 1), b2 + hstepB, voffB); PG8_STAGE(PG8_SA(0, 0), a2, voffA);
            PG8_WAIT_V(8); PG8_WAIT_L(0); PG8_BAR; PG8_MMA(1, 0, At, B0); PG8_MMA(1, 1, At, B1); PG8_BAR; PG8_SCHED;
            PG8_LDB(B0, 1, 0); PG8_LDB(B1, 1, 1); PG8_SCHED; PG8_LDA(At, 1, 0); PG8_STAGE(PG8_SA(0, 1), a2 + hstepA, voffA);
            PG8_WAIT_V(8); PG8_WAIT_L(0); PG8_BAR; PG8_MMA(0, 0, At, B0); PG8_MMA(0, 1, At, B1); PG8_BAR; PG8_SCHED;
            PG8_LDA(At, 1, 1); PG8_STAGE(PG8_SB(1, 0), b3, voffB); PG8_STAGE(PG8_SB(1, 1), b3 + hstepB, voffB); PG8_STAGE(PG8_SA(1, 0), a3, voffA);
            PG8_WAIT_V(8); PG8_WAIT_L(0); PG8_BAR; PG8_MMA(1, 0, At, B0); PG8_MMA(1, 1, At, B1); PG8_BAR; PG8_SCHED;
        }
        if (wr == 0) PG8_BAR;
        if constexpr (FP8) asm volatile("s_nop 15\n\ts_nop 15" ::: "memory");
        E(acc, cur, wr, wc, fr, fq);
        if (!has_next) break;
#pragma unroll
        for (int a = 0; a < 2; ++a)
#pragma unroll
            for (int b = 0; b < 2; ++b)
#pragma unroll
                for (int m = 0; m < 4; ++m)
#pragma unroll
                    for (int n = 0; n < 2; ++n) acc[a][b][m][n] = (f32x4){0.f, 0.f, 0.f, 0.f};
        cur = nxt; cA = nA; cB = nB; ++ui;
        if (wr == 1) PG8_BAR;
    }
    PG8_WAIT_V(0);
    PG8_BAR;
#undef PG8_ABASE
#undef PG8_BBASE
#undef PG8_SA
#undef PG8_SB
#undef PG8_STAGE
#undef PG8_LDA
#undef PG8_LDB
#undef PG8_MMA
#undef PG8_WAIT_V
#undef PG8_WAIT_L
#undef PG8_BAR
#undef PG8_SCHED
}
}

#define XB_TMO      128
#define XB_XCNT(j)  (256  + 64 * (j))
#define XB_XSUB(j)  (1280 + 64 * (j))
#define XB_XGEN(j)  (2304 + 64 * (j))
#define XB_TOP      3328
#define XB_TOPGEN   3392
#define XCD_BAR_WORDS 3456
#define XB_SPIN_CAP (1u << 18)
__device__ __forceinline__ unsigned xb_ld(unsigned* p)              { return __hip_atomic_load(p, __ATOMIC_RELAXED, __HIP_MEMORY_SCOPE_AGENT); }
__device__ __forceinline__ unsigned xb_add(unsigned* p, unsigned v) { return __hip_atomic_fetch_add(p, v, __ATOMIC_RELAXED, __HIP_MEMORY_SCOPE_AGENT); }
__device__ __forceinline__ unsigned xb_xcc_id() { return (unsigned)__builtin_amdgcn_s_getreg((3 << 11) | 20) & 0xFu; }
#define XB_SPIN(cond, bar) do { unsigned _sp = 0; while (cond) { __builtin_amdgcn_s_sleep(1); \
    if ((++_sp & 255u) == 0u) { if (xb_ld(&(bar)[XB_TMO])) break; if (_sp > XB_SPIN_CAP) { atomicAdd(&(bar)[XB_TMO], 1u); break; } } } } while (0)
struct XcdBarrier { unsigned* bar; unsigned x; volatile LAS unsigned* st; int wave; };
__device__ __forceinline__ XcdBarrier xcd_barrier_post(unsigned* bar, volatile LAS unsigned* st) {
    XcdBarrier b; b.bar = bar; b.x = xb_xcc_id(); b.st = st;
    if (threadIdx.x == 0) (void)xb_add(&bar[XB_XCNT(b.x)], 1u);
    return b;
}
__device__ __forceinline__ void xcd_barrier_complete(unsigned* bar, unsigned x, unsigned& nloc, unsigned& nx) {
    const unsigned G = gridDim.x * gridDim.y * gridDim.z;
    unsigned sum, cnt, mine, sp = 0u;
    for (;;) {
        sum = 0u; cnt = 0u; mine = 0u;
#pragma unroll
        for (unsigned j = 0; j < 16; ++j) { const unsigned c = xb_ld(&bar[XB_XCNT(j)]); sum += c; cnt += (c > 0u) ? 1u : 0u; mine = (j == x) ? c : mine; }
        if (sum == G) break;
        __builtin_amdgcn_s_sleep(1);
        if ((++sp & 255u) == 0u) { if (xb_ld(&bar[XB_TMO])) break; if (sp > XB_SPIN_CAP) { atomicAdd(&bar[XB_TMO], 1u); break; } }
    }
    nloc = mine > 0u ? mine : 1u; nx = cnt > 0u ? cnt : 1u;
}
__device__ __forceinline__ void xcd_barrier(const XcdBarrier& b) {
    asm volatile("s_waitcnt vmcnt(0)" ::: "memory");
    __syncthreads();
    if (b.wave == 0 && __builtin_amdgcn_mbcnt_hi(~0u, __builtin_amdgcn_mbcnt_lo(~0u, 0u)) == 0u) {
        unsigned* bar = b.bar;
        __builtin_amdgcn_s_waitcnt(0);
        unsigned nloc = b.st[0], nx = b.st[1];
        if (nloc == 0u) { xcd_barrier_complete(bar, b.x, nloc, nx); b.st[0] = nloc; b.st[1] = nx; }
        const unsigned old = xb_add(&bar[XB_XSUB(b.x)], 1u);
        const unsigned gen = old / nloc;
        if (old + 1u == (gen + 1u) * nloc) {
            __builtin_amdgcn_fence(__ATOMIC_RELEASE, "agent");
            asm volatile("s_waitcnt vmcnt(0)" ::: "memory");
            const unsigned og = xb_add(&bar[XB_TOP], 1u);
            const unsigned tg = og / nx;
            if (og + 1u == (tg + 1u) * nx) xb_add(&bar[XB_TOPGEN], 1u);
            else XB_SPIN(xb_ld(&bar[XB_TOPGEN]) == tg, bar);
            __builtin_amdgcn_fence(__ATOMIC_ACQUIRE, "agent");
            xb_add(&bar[XB_XGEN(b.x)], 1u);
            asm volatile("s_waitcnt vmcnt(0)" ::: "memory");
        } else {
            XB_SPIN(xb_ld(&bar[XB_XGEN(b.x)]) == gen, bar);
            __builtin_amdgcn_fence(__ATOMIC_ACQUIRE, "agent");
            asm volatile("s_waitcnt vmcnt(0)" ::: "memory");
        }
    }
    __syncthreads();
}

#ifndef DSA_XREP
#define DSA_XREP 0
#define DSA_XF 0
#endif
#ifndef DSA_REP_P1
#define DSA_REP_P1 1
#endif
#ifndef DSA_REP_P2
#define DSA_REP_P2 1
#endif
#ifndef DSA_REP_ATT
#define DSA_REP_ATT 1
#endif
__device__ __forceinline__ int opaque_int(int n) { asm volatile("" : "+s"(n)); return n; }
__device__ __forceinline__ int ph_reps(int k) { int n = ((REP_MASK >> k) & 1u) ? REP_N : 1; asm volatile("" : "+s"(n)); return n; }
struct Args { const float* in[26]; float* out; unsigned char* ws; int ph_lo, ph_hi; };
enum { I_X = 0, I_C, I_ADAW, I_ADAB, I_NORMG, I_WG, I_WU, I_WDN, I_ABWIN, I_LRE, I_LIM, I_LOGDT, I_BRE, I_BIM, I_CRE, I_CIM, I_S5D, I_WGLU, I_BGLU, I_KVG, I_WKVUP, I_ABWOUT,
       I_CWQKV, I_RELB, I_CWOUT, I_FING };

__device__ __forceinline__ void tr_item(const float* src, int ldsrc, int nvalid, int k0, int n0, bf16* dst, int lddst, LAS float* scr, int lane) {
    const int nn = n0 + (lane & 31); const bool ok = nn < nvalid;
#pragma unroll 8
    for (int i = 0; i < 32; ++i) { const int kk = 2 * i + (lane >> 5); scr[kk * 33 + (lane & 31)] = ok ? src[(size_t)(k0 + kk) * ldsrc + nn] : 0.f; }
    LDS_WAIT(); asm volatile("" ::: "memory");
    const int c = lane & 7;
#pragma unroll
    for (int j = 0; j < 4; ++j) { const int n = (lane >> 3) + 8 * j; const LAS float* s = scr + (8 * c) * 33 + n;
        u32x4 o; o.x = pk2(s[0 * 33], s[1 * 33]); o.y = pk2(s[2 * 33], s[3 * 33]); o.z = pk2(s[4 * 33], s[5 * 33]); o.w = pk2(s[6 * 33], s[7 * 33]);
        if (n0 + n < nvalid) *(u32x4*)(dst + (size_t)n * lddst + 8 * c) = o; }
    LDS_WAIT(); asm volatile("" ::: "memory");
}

__device__ __forceinline__ void tr_item8(const float* src, int ldsrc, int k0, int n0, unsigned char* dst, int lddst, float scale, LAS float* scr, int lane) {
    const int nn = n0 + (lane & 31);
#pragma unroll 8
    for (int i = 0; i < 32; ++i) { const int kk = 2 * i + (lane >> 5); scr[kk * 33 + (lane & 31)] = src[(size_t)(k0 + kk) * ldsrc + nn] * scale; }
    LDS_WAIT(); asm volatile("" ::: "memory");
    const int n = lane & 31, kh = lane >> 5; const LAS float* sp = scr + (32 * kh) * 33 + n;
    u32x4 o0, o1;
    o0.x = pk4_fp8(sp[0 * 33], sp[1 * 33], sp[2 * 33], sp[3 * 33]); o0.y = pk4_fp8(sp[4 * 33], sp[5 * 33], sp[6 * 33], sp[7 * 33]);
    o0.z = pk4_fp8(sp[8 * 33], sp[9 * 33], sp[10 * 33], sp[11 * 33]); o0.w = pk4_fp8(sp[12 * 33], sp[13 * 33], sp[14 * 33], sp[15 * 33]);
    o1.x = pk4_fp8(sp[16 * 33], sp[17 * 33], sp[18 * 33], sp[19 * 33]); o1.y = pk4_fp8(sp[20 * 33], sp[21 * 33], sp[22 * 33], sp[23 * 33]);
    o1.z = pk4_fp8(sp[24 * 33], sp[25 * 33], sp[26 * 33], sp[27 * 33]); o1.w = pk4_fp8(sp[28 * 33], sp[29 * 33], sp[30 * 33], sp[31 * 33]);
    unsigned char* d = dst + (size_t)n * lddst + 32 * kh;
    *(u32x4*)d = o0; *(u32x4*)(d + 16) = o1;
    LDS_WAIT(); asm volatile("" ::: "memory");
}

template <bool FP8>
__device__ __forceinline__ void tr_item64(const float* src, int ldsrc, int k0, int n0, void* dst, int lddst, float scale, LAS float* scr, int lane) {
    const float* sp = src + (size_t)(k0 + (lane >> 4)) * ldsrc + n0 + 4 * (lane & 15);
    f32x4 v[16];
#pragma unroll
    for (int i = 0; i < 16; ++i) v[i] = *(const f32x4*)(sp + (size_t)(4 * i) * ldsrc);
#pragma unroll
    for (int i = 0; i < 16; ++i) { LAS float* w = scr + (4 * i + (lane >> 4)) * 65 + 4 * (lane & 15); w[0] = v[i].x * scale; w[1] = v[i].y * scale; w[2] = v[i].z * scale; w[3] = v[i].w * scale; }
    LDS_WAIT(); asm volatile("" ::: "memory");
    if (FP8) {
        const int c = lane & 3;
#pragma unroll
        for (int j = 0; j < 4; ++j) { const int n = 16 * j + (lane >> 2); const LAS float* r = scr + (16 * c) * 65 + n;
            u32x4 o; o.x = pk4_fp8(r[0], r[65], r[130], r[195]); o.y = pk4_fp8(r[260], r[325], r[390], r[455]); o.z = pk4_fp8(r[520], r[585], r[650], r[715]); o.w = pk4_fp8(r[780], r[845], r[910], r[975]);
            *(u32x4*)((unsigned char*)dst + (size_t)n * lddst + 16 * c) = o; }
    } else {
        const int c = lane & 7;
#pragma unroll
        for (int j = 0; j < 8; ++j) { const int n = 8 * j + (lane >> 3); const LAS float* r = scr + (8 * c) * 65 + n;
            u32x4 o; o.x = pk2(r[0], r[65]); o.y = pk2(r[130], r[195]); o.z = pk2(r[260], r[325]); o.w = pk2(r[390], r[455]);
            *(u32x4*)((bf16*)dst + (size_t)n * lddst + 8 * c) = o; }
    }
    LDS_WAIT(); asm volatile("" ::: "memory");
}

__device__ __forceinline__ void p0_prologue(const Args& a, LAS unsigned char* lds, int G, int wave_s) {
    int lane_o = (int)__builtin_amdgcn_mbcnt_hi(~0u, __builtin_amdgcn_mbcnt_lo(~0u, 0u)); asm volatile("" : "+v"(lane_o)); const int lane = lane_o, wave = wave_s, tid_o = wave_s * 64 + lane_o;
    unsigned char* ws = a.ws;
    const int tid = tid_o;
    {
        LAS float* cond = (LAS float*)(lds + 131072); LAS float* red = (LAS float*)(lds + 131072 + 8192);
        for (int k = tid; k < DM; k += NTHR) cond[k] = silu_f(a.in[I_C][k]);
        __syncthreads();
        float* mod = (float*)(ws + WS_MOD);
        for (int u = blockIdx.x; u < 144; u += G) {
            const int layer = u / 72, col0 = (u % 72) * 256 + 4 * lane;
            const float* w = a.in[I_ADAW] + (size_t)layer * DM * NMOD + (size_t)(wave * 256) * NMOD + col0;
            f32x4 s4 = (f32x4){0.f, 0.f, 0.f, 0.f};
#pragma unroll 16
            for (int k = 0; k < 256; ++k) { const f32x4 v = *(const f32x4*)(w + (size_t)k * NMOD); s4 += v * cond[wave * 256 + k]; }
            *(LAS f32x4*)(red + wave * 256 + 4 * lane) = s4;
            __syncthreads();
            if (tid < 256) { float s = 0.f;
#pragma unroll
                for (int w8 = 0; w8 < 8; ++w8) s += red[w8 * 256 + tid];
                const int n = (u % 72) * 256 + tid; mod[layer * NMOD + n] = s + a.in[I_ADAB][layer * NMOD + n]; }
            __syncthreads();
        }
    }
    LAS float* scr = (LAS float*)(lds + wave * 16640);
    const int gw = blockIdx.x * NWAVES + wave, NGW = G * NWAVES;
    unsigned char* Wgu = ws + WS_WGU; unsigned char* Wd = ws + WS_WD; bf16* Win = (bf16*)(ws + WS_WIN); bf16* Wglu = (bf16*)(ws + WS_WGLU);
    bf16* Wout = (bf16*)(ws + WS_WOUT); bf16* Woutb = (bf16*)(ws + WS_WOUTB); bf16* Wqkv = (bf16*)(ws + WS_WQKV); bf16* Wcout = (bf16*)(ws + WS_WCOUT);
    constexpr int I_FFN = 4 * 3 * 2752, I_IN = 32 * 107, I_GLU = 16 * 16, I_OUT = 32 * 32, I_QKV = 32 * 96, I_CO = 32 * 32;
    constexpr int NITEMS = I_FFN + I_IN + I_GLU + I_OUT + I_QKV + I_CO;
    for (int it = gw; it < NITEMS; it += NGW) {
        int r = it;
        if (r < I_FFN) {
            const int f = r / 8256, rr = r % 8256, which = rr / 2752, q = rr % 2752;
            if (which < 2) { const int kb = q / 86, nb = q % 86, n0 = 64 * nb, k0 = 64 * kb;
                const float* src = a.in[which ? I_WU : I_WG] + (size_t)f * DM * FF;
                const int row = 256 * (n0 / 128) + (n0 % 128) + 128 * which;
                tr_item64<true>(src, FF, k0, n0, Wgu + (size_t)f * NGU * DM + (size_t)row * DM + k0, DM, 64.0f, scr, lane);
            } else { const int kb = q / 32, nb = q % 32, n0 = 64 * nb, k0 = 64 * kb;
                const float* src = a.in[I_WDN] + (size_t)f * FF * DM;
                tr_item64<true>(src, DM, k0, n0, Wd + (size_t)f * DM * FFP + (size_t)n0 * FFP + k0, FFP, 128.0f, scr, lane); }
            continue; }
        r -= I_FFN;
        if (r < I_IN) { const int kb = r / 107, nb = r % 107, n0 = 32 * nb, k0 = 64 * kb;
            if (n0 >= 1024 && n0 < 2048) continue;
            const int row = n0 + (n0 >= 2048 ? 1024 : 0);
            tr_item(a.in[I_ABWIN], 3408, 3408, k0, n0, Win + (size_t)row * DM + k0, DM, scr, lane); continue; }
        r -= I_IN;
        if (r < I_GLU) { const int kb = r / 16, nb = r % 16, n0 = 64 * nb, k0 = 64 * kb;
            tr_item64<false>(a.in[I_WGLU], 1024, k0, n0, Wglu + (size_t)n0 * 1024 + k0, 1024, 1.0f, scr, lane); continue; }
        r -= I_GLU;
        if (r < I_OUT) { const int kb = r / 32, nb = r % 32, n0 = 64 * nb, k0 = 64 * kb;
#if FP8_MIXOUT
            if (k0 < 1024) tr_item64<true>(a.in[I_ABWOUT], DM, k0, n0, (unsigned char*)Wout + (size_t)n0 * NCAT + k0, NCAT, 64.0f, scr, lane);
#else
            if (k0 < 1024) tr_item64<false>(a.in[I_ABWOUT], DM, k0, n0, Wout + (size_t)n0 * NCAT + k0, NCAT, 1.0f, scr, lane);
#endif
            else           tr_item64<false>(a.in[I_ABWOUT], DM, k0, n0, Woutb + (size_t)n0 * DM + k0, DM, 1.0f, scr, lane);
            continue; }
        r -= I_OUT;
        if (r < I_QKV) { const int kb = r / 96, nb = r % 96, n0 = 64 * nb, k0 = 64 * kb;
#if FP8_QKV
            tr_item64<true>(a.in[I_CWQKV], 6144, k0, n0, (unsigned char*)Wqkv + (size_t)n0 * DM + k0, DM, 64.0f, scr, lane); continue; }
#else
            tr_item64<false>(a.in[I_CWQKV], 6144, k0, n0, Wqkv + (size_t)n0 * DM + k0, DM, 1.0f, scr, lane); continue; }
#endif
        r -= I_QKV;
        { const int kb = r / 32, nb = r % 32, n0 = 64 * nb, k0 = 64 * kb;
#if FP8_MIXOUT
            tr_item64<true>(a.in[I_CWOUT], DM, k0, n0, (unsigned char*)Wcout + (size_t)n0 * DM + k0, DM, 64.0f, scr, lane); }
#else
            tr_item64<false>(a.in[I_CWOUT], DM, k0, n0, Wcout + (size_t)n0 * DM + k0, DM, 1.0f, scr, lane); }
#endif
    }
    {
        const int gt = blockIdx.x * NTHR + tid, NGT = G * NTHR;
        bf16* Wqraw = (bf16*)(ws + WS_WQRAW); bf16* Wupraw = (bf16*)(ws + WS_WUPRAW);
        for (int i = gt; i < 2048 * 256; i += NGT) { const int k = i >> 8, d4 = (i & 255) * 4; const f32x4 v = *(const f32x4*)(a.in[I_ABWIN] + (size_t)k * 3408 + 1024 + d4);
            u32x2 o; o.x = pk2(v.x, v.y); o.y = pk2(v.z, v.w); *(u32x2*)(Wqraw + (size_t)k * DM + d4) = o; }
        for (int i = gt; i < 256 * 512; i += NGT) { const f32x4 v = *(const f32x4*)(a.in[I_WKVUP] + (size_t)i * 4);
            u32x2 o; o.x = pk2(v.x, v.y); o.y = pk2(v.z, v.w); *(u32x2*)(Wupraw + (size_t)i * 4) = o; }
        for (int i = gt; i < (NIN - 4432) * DM / 8; i += NGT) *(u32x4*)(Win + (size_t)4432 * DM + (size_t)i * 8) = (u32x4){0u, 0u, 0u, 0u};
        for (int i = gt; i < 4 * DM * 8; i += NGT) *(u32x4*)(Wd + (size_t)(i >> 3) * FFP + FF + 16 * (i & 7)) = (u32x4){0u, 0u, 0u, 0u};
        for (int i = gt; i < SEQ * 8; i += NGT) *(u32x4*)(ws + WS_HMID + (size_t)(i >> 3) * FFP + FF + 16 * (i & 7)) = (u32x4){0u, 0u, 0u, 0u};
        if (gt < 4096) { const int g = gt >> 6;
            const double dt = exp((double)a.in[I_LOGDT][g]); const double lr = a.in[I_LRE][gt], li = a.in[I_LIM][gt];
            const double mag = exp(lr * dt), ar = mag * cos(li * dt), ai = mag * sin(li * dt);
            const double den = lr * lr + li * li, nr = ar - 1.0, fre = (nr * lr + ai * li) / den, fim = (ai * lr - nr * li) / den;
            const double m64 = exp(64.0 * lr * dt), a64r = m64 * cos(64.0 * li * dt), a64i = m64 * sin(64.0 * li * dt);
            float* T = (float*)(ws + WS_S5T);
            T[S5_AR + gt] = (float)ar; T[S5_AI + gt] = (float)ai; T[S5_A64R + gt] = (float)a64r; T[S5_A64I + gt] = (float)a64i;
            for (int c = 0; c < 16; ++c) { const double br = a.in[I_BRE][gt * 16 + c], bi = a.in[I_BIM][gt * 16 + c];
                T[S5_BBR + gt * 16 + c] = (float)(fre * br - fim * bi); T[S5_BBI + gt * 16 + c] = (float)(fre * bi + fim * br); }
        }
    }
}

template <bool FINAL, bool OUT8 = false>
__device__ __forceinline__ void norm_phase(const float* hin, const float* gvec, const float* shift, const float* scale, bf16* hn, float* fout, int G, int wave_s) {
    int lane_o = (int)__builtin_amdgcn_mbcnt_hi(~0u, __builtin_amdgcn_mbcnt_lo(~0u, 0u)); asm volatile("" : "+v"(lane_o)); const int lane = lane_o, wave = wave_s, tid_o = wave_s * 64 + lane_o;
    const int gw = blockIdx.x * NWAVES + wave, NGW = G * NWAVES;
    f32x4 gs[8], sh[8];
#pragma unroll
    for (int j = 0; j < 8; ++j) { const int c = 4 * lane + 256 * j; const f32x4 gg = *(const f32x4*)(gvec + c);
        if (FINAL) { gs[j] = gg; sh[j] = (f32x4){0.f, 0.f, 0.f, 0.f}; }
        else { const f32x4 sc = *(const f32x4*)(scale + c); gs[j] = gg * (sc + 1.0f); sh[j] = *(const f32x4*)(shift + c); } }
    for (int m = gw; m < SEQ; m += NGW) {
        const f32x4* xr = (const f32x4*)(hin + (size_t)m * DM) + lane;
        f32x4 v[8]; float s = 0.f;
#pragma unroll
        for (int j = 0; j < 8; ++j) { v[j] = xr[64 * j]; s += (v[j].x * v[j].x + v[j].y * v[j].y) + (v[j].z * v[j].z + v[j].w * v[j].w); }
        const float rstd = 1.0f / sqrtf(wave_sum(s) * (1.0f / DM) + 1e-6f);
        if (FINAL) { f32x4* o = (f32x4*)(fout + (size_t)m * DM) + lane;
#pragma unroll
            for (int j = 0; j < 8; ++j) o[64 * j] = v[j] * rstd * gs[j];
        } else if (OUT8) { unsigned* o = (unsigned*)((unsigned char*)hn + (size_t)m * DM) + lane;
#pragma unroll
            for (int j = 0; j < 8; ++j) { const f32x4 y = (v[j] * rstd * gs[j] + sh[j]) * 8.0f; o[64 * j] = pk4_fp8(y.x, y.y, y.z, y.w); }
        } else { u32x2* o = (u32x2*)(hn + (size_t)m * DM) + lane;
#pragma unroll
            for (int j = 0; j < 8; ++j) { const f32x4 y = v[j] * rstd * gs[j] + sh[j]; u32x2 w; w.x = pk2(y.x, y.y); w.y = pk2(y.z, y.w); o[64 * j] = w; } }
    }
}

__device__ __forceinline__ void s5_stage_u(const bf16* proj, int g, int j, LAS float* ut, int lane) {
    const u32x4* p = (const u32x4*)(proj + (size_t)(64 * j + lane) * NIN + C_U + 16 * g);
    const u32x4 a = p[0], b = p[1];
    LAS f32x4* o = (LAS f32x4*)(ut + lane * 16);
    o[0] = (f32x4){bflo(a.x), bfhi(a.x), bflo(a.y), bfhi(a.y)}; o[1] = (f32x4){bflo(a.z), bfhi(a.z), bflo(a.w), bfhi(a.w)};
    o[2] = (f32x4){bflo(b.x), bfhi(b.x), bflo(b.y), bfhi(b.y)}; o[3] = (f32x4){bflo(b.z), bfhi(b.z), bflo(b.w), bfhi(b.w)};
    LDS_WAIT(); asm volatile("" ::: "memory");
}
__device__ __forceinline__ void phase_a2(const Args& a, LAS unsigned char* lds, int G, int wave_s) {
    int lane_o = (int)__builtin_amdgcn_mbcnt_hi(~0u, __builtin_amdgcn_mbcnt_lo(~0u, 0u)); asm volatile("" : "+v"(lane_o)); const int lane = lane_o, wave = wave_s, tid_o = wave_s * 64 + lane_o;
    unsigned char* ws = a.ws; const bf16* proj = (const bf16*)(ws + WS_PROJ);
    const int gw = blockIdx.x * NWAVES + wave, NGW = G * NWAVES;
    { bf16* kvn = (bf16*)(ws + WS_KVN); const f32x4 gg = *(const f32x4*)(a.in[I_KVG] + 4 * lane);
      for (int m = gw; m < SEQ; m += NGW) { const u32x2 w = *(const u32x2*)(proj + (size_t)m * NIN + C_KVL + 4 * lane);
          const f32x4 v = (f32x4){bflo(w.x), bfhi(w.x), bflo(w.y), bfhi(w.y)};
          const float s = wave_sum((v.x * v.x + v.y * v.y) + (v.z * v.z + v.w * v.w)); const float rstd = 1.0f / sqrtf(s * (1.0f / 256.0f) + 1e-6f);
          const f32x4 y = v * rstd * gg; u32x2 o; o.x = pk2(y.x, y.y); o.y = pk2(y.z, y.w); *(u32x2*)(kvn + (size_t)m * 256 + 4 * lane) = o; } }
    const float* T = (const float*)(ws + WS_S5T); float* E = (float*)(ws + WS_E);
    LAS float* ut = (LAS float*)(lds + wave * 8192);
    for (int u = gw; u < 64 * 128; u += NGW) { const int g = u & 63, j = u >> 6, sp = g * 64 + lane;
        s5_stage_u(proj, g, j, ut, lane);
        const float ar = T[S5_AR + sp], ai = T[S5_AI + sp];
        float bbr[16], bbi[16];
#pragma unroll
        for (int c4 = 0; c4 < 4; ++c4) { const f32x4 r = *(const f32x4*)(T + S5_BBR + sp * 16 + 4 * c4), i = *(const f32x4*)(T + S5_BBI + sp * 16 + 4 * c4);
            bbr[4 * c4] = r.x; bbr[4 * c4 + 1] = r.y; bbr[4 * c4 + 2] = r.z; bbr[4 * c4 + 3] = r.w; bbi[4 * c4] = i.x; bbi[4 * c4 + 1] = i.y; bbi[4 * c4 + 2] = i.z; bbi[4 * c4 + 3] = i.w; }
        float xr = 0.f, xi = 0.f;
        for (int t = 0; t < 64; ++t) { const LAS f32x4* up = (const LAS f32x4*)(ut + t * 16); float bur = 0.f, bui = 0.f;
#pragma unroll
            for (int c4 = 0; c4 < 4; ++c4) { const f32x4 uv = up[c4];
                bur += bbr[4 * c4] * uv.x + bbr[4 * c4 + 1] * uv.y + bbr[4 * c4 + 2] * uv.z + bbr[4 * c4 + 3] * uv.w;
                bui += bbi[4 * c4] * uv.x + bbi[4 * c4 + 1] * uv.y + bbi[4 * c4 + 2] * uv.z + bbi[4 * c4 + 3] * uv.w; }
            const float nr = ar * xr - ai * xi + bur, ni = ar * xi + ai * xr + bui; xr = nr; xi = ni; }
        E[(size_t)(g * 128 + j) * 64 + lane] = xr; E[(size_t)(64 * 128 * 64) + (size_t)(g * 128 + j) * 64 + lane] = xi;
        LDS_WAIT(); asm volatile("" ::: "memory");
    }
}

__device__ __forceinline__ void s5_scan_out(const Args& a, LAS unsigned char* lds, int G, int wave_s) {
    int lane_o = (int)__builtin_amdgcn_mbcnt_hi(~0u, __builtin_amdgcn_mbcnt_lo(~0u, 0u)); asm volatile("" : "+v"(lane_o)); const int lane = lane_o, wave = wave_s, tid_o = wave_s * 64 + lane_o;
    unsigned char* ws = a.ws; const bf16* proj = (const bf16*)(ws + WS_PROJ);
    const int gw = blockIdx.x * NWAVES + wave, NGW = G * NWAVES;
    const float* T = (const float*)(ws + WS_S5T); const float* E = (const float*)(ws + WS_E); bf16* yap = (bf16*)(ws + WS_YAPRE);
    LAS float* ut = (LAS float*)(lds + wave * 16384);
    LAS unsigned char* X = lds + wave * 16384 + 4096;
    const int fr = lane & 15, fq = lane >> 4;
    for (int wu = gw; wu < 2048; wu += NGW) { const int g = wu & 63, jb = (wu >> 6) * 4, sp = g * 64 + lane;
        const float ar = T[S5_AR + sp], ai = T[S5_AI + sp], a64r = T[S5_A64R + sp], a64i = T[S5_A64I + sp];
        float bbr[16], bbi[16];
#pragma unroll
        for (int c4 = 0; c4 < 4; ++c4) { const f32x4 r = *(const f32x4*)(T + S5_BBR + sp * 16 + 4 * c4), i = *(const f32x4*)(T + S5_BBI + sp * 16 + 4 * c4);
            bbr[4 * c4] = r.x; bbr[4 * c4 + 1] = r.y; bbr[4 * c4 + 2] = r.z; bbr[4 * c4 + 3] = r.w; bbi[4 * c4] = i.x; bbi[4 * c4 + 1] = i.y; bbi[4 * c4 + 2] = i.z; bbi[4 * c4 + 3] = i.w; }
        bf16x8 cf[4];
#pragma unroll
        for (int ks = 0; ks < 4; ++ks) { const int k0 = 32 * ks + 8 * fq; const bool im = k0 >= 64; const float* src = a.in[im ? I_CIM : I_CRE] + (size_t)(g * 16 + fr) * 64 + (k0 & 63);
            const f32x4 v0 = *(const f32x4*)src, v1 = *(const f32x4*)(src + 4); const float sg = im ? -1.f : 1.f;
            u32x4 w; w.x = pk2(sg * v0.x, sg * v0.y); w.y = pk2(sg * v0.z, sg * v0.w); w.z = pk2(sg * v1.x, sg * v1.y); w.w = pk2(sg * v1.z, sg * v1.w);
            cf[ks] = __builtin_bit_cast(bf16x8, w); }
        const float dsk = a.in[I_S5D][g * 16 + fr];
        float xr = 0.f, xi = 0.f;
        for (int i = 0; i < jb; i += 4) { float er[4], ei[4];
#pragma unroll
            for (int q = 0; q < 4; ++q) { er[q] = E[(size_t)(g * 128 + i + q) * 64 + lane]; ei[q] = E[(size_t)(64 * 128 * 64) + (size_t)(g * 128 + i + q) * 64 + lane]; }
#pragma unroll
            for (int q = 0; q < 4; ++q) { const float nr = a64r * xr - a64i * xi + er[q], ni = a64r * xi + a64i * xr + ei[q]; xr = nr; xi = ni; } }
#pragma unroll 1
        for (int jj = 0; jj < 4; ++jj) { const int j = jb + jj;
        s5_stage_u(proj, g, j, ut, lane);
        for (int tt = 0; tt < 4; ++tt) {
            for (int t16 = 0; t16 < 16; ++t16) { const LAS f32x4* up = (const LAS f32x4*)(ut + (16 * tt + t16) * 16); float bur = 0.f, bui = 0.f;
#pragma unroll
                for (int c4 = 0; c4 < 4; ++c4) { const f32x4 uv = up[c4];
                    bur += bbr[4 * c4] * uv.x + bbr[4 * c4 + 1] * uv.y + bbr[4 * c4 + 2] * uv.z + bbr[4 * c4 + 3] * uv.w;
                    bui += bbi[4 * c4] * uv.x + bbi[4 * c4 + 1] * uv.y + bbi[4 * c4 + 2] * uv.z + bbi[4 * c4 + 3] * uv.w; }
                const float nr = ar * xr - ai * xi + bur, ni = ar * xi + ai * xr + bui; xr = nr; xi = ni;
                *(LAS unsigned short*)(X + t16 * 272 + 2 * lane) = (unsigned short)f2bf(xr); *(LAS unsigned short*)(X + t16 * 272 + 128 + 2 * lane) = (unsigned short)f2bf(xi); }
            LDS_WAIT(); asm volatile("" ::: "memory");
            f32x4 acc = (f32x4){0.f, 0.f, 0.f, 0.f};
#pragma unroll
            for (int ks = 0; ks < 4; ++ks) { const bf16x8 af = *(const LAS bf16x8*)(X + fr * 272 + 64 * ks + 16 * fq); acc = __builtin_amdgcn_mfma_f32_16x16x32_bf16(af, cf[ks], acc, 0, 0, 0); }
#pragma unroll
            for (int r = 0; r < 4; ++r) { const int tl = 16 * tt + 4 * fq + r; const float y = acc[r] + dsk * ut[tl * 16 + fr];
                yap[(size_t)(64 * j + tl) * 1024 + 16 * g + fr] = (bf16)f2bf(gelu_tanh_f(y)); }
            LDS_WAIT(); asm volatile("" ::: "memory");
        }
        }
    }
}

__device__ __forceinline__ void lds_add(LAS unsigned* p, unsigned v) { (void)__hip_atomic_fetch_add(p, v, __ATOMIC_RELAXED, __HIP_MEMORY_SCOPE_WORKGROUP); }
__device__ __forceinline__ float relu_i(float x) { int xi = __builtin_bit_cast(int, x); xi = xi > 0 ? xi : 0; return __builtin_bit_cast(float, xi); }
__device__ __forceinline__ unsigned ord_key(float s) { const unsigned u = __builtin_bit_cast(unsigned, s); return u ^ ((u >> 31) ? 0xFFFFFFFFu : 0x80000000u); }
template <int NB, bool PACKED>
__device__ __forceinline__ void hist_search(const LAS unsigned* hist, int field, unsigned need, int lane, int& bstar, unsigned& above) {
    constexpr int PER = NB / 64;
    const int sh = PACKED ? 16 * field : 0; const unsigned fm = PACKED ? 0xffffu : 0xffffffffu;
    unsigned tot = 0;
#pragma unroll 4
    for (int i = 0; i < PER; i += 4) { const u32x4 h = *(const LAS u32x4*)(hist + lane * PER + i); tot += ((h.x >> sh) & fm) + ((h.y >> sh) & fm) + ((h.z >> sh) & fm) + ((h.w >> sh) & fm); }
    unsigned incl = tot;
#pragma unroll
    for (int o = 1; o < 64; o <<= 1) { const unsigned v = __shfl_down(incl, o); if (lane + o < 64) incl += v; }
    const unsigned excl = incl - tot;
    const unsigned long long mask = __ballot(incl >= need);
    const int lstar = 63 - __builtin_clzll(mask | 1ull);
    unsigned cum = excl; int b = -1; unsigned ab = 0;
#pragma unroll 1
    for (int i = PER - 4; i >= 0; i -= 4) { const u32x4 h = *(const LAS u32x4*)(hist + lane * PER + i);
        const unsigned c3 = (h.w >> sh) & fm, c2 = (h.z >> sh) & fm, c1 = (h.y >> sh) & fm, c0 = (h.x >> sh) & fm;
        if (b < 0) { if (cum + c3 >= need) { b = lane * PER + i + 3; ab = cum; } else cum += c3; }
        if (b < 0) { if (cum + c2 >= need) { b = lane * PER + i + 2; ab = cum; } else cum += c2; }
        if (b < 0) { if (cum + c1 >= need) { b = lane * PER + i + 1; ab = cum; } else cum += c1; }
        if (b < 0) { if (cum + c0 >= need) { b = lane * PER + i + 0; ab = cum; } else cum += c0; } }
    bstar = __shfl(b, lstar); above = __shfl(ab, lstar);
}

template <int MODE, int XF = 0>
__device__ __forceinline__ void dsa_pass(const bf16* proj, LAS unsigned char* lds, LAS unsigned char* wl, int nadm, int tid, int lane, const bf16x8 (&qa)[4], const float (&wv)[16],
                                         unsigned myb, unsigned& ns0, unsigned& ns1, unsigned& nc0, unsigned& nc1, float* srow = nullptr) {
    const int l31 = lane & 31, hh = lane >> 5;
    LAS unsigned* hist = (LAS unsigned*)wl; LAS unsigned* cok = (LAS unsigned*)wl; LAS int* cix = (LAS int*)(wl + 4096); LAS int* sel = (LAS int*)(wl + 16896);
    const int skey = tid >> 3, ssub = tid & 7;
    const bf16* gsrc = proj + (size_t)skey * NIN + C_KI + 8 * ssub;
    const int sdst = ((skey >> 5) * 18944) + 8192 + (skey & 31) * 128 + ((ssub ^ (skey & 7)) * 16);
    const int nch = (nadm + 127) / 128;
#define DSA_LD(c_, r0_, r1_) do { const int cc_ = (c_) < nch ? (c_) : nch - 1; r0_ = *(const u32x4*)(gsrc + (size_t)(128 * cc_) * NIN); r1_ = *(const u32x4*)(gsrc + (size_t)(128 * cc_ + 64) * NIN); } while (0)
    u32x4 stg0, stg1, sA0, sA1, sB0, sB1, sC0, sC1;
    DSA_LD(0, stg0, stg1); DSA_LD(1, sA0, sA1); DSA_LD(2, sB0, sB1); DSA_LD(3, sC0, sC1);
    if (!(XF & 2)) { *(LAS u32x4*)(lds + sdst) = stg0; *(LAS u32x4*)(lds + sdst + 2 * 18944) = stg1; }
    __syncthreads();
    for (int ch = 0; ch < nch; ++ch) {
        if (!(XF & 2)) { stg0 = sA0; stg1 = sA1; sA0 = sB0; sA1 = sB1; sB0 = sC0; sB1 = sC1; DSA_LD(ch + 4, sC0, sC1); }
        {
            const bool full = 128 * ch + 64 < nadm;
            const LAS unsigned char* tb = lds + ((ch & 1) * 4) * 18944 + 8192 + l31 * 128;
            f32x16 acc[4];
#pragma unroll
            for (int tl = 0; tl < 4; ++tl)
#pragma unroll
                for (int i = 0; i < 16; ++i) acc[tl][i] = 0.f;
#pragma unroll
            for (int tl = 0; tl < 4; ++tl) { if (tl < 2 || full) {
#pragma unroll
                for (int ks = 0; ks < 4; ++ks) { const bf16x8 kf = *(const LAS bf16x8*)(tb + tl * 18944 + (((2 * ks + hh) ^ (l31 & 7)) * 16));
                    if (!(XF & 8)) acc[tl] = __builtin_amdgcn_mfma_f32_32x32x16_bf16(qa[ks], kf, acc[tl], 0, 0, 0); else acc[tl][ks] += __builtin_bit_cast(float, (int)kf[0] << 16); } } }
#pragma unroll
            for (int tl = 0; tl < 4; ++tl) { if (tl < 2 || full) {
                float s0 = 0.f, s1 = 0.f;
#pragma unroll
                for (int i = 0; i < ((XF & 16) ? 2 : 16); i += 2) { s0 += wv[i] * relu_i(acc[tl][i]); s1 += wv[i + 1] * relu_i(acc[tl][i + 1]); }
                const unsigned ok = ord_key(s0 + s1), bin = ok >> 21;
                if (MODE == 1) { lds_add(&hist[bin], 1u << (16 * hh)); __builtin_nontemporal_store(s0 + s1, srow + 128 * ch + 32 * tl + l31); }
                else if (MODE == 3) { if (!(XF & 1)) lds_add(&hist[bin], 0u); else asm volatile("" :: "v"(bin)); }
                else {
                    const int key = 128 * ch + 32 * tl + l31;
                    const bool isel = bin > myb, icand = bin == myb;
                    const unsigned long long ms = __ballot(isel), mc = __ballot(icand);
                    const unsigned ms0 = (unsigned)ms, ms1 = (unsigned)(ms >> 32), mc0 = (unsigned)mc, mc1 = (unsigned)(mc >> 32);
                    const unsigned lowm = (1u << l31) - 1u;
                    const unsigned ps = (hh ? ns1 + (unsigned)__builtin_popcount(ms1 & lowm) : ns0 + (unsigned)__builtin_popcount(ms0 & lowm));
                    const unsigned pc = (hh ? nc1 + (unsigned)__builtin_popcount(mc1 & lowm) : nc0 + (unsigned)__builtin_popcount(mc0 & lowm));
                    if (isel && ps < 256u) sel[hh * 256 + ps] = key;
                    if (icand && pc < 512u) { cok[hh * 512 + pc] = ok; cix[hh * 512 + pc] = key; }
                    ns0 += (unsigned)__builtin_popcount(ms0); ns1 += (unsigned)__builtin_popcount(ms1); nc0 += (unsigned)__builtin_popcount(mc0); nc1 += (unsigned)__builtin_popcount(mc1);
                }
            } }
        }
        if (!(XF & 2) && ch + 1 < nch) { const int bo = ((ch + 1) & 1) * 4 * 18944; *(LAS u32x4*)(lds + sdst + bo) = stg0; *(LAS u32x4*)(lds + sdst + bo + 2 * 18944) = stg1; }
        if (!(XF & 4)) __syncthreads();
    }
    if (XF & 4) __syncthreads();
#undef DSA_LD
}

__device__ __forceinline__ void dsa_phase(const Args& a, LAS unsigned char* lds, int G, int wave_s) {
    int lane_o = (int)__builtin_amdgcn_mbcnt_hi(~0u, __builtin_amdgcn_mbcnt_lo(~0u, 0u)); asm volatile("" : "+v"(lane_o)); const int lane = lane_o, wave = wave_s, tid_o = wave_s * 64 + lane_o;
    unsigned char* ws = a.ws; const bf16* proj = (const bf16*)(ws + WS_PROJ); const bf16* kvn = (const bf16*)(ws + WS_KVN);
    bf16* ycat = (bf16*)(ws + WS_YCAT);
    constexpr int WREG = 18944;
    LAS unsigned char* wl = lds + wave * WREG;
    LAS unsigned* hist = (LAS unsigned*)wl; LAS int* sel = (LAS int*)(wl + 16896);
    const int l31 = lane & 31, hh = lane >> 5, fr = lane & 15, fq = lane >> 4;
#if TIMING
    unsigned long long tseg[6] = {0, 0, 0, 0, 0, 0}, tlast = __builtin_amdgcn_s_memrealtime();
#define DSA_SEG(i_) do { const unsigned long long n_ = __builtin_amdgcn_s_memrealtime(); tseg[i_] += n_ - tlast; tlast = n_; } while (0)
#else
#define DSA_SEG(i_) do { } while (0)
#endif
    for (int un = blockIdx.x; un < 512; un += G) {
        __syncthreads();
        const int unit = (un < 256) ? un : 767 - un;
        const int t0 = unit * 16, tq = t0 + 2 * wave;
        const int nadm = ((t0 >> 6) + 1) * 64;
        if (nadm > 256) {
            bf16x8 qa[4];
            { const int r = l31, qq = (r >> 2) & 1, head = (r & 3) + 4 * (r >> 3);
              const bf16* qp = proj + (size_t)(tq + qq) * NIN + C_QI + head * 64 + 8 * hh;
#pragma unroll
              for (int ks = 0; ks < 4; ++ks) qa[ks] = *(const bf16x8*)(qp + 16 * ks); }
            float wv[16];
            { const u32x4 w0 = *(const u32x4*)(proj + (size_t)(tq + hh) * NIN + C_WI), w1 = *(const u32x4*)(proj + (size_t)(tq + hh) * NIN + C_WI + 8);
              const float sc = 1.0f / 32.0f;
              wv[0] = bflo(w0.x) * sc; wv[1] = bfhi(w0.x) * sc; wv[2] = bflo(w0.y) * sc; wv[3] = bfhi(w0.y) * sc; wv[4] = bflo(w0.z) * sc; wv[5] = bfhi(w0.z) * sc; wv[6] = bflo(w0.w) * sc; wv[7] = bfhi(w0.w) * sc;
              wv[8] = bflo(w1.x) * sc; wv[9] = bfhi(w1.x) * sc; wv[10] = bflo(w1.y) * sc; wv[11] = bfhi(w1.y) * sc; wv[12] = bflo(w1.z) * sc; wv[13] = bfhi(w1.z) * sc; wv[14] = bflo(w1.w) * sc; wv[15] = bfhi(w1.w) * sc; }
            unsigned ns0 = 0, ns1 = 0, nc0 = 0, nc1 = 0;
#if DSA_REP_P1 > 1
            for (int rp1 = 0, np1 = opaque_int(DSA_REP_P1); rp1 < np1; ++rp1)
#endif
            {
                for (int i = lane; i < 2048; i += 64) hist[i] = 0u;
                dsa_pass<1>(proj, lds, wl, nadm, tid_o, lane, qa, wv, 0u, ns0, ns1, nc0, nc1, (float*)(ws + WS_SCORE) + (size_t)(tq + hh) * SEQ);
            }
#if DSA_XREP > 0
            for (int rx = 0, nx = opaque_int(DSA_XREP); rx < nx; ++rx) dsa_pass<3, DSA_XF>(proj, lds, wl, nadm, tid_o, lane, qa, wv, 0u, ns0, ns1, nc0, nc1);
#endif
            DSA_SEG(1);
            int b1[2]; unsigned ab1[2];
            hist_search<2048, true>(hist, 0, 256u, lane, b1[0], ab1[0]);
            hist_search<2048, true>(hist, 1, 256u, lane, b1[1], ab1[1]);
            asm volatile("" ::: "memory");
            DSA_SEG(2);
            LAS unsigned* cok = (LAS unsigned*)wl; LAS int* cix = (LAS int*)(wl + 4096);
            VM_WAIT();
#if DSA_REP_P2 > 1
            for (int rp2 = 0, np2 = opaque_int(DSA_REP_P2); rp2 < np2; ++rp2)
#endif
            {
                ns0 = 0; ns1 = 0; nc0 = 0; nc1 = 0;
#pragma unroll 1
                for (int qq = 0; qq < 2; ++qq) {
                    const float* sr = (const float*)(ws + WS_SCORE) + (size_t)(tq + qq) * SEQ + lane;
                    const unsigned bq = (unsigned)(qq ? b1[1] : b1[0]); unsigned ns = 0, nc = 0;
                    const unsigned long long lowm = (1ull << lane) - 1ull;
                    for (int k0 = 0; k0 < nadm; k0 += 256) {
                        float v[4];
#pragma unroll
                        for (int u = 0; u < 4; ++u) v[u] = (k0 + 64 * u < nadm) ? __builtin_nontemporal_load(sr + k0 + 64 * u) : 0.f;
#pragma unroll
                        for (int u = 0; u < 4; ++u) { if (k0 + 64 * u < nadm) {
                            const unsigned ok = ord_key(v[u]), bin = ok >> 21; const bool isel = bin > bq, icand = bin == bq;
                            const unsigned long long ms = __ballot(isel), mc = __ballot(icand);
                            const unsigned ps = ns + (unsigned)__builtin_popcountll(ms & lowm), pc = nc + (unsigned)__builtin_popcountll(mc & lowm);
                            if (isel && ps < 256u) sel[qq * 256 + ps] = k0 + 64 * u + lane;
                            if (icand && pc < 512u) { cok[qq * 512 + pc] = ok; cix[qq * 512 + pc] = k0 + 64 * u + lane; }
                            ns += (unsigned)__builtin_popcountll(ms); nc += (unsigned)__builtin_popcountll(mc); } }
                    }
                    if (qq) { ns1 = ns; nc1 = nc; } else { ns0 = ns; nc0 = nc; }
                }
            }
            LDS_WAIT(); asm volatile("" ::: "memory");
            DSA_SEG(3);
#pragma unroll 1
            for (int qq = 0; qq < 2; ++qq) {
                const unsigned nsq = qq ? ns1 : ns0; unsigned C = qq ? nc1 : nc0; C = C > 512u ? 512u : C;
                const unsigned need = nsq < 256u ? 256u - nsq : 0u;
                const unsigned C4 = (C + 3u) & ~3u;
                for (unsigned i = C + lane; i < C4; i += 64) cok[qq * 512 + i] = 0u;
                LDS_WAIT(); asm volatile("" ::: "memory");
                for (unsigned i0 = 0; i0 < C; i0 += 64) {
                    const unsigned i = i0 + lane; const bool act = i < C;
                    const unsigned mk = act ? cok[qq * 512 + i] : 0u;
                    unsigned rank = 0;
                    for (unsigned j = 0; j < C4; j += 4) { const u32x4 o = *(const LAS u32x4*)(cok + qq * 512 + j);
                        rank += (o.x > mk || (o.x == mk && j + 0 < i)) ? 1u : 0u; rank += (o.y > mk || (o.y == mk && j + 1 < i)) ? 1u : 0u;
                        rank += (o.z > mk || (o.z == mk && j + 2 < i)) ? 1u : 0u; rank += (o.w > mk || (o.w == mk && j + 3 < i)) ? 1u : 0u; }
                    if (act && rank < need) sel[qq * 256 + nsq + rank] = cix[qq * 512 + i];
                }
                const unsigned filled = nsq + (need < C ? need : C);
                for (unsigned i = filled + lane; i < 256u; i += 64) sel[qq * 256 + i] = -1;
            }
            LDS_WAIT(); asm volatile("" ::: "memory");
        } else {
            for (int i = lane; i < 512; i += 64) { const int k = i & 255; sel[i] = k < nadm ? k : -1; }
            LDS_WAIT(); asm volatile("" ::: "memory");
        }
        DSA_SEG(4);
#pragma unroll 1
        for (int qq = 0; qq < 2 * DSA_REP_ATT; ++qq) {
            const int t = tq + (qq & 1); const int head = fr & 7;
            const float slope = fast_exp2(-(float)(head + 1));
            bf16x8 qf[8];
            { const bf16* qp = proj + (size_t)t * NIN + C_QT + head * 256 + 8 * fq;
#pragma unroll
              for (int ks = 0; ks < 8; ++ks) qf[ks] = *(const bf16x8*)(qp + 32 * ks); }
            f32x4 oacc[16];
#pragma unroll
            for (int i = 0; i < 16; ++i) oacc[i] = (f32x4){0.f, 0.f, 0.f, 0.f};
            float mrun = -1e30f, lrun = 0.f;
            u32x4 gr[16];
#pragma unroll
            for (int i = 0; i < 16; ++i) { int s = sel[(qq & 1) * 256 + hh + 2 * i]; s = s < 0 ? 0 : s; gr[i] = *(const u32x4*)(kvn + (size_t)s * 256 + 8 * l31); }
            for (int kt = 0; kt < 8; ++kt) {
                asm volatile("" ::: "memory");
#pragma unroll
                for (int i = 0; i < 16; ++i) *(LAS u32x4*)(wl + (hh + 2 * i) * 528 + 16 * l31) = gr[i];
                if (kt + 1 < 8) {
#pragma unroll
                    for (int i = 0; i < 16; ++i) { int s = sel[(qq & 1) * 256 + 32 * (kt + 1) + hh + 2 * i]; s = s < 0 ? 0 : s; gr[i] = *(const u32x4*)(kvn + (size_t)s * 256 + 8 * l31); } }
                LDS_WAIT(); asm volatile("" ::: "memory");
                f32x4 sacc[2];
#pragma unroll
                for (int sb = 0; sb < 2; ++sb) { f32x4 c4 = (f32x4){0.f, 0.f, 0.f, 0.f};
#pragma unroll
                    for (int ks = 0; ks < 8; ++ks) { const bf16x8 af = *(const LAS bf16x8*)(wl + (16 * sb + fr) * 528 + 64 * ks + 16 * fq); c4 = __builtin_amdgcn_mfma_f32_16x16x32_bf16(af, qf[ks], c4, 0, 0, 0); }
                    sacc[sb] = c4; }
                float lg[8]; float mx = -1e30f;
#pragma unroll
                for (int sb = 0; sb < 2; ++sb) { const LAS int* sp = sel + (qq & 1) * 256 + 32 * kt + 16 * sb + 4 * fq;
#pragma unroll
                    for (int r = 0; r < 4; ++r) { const int s = sp[r]; const float d = (float)(t - s); float v = sacc[sb][r] - slope * fabsf(d); v = s < 0 ? -1e30f : v; lg[4 * sb + r] = v; mx = fmaxf(mx, v); } }
                mx = fmaxf(mx, __shfl_xor(mx, 16)); mx = fmaxf(mx, __shfl_xor(mx, 32));
                const float mnew = fmaxf(mrun, mx); const float alpha = fast_exp2((mrun - mnew) * 1.4426950408889634f);
                float ps = 0.f; float p[8];
#pragma unroll
                for (int i = 0; i < 8; ++i) { p[i] = lg[i] <= -1e29f ? 0.f : fast_exp2((lg[i] - mnew) * 1.4426950408889634f); ps += p[i]; }
                lrun = lrun * alpha + ps; mrun = mnew;
#pragma unroll
                for (int i = 0; i < 16; ++i) oacc[i] = oacc[i] * alpha;
                u32x4 pw; pw.x = pk2(p[0], p[1]); pw.y = pk2(p[2], p[3]); pw.z = pk2(p[4], p[5]); pw.w = pk2(p[6], p[7]);
                const bf16x8 pf = __builtin_bit_cast(bf16x8, pw);
#pragma unroll
                for (int rt = 0; rt < 16; ++rt) {
                    const LAS unsigned char* p0 = wl + (4 * fq + (fr >> 2)) * 528 + (16 * rt + 4 * (fr & 3)) * 2;
                    const v4i16_t a0 = __builtin_amdgcn_ds_read_tr16_b64_v4i16((LAS v4i16_t*)p0);
                    const v4i16_t a1 = __builtin_amdgcn_ds_read_tr16_b64_v4i16((LAS v4i16_t*)(p0 + 16 * 528));
                    bf16x8 af; af[0] = a0[0]; af[1] = a0[1]; af[2] = a0[2]; af[3] = a0[3]; af[4] = a1[0]; af[5] = a1[1]; af[6] = a1[2]; af[7] = a1[3];
                    oacc[rt] = __builtin_amdgcn_mfma_f32_16x16x32_bf16(af, pf, oacc[rt], 0, 0, 0); }
                LDS_WAIT(); asm volatile("" ::: "memory");
            }
            float lt = lrun; lt += __shfl_xor(lt, 16); lt += __shfl_xor(lt, 32);
            const float inv = 1.0f / lt;
#if FP8_MIXOUT
            if (fr < 8) { unsigned char* op = (unsigned char*)ycat + (size_t)t * NCAT + 1024 + fr * 256 + 4 * fq; const float inv8 = inv * 8.0f;
#pragma unroll
                for (int rt = 0; rt < 16; ++rt) { const f32x4 v = oacc[rt] * inv8; *(unsigned*)(op + 16 * rt) = pk4_fp8(v.x, v.y, v.z, v.w); } }
#else
            if (fr < 8) { bf16* op = ycat + (size_t)t * NCAT + 1024 + fr * 256 + 4 * fq;
#pragma unroll
                for (int rt = 0; rt < 16; ++rt) { const f32x4 v = oacc[rt] * inv; u32x2 w; w.x = pk2(v.x, v.y); w.y = pk2(v.z, v.w); *(u32x2*)(op + 16 * rt) = w; } }
#endif
        }
        LDS_WAIT(); asm volatile("" ::: "memory");
        DSA_SEG(5);
    }
#if TIMING
    if (blockIdx.x == TBLK && wave_s == 0 && lane == 0) { unsigned long long* ts = (unsigned long long*)(ws + WS_DIAG) + 32; unsigned long long c = 0; ts[0] = 0;
        for (int i = 0; i < 6; ++i) { c += tseg[i]; ts[1 + i] = c; } }
#endif
#undef DSA_SEG
}

__device__ __forceinline__ void attn_c_phase(const Args& a, LAS unsigned char* lds, int G, int wave_s) {
    int lane_o = (int)__builtin_amdgcn_mbcnt_hi(~0u, __builtin_amdgcn_mbcnt_lo(~0u, 0u)); asm volatile("" : "+v"(lane_o)); const int lane = lane_o, wave = wave_s, tid_o = wave_s * 64 + lane_o;
    unsigned char* ws = a.ws; const bf16* Q = (const bf16*)(ws + WS_Q); const bf16* K = (const bf16*)(ws + WS_K); const bf16* VT = (const bf16*)(ws + WS_VT); bf16* O = (bf16*)(ws + WS_O);
    LAS float* btab = (LAS float*)(lds + 65536);
    const int l31 = lane & 31, hh = lane >> 5;
    const float sc = 0.08838834764831845f * 1.4426950408889634f;
    const int kkey = tid_o >> 4, kc = tid_o & 15, vd = tid_o >> 3, vc = tid_o & 7;
    for (int un = blockIdx.x; un < 512; un += G) {
        const int head = un >> 5, cg = un & 31, ci = wave >> 1, chunk = 4 * cg + ci;
        __syncthreads();
        for (int i = tid_o; i < 513; i += NTHR) btab[i] = a.in[I_RELB][head * 513 + i] * 1.4426950408889634f;
        const int t = 64 * chunk + 32 * (wave & 1) + l31;
        bf16x8 qf[8];
        { const bf16* qp = Q + (size_t)t * DM + head * 128 + 8 * hh;
#pragma unroll
          for (int ks = 0; ks < 8; ++ks) qf[ks] = *(const bf16x8*)(qp + 16 * ks); }
        f32x16 oacc[4];
#pragma unroll
        for (int d = 0; d < 4; ++d)
#pragma unroll
            for (int i = 0; i < 16; ++i) oacc[d][i] = 0.f;
        float mrun = -1e30f, lrun = 0.f;
        const int cb0 = 4 * cg - 8;
        const int j0 = cb0 < 0 ? -cb0 : 0;
        const bf16* kg = K + (size_t)kkey * DM + head * 128 + kc * 8; const bf16* vg = VT + (size_t)(head * 128 + vd) * SEQ + vc * 8;
        const int kdst = kkey * 256 + ((kc ^ (kkey & 15)) * 16), vdst = 16384 + vd * 128 + ((vc ^ ((vd >> 1) & 7)) * 16);
        u32x4 sk0, sk1, sv0, sv1;
#define ATC_LD(j_) do { const size_t s0_ = (size_t)(64 * (cb0 + (j_))); sk0 = *(const u32x4*)(kg + s0_ * DM); sk1 = *(const u32x4*)(kg + (s0_ + 32) * DM); sv0 = *(const u32x4*)(vg + s0_); sv1 = *(const u32x4*)(vg + s0_ + (size_t)64 * SEQ); } while (0)
#define ATC_ST(b_) do { LAS unsigned char* d_ = lds + (b_) * 32768; *(LAS u32x4*)(d_ + kdst) = sk0; *(LAS u32x4*)(d_ + kdst + 32 * 256) = sk1; *(LAS u32x4*)(d_ + vdst) = sv0; *(LAS u32x4*)(d_ + vdst + 64 * 128) = sv1; } while (0)
        ATC_LD(j0); ATC_ST(j0 & 1);
        __syncthreads();
        for (int j = j0; j < 12; ++j) {
            if (j + 1 < 12) ATC_LD(j + 1);
            if (j >= ci && j <= ci + 8) {
                const LAS unsigned char* kb = lds + (j & 1) * 32768; const LAS unsigned char* vb = kb + 16384;
                const int s0 = 64 * (cb0 + j);
#pragma unroll
                for (int sub = 0; sub < 2; ++sub) {
                    f32x16 sa;
#pragma unroll
                    for (int i = 0; i < 16; ++i) sa[i] = 0.f;
                    const int krow = 32 * sub + l31;
#pragma unroll
                    for (int ks = 0; ks < 8; ++ks) { const bf16x8 kf = *(const LAS bf16x8*)(kb + krow * 256 + (((2 * ks + hh) ^ (krow & 15)) * 16)); sa = __builtin_amdgcn_mfma_f32_32x32x16_bf16(kf, qf[ks], sa, 0, 0, 0); }
                    float mx = -1e30f; float lg[16];
#pragma unroll
                    for (int i = 0; i < 16; ++i) { const int s = s0 + 32 * sub + (i & 3) + 8 * (i >> 2) + 4 * hh; int rel = t - s; rel = rel > 256 ? 256 : rel; lg[i] = sa[i] * sc + btab[rel + 256]; mx = fmaxf(mx, lg[i]); }
                    mx = fmaxf(mx, __shfl_xor(mx, 32));
                    const float mnew = fmaxf(mrun, mx), alpha = fast_exp2(mrun - mnew);
                    float ps = 0.f; float p[16];
#pragma unroll
                    for (int i = 0; i < 16; ++i) { p[i] = fast_exp2(lg[i] - mnew); ps += p[i]; }
                    lrun = lrun * alpha + ps; mrun = mnew;
#pragma unroll
                    for (int d = 0; d < 4; ++d)
#pragma unroll
                        for (int i = 0; i < 16; ++i) oacc[d][i] *= alpha;
#pragma unroll
                    for (int s = 0; s < 2; ++s) {
                        u32x4 pw; pw.x = pk2(p[8 * s], p[8 * s + 1]); pw.y = pk2(p[8 * s + 2], p[8 * s + 3]); pw.z = pk2(p[8 * s + 4], p[8 * s + 5]); pw.w = pk2(p[8 * s + 6], p[8 * s + 7]);
                        const bf16x8 pf = __builtin_bit_cast(bf16x8, pw);
                        const int q0 = 8 * sub + 4 * s + hh;
#pragma unroll
                        for (int d = 0; d < 4; ++d) { const int dr = 32 * d + l31; const LAS unsigned char* vr = vb + dr * 128 + (q0 & 1) * 8; const int sw = (dr >> 1) & 7;
                            const u32x2 v0 = *(const LAS u32x2*)(vr + (((q0 >> 1) ^ sw) * 16)), v1 = *(const LAS u32x2*)(vr + ((((q0 >> 1) + 1) ^ sw) * 16));
                            u32x4 vw; vw.x = v0.x; vw.y = v0.y; vw.z = v1.x; vw.w = v1.y;
                            oacc[d] = __builtin_amdgcn_mfma_f32_32x32x16_bf16(__builtin_bit_cast(bf16x8, vw), pf, oacc[d], 0, 0, 0); }
                    }
                }
            }
            if (j + 1 < 12) ATC_ST((j + 1) & 1);
            __syncthreads();
        }
#undef ATC_LD
#undef ATC_ST
        float lt = lrun + __shfl_xor(lrun, 32); const float inv = 1.0f / lt;
#if FP8_MIXOUT
        unsigned char* op = (unsigned char*)O + (size_t)t * DM + head * 128 + 4 * hh; const float inv8 = inv * 8.0f;
#pragma unroll
        for (int d = 0; d < 4; ++d)
#pragma unroll
            for (int gq = 0; gq < 4; ++gq) *(unsigned*)(op + 32 * d + 8 * gq) = pk4_fp8(oacc[d][4 * gq] * inv8, oacc[d][4 * gq + 1] * inv8, oacc[d][4 * gq + 2] * inv8, oacc[d][4 * gq + 3] * inv8);
#else
        bf16* op = O + (size_t)t * DM + head * 128 + 4 * hh;
#pragma unroll
        for (int d = 0; d < 4; ++d)
#pragma unroll
            for (int gq = 0; gq < 4; ++gq) { u32x2 w; w.x = pk2(oacc[d][4 * gq] * inv, oacc[d][4 * gq + 1] * inv); w.y = pk2(oacc[d][4 * gq + 2] * inv, oacc[d][4 * gq + 3] * inv);
                *(u32x2*)(op + 32 * d + 8 * gq) = w; }
#endif
    }
    __syncthreads();
}

__global__ void __launch_bounds__(NTHR, 2) fwd_kernel(Args args) {
    extern __shared__ __attribute__((aligned(16))) unsigned char lds_raw[];
    LAS unsigned char* lds = (LAS unsigned char*)lds_raw;
    volatile LAS unsigned* MISC = (volatile LAS unsigned*)(lds + MISC_OFF);
    const int wave_s = __builtin_amdgcn_readfirstlane((int)threadIdx.x >> 6);
    const int G = gridDim.x;
    unsigned char* ws = args.ws;
    if (threadIdx.x < 64) MISC[threadIdx.x] = 0u;
    __syncthreads();
    const int lo = args.ph_lo, hi = args.ph_hi;
    const bool multi = (hi - lo) > 1;
    XcdBarrier bar; bar.bar = (unsigned*)(ws + WS_CTL) + CW_BAR; bar.x = 0; bar.st = nullptr;
    if (multi) bar = xcd_barrier_post((unsigned*)(ws + WS_CTL) + CW_BAR, MISC + 8);
    bar.wave = wave_s;
#define IN(k) (lo <= (k) && (k) < hi)
#if TIMING
#define STAMP(k) do { if (blockIdx.x == 0 && wave_s == 0 && __builtin_amdgcn_mbcnt_hi(~0u, __builtin_amdgcn_mbcnt_lo(~0u, 0u)) == 0u) __hip_atomic_store((unsigned long long*)(ws + WS_DIAG) + (k), __builtin_amdgcn_s_memrealtime(), __ATOMIC_RELAXED, __HIP_MEMORY_SCOPE_AGENT); } while (0)
#define SEAM(k) do { if (IN((k) + 1)) xcd_barrier(bar); STAMP((k) + 1); } while (0)
#else
#define STAMP(k) do { } while (0)
#define SEAM(k) do { if (IN((k) + 1)) xcd_barrier(bar); } while (0)
#endif

 #if REP_MASK
#define PH_LOOP(k) _Pragma("unroll") for (int r_ = 0; r_ < ((((REP_MASK) >> (k)) & 1u) ? REP_N : 1); ++r_)
#else
#define PH_LOOP(k)
#endif
    float* H = args.out;
    float* mod = (float*)(ws + WS_MOD);
    bf16* hn = (bf16*)(ws + WS_HN); bf16* hmid = (bf16*)(ws + WS_HMID); bf16* proj = (bf16*)(ws + WS_PROJ);

    STAMP(0);
    PH_LOOP(0) { if (EN(0) && IN(0)) p0_prologue(args, lds, G, wave_s);
    if (IN(0)) SEAM(0); }

#define FFN_PHASES(S_, PB_) do { \
        constexpr int layer_ = (S_) >> 1, sub_ = ((S_) & 1) ? 2 : 0; \
        const float* hin_ = ((S_) == 0) ? args.in[I_X] : H; \
        const float* mvec_ = mod + layer_ * NMOD + sub_ * 3 * DM; \
        PH_LOOP(PB_) { if (EN(1) && IN(PB_)) norm_phase<false, true>(hin_, args.in[I_NORMG] + (layer_ * 3 + sub_) * DM, mvec_, mvec_ + DM, hn, nullptr, G, wave_s); \
        if ((S_) == 0 && EN(2) && IN(PB_)) { \
              \
            pg8::Gemm g{(const bf16*)(ws + WS_WUPRAW), (const bf16*)(ws + WS_WQRAW), 256, 2048, 128, 2048, 2048, 8, 128, 128, \
                        (const bf16*)(ws + WS_WOUTB) + 1024, (const bf16*)(ws + WS_WUPRAW) + 1024, 2048, 256, 8, 128, 128}; \
            pg8::StaticOrder S; S.init(g, G, (int)blockIdx.x); \
            pg8::EpiBf16 E{(bf16*)(ws + WS_WIN) + (size_t)1024 * DM, DM, (size_t)256 * DM, 0.08838834764831845f, FP8_MIXOUT ? (bf16*)(ws + WS_WOUT + 1024) : (bf16*)(ws + WS_WOUT) + 1024, NCAT, (size_t)256, FP8_MIXOUT ? 64.0f : 1.0f, 0, 0, FP8_MIXOUT}; \
            pg8::gemm_phase<pg8::EpiBf16>(lds, g, S, E, wave_s); } \
        if (IN(PB_)) SEAM(PB_); } \
        PH_LOOP((PB_) + 1) { if (EN(3) && IN((PB_) + 1)) { \
            pg8::Gemm g{hn, (const bf16*)(ws + WS_WGU + (size_t)(S_) * NGU * DM), SEQ, NGU, DM / 2, DM / 2, DM / 2, 1, 0, 0, nullptr, nullptr, 0, 0, 0, 0, 0}; \
            pg8::StaticOrder S; S.init(g, G, (int)blockIdx.x); \
            pg8::EpiSwiGLU E{(unsigned char*)hmid, FFP, 0x7c7c7c7c, 0x79797979};     \
            pg8::gemm_phase<pg8::EpiSwiGLU, true>(lds, g, S, E, wave_s); } \
        if (IN((PB_) + 1)) SEAM((PB_) + 1); } \
        PH_LOOP((PB_) + 2) { if (EN(4) && IN((PB_) + 2)) { \
            pg8::Gemm g{hmid, (const bf16*)(ws + WS_WD + (size_t)(S_) * DM * FFP), SEQ, DM, FFP / 2, FFP / 2, FFP / 2, 1, 0, 0, nullptr, nullptr, 0, 0, 0, 0, 0}; \
            pg8::StaticOrder S; S.init(g, G, (int)blockIdx.x); \
            pg8::EpiResid E{hin_, H, mvec_ + 2 * DM, 0.5f, 0x7c7c7c7c, 0x78787878};     \
            pg8::gemm_phase<pg8::EpiResid, true>(lds, g, S, E, wave_s); } \
        if (IN((PB_) + 2)) SEAM((PB_) + 2); } \
    } while (0)
#define MIXOUT_PHASE(LYR_, PM_, APTR_, BPTR_, K_) do { \
        if (EN(12) && IN(PM_)) { \
            const float* m1_ = mod + (LYR_) * NMOD + 1 * 3 * DM; \
            constexpr int KU_ = FP8_MIXOUT ? (K_) / 2 : (K_); \
            pg8::Gemm g{(const bf16*)(APTR_), (const bf16*)(BPTR_), SEQ, DM, KU_, KU_, KU_, 1, 0, 0, nullptr, nullptr, 0, 0, 0, 0, 0}; \
            pg8::StaticOrder S; S.init(g, G, (int)blockIdx.x); \
            pg8::EpiResid E{H, H, m1_ + 2 * DM, 1.0f, 0x7c7c7c7c, 0x79797979}; \
            pg8::gemm_phase<pg8::EpiResid, FP8_MIXOUT != 0>(lds, g, S, E, wave_s); } \
        if (IN(PM_)) SEAM(PM_); \
    } while (0)

    FFN_PHASES(0, 1);
    {
        const float* m1 = mod + 0 * NMOD + 1 * 3 * DM;
        PH_LOOP(4) { if (EN(1) && IN(4)) norm_phase<false>(H, args.in[I_NORMG] + (0 * 3 + 1) * DM, m1, m1 + DM, hn, nullptr, G, wave_s);
        if (IN(4)) SEAM(4); }
        PH_LOOP(5) { if (EN(5) && IN(5)) {
            pg8::Gemm g{hn, (const bf16*)(ws + WS_WIN), SEQ, NIN, DM, DM, DM, 1, 0, 0, nullptr, nullptr, 0, 0, 0, 0, 0};
            pg8::StaticOrder S; S.init(g, G, (int)blockIdx.x);
            pg8::EpiBf16 E{proj, NIN, 0, 1.0f, nullptr, 0, 0, 0.f};
            pg8::gemm_phase<pg8::EpiBf16>(lds, g, S, E, wave_s);
        }
        if (IN(5)) SEAM(5); }
        PH_LOOP(6) { if (EN(6) && IN(6)) phase_a2(args, lds, G, wave_s);
        if (IN(6)) SEAM(6); }
        PH_LOOP(24) { if (EN(7) && IN(7)) { s5_scan_out(args, lds, G, wave_s); __syncthreads(); } }
        STAMP(25);
        PH_LOOP(25) { if (EN(8) && IN(7)) dsa_phase(args, lds, G, wave_s); }
        if (IN(7)) SEAM(7);
        PH_LOOP(8) { if (EN(9) && IN(8)) {
            pg8::Gemm g{(const bf16*)(ws + WS_YAPRE), (const bf16*)(ws + WS_WGLU), SEQ, 1024, 1024, 1024, 1024, 1, 0, 0, nullptr, nullptr, 0, 0, 0, 0, 0};
            pg8::StaticOrder S; S.init(g, G, (int)blockIdx.x);
            pg8::EpiGLU E{(const bf16*)(ws + WS_YAPRE), args.in[I_BGLU], (bf16*)(ws + WS_YCAT), NCAT};
            pg8::gemm_phase<pg8::EpiGLU>(lds, g, S, E, wave_s);
        }
        if (IN(8)) SEAM(8); }
    }
#ifdef EXTRA_BARRIERS
    for (int xb_ = 0; xb_ < EXTRA_BARRIERS; ++xb_) xcd_barrier(bar);
#endif
#ifdef EXP_GEMM
    {
        xcd_barrier(bar);
#if EXP_GEMM == 1
        pg8::Gemm g{hmid, (const bf16*)(ws + WS_WD), SEQ, DM, FFP / 2, FFP / 2, FFP / 2, 1, 0, 0, nullptr, nullptr, 0, 0, 0, 0, 0};
        pg8::StaticOrder S; S.init(g, G, (int)blockIdx.x); S.force = EXP_FORCE;
        pg8::EpiBf16 E{(bf16*)(ws + WS_SCORE), DM, 0, 1.0f, nullptr, 0, 0, 0.f, 0x7c7c7c7c, 0x78787878};
        pg8::gemm_phase<pg8::EpiBf16, true>(lds, g, S, E, wave_s);
#elif EXP_GEMM == 3
        pg8::Gemm g{hmid, (const bf16*)(ws + WS_WD), SEQ, DM, FFP / 2, FFP / 2, FFP / 2, 1, 0, 0, nullptr, nullptr, 0, 0, 0, 0, 0};
        pg8::StaticOrder S; S.init(g, G, (int)blockIdx.x); S.force = EXP_FORCE;
        pg8::EpiResid E{H, (float*)(ws + WS_SCORE), mod + 2 * DM, 0.5f, 0x7c7c7c7c, 0x78787878};
        pg8::gemm_phase<pg8::EpiResid, true>(lds, g, S, E, wave_s);
#elif EXP_GEMM == 2
        pg8::Gemm g{hn, (const bf16*)(ws + WS_WGU), SEQ, NGU, DM / 2, DM / 2, DM / 2, 1, 0, 0, nullptr, nullptr, 0, 0, 0, 0, 0};
        pg8::StaticOrder S; S.init(g, G, (int)blockIdx.x); S.force = EXP_FORCE;
        pg8::EpiBf16 E{(bf16*)(ws + WS_SCORE), NGU, 0, 1.0f, nullptr, 0, 0, 0.f, 0x7c7c7c7c, 0x79797979};
        pg8::gemm_phase<pg8::EpiBf16, true>(lds, g, S, E, wave_s);
#endif
        xcd_barrier(bar);
    }
#endif
    MIXOUT_PHASE(0, 9, ws + WS_YCAT, ws + WS_WOUT, NCAT);
    FFN_PHASES(1, 10);
    FFN_PHASES(2, 13);
    {
        const float* m1 = mod + 1 * NMOD + 1 * 3 * DM;
        PH_LOOP(16) { if (EN(1) && IN(16)) norm_phase<false, FP8_QKV != 0>(H, args.in[I_NORMG] + (1 * 3 + 1) * DM, m1, m1 + DM, hn, nullptr, G, wave_s);
        if (IN(16)) SEAM(16); }
        PH_LOOP(17) { if (EN(10) && IN(17)) {
            constexpr int KU = FP8_QKV ? DM / 2 : DM;
            pg8::Gemm g{hn, (const bf16*)(ws + WS_WQKV), SEQ, 2048, KU, KU, KU, 2, 0, (size_t)2048 * KU,
                        (const bf16*)(ws + WS_WQKV) + (size_t)4096 * KU, hn, 2048, SEQ, 1, 0, 0};
            pg8::StaticOrder S; S.init(g, G, (int)blockIdx.x);
            pg8::EpiBf16 E{(bf16*)(ws + WS_Q), DM, (size_t)SEQ * DM, 1.0f, (bf16*)(ws + WS_VT), SEQ, 0, 1.0f, 0x7c7c7c7c, 0x79797979};
            pg8::gemm_phase<pg8::EpiBf16, FP8_QKV != 0>(lds, g, S, E, wave_s);
        }
        if (IN(17)) SEAM(17); }
        PH_LOOP(18) { if (EN(11) && IN(18)) attn_c_phase(args, lds, G, wave_s);
        if (IN(18)) SEAM(18); }
    }
    MIXOUT_PHASE(1, 19, ws + WS_O, ws + WS_WCOUT, DM);
    FFN_PHASES(3, 20);
    if (EN(13) && IN(23)) { norm_phase<true>(H, args.in[I_FING], nullptr, nullptr, nullptr, args.out, G, wave_s); }
#if TIMING
    {
        xcd_barrier(bar); STAMP(24);
        if (blockIdx.x == 0 && wave_s == 0) {
            const unsigned long long* ts = (const unsigned long long*)(ws + WS_DIAG);
            const unsigned long long a0 = __hip_atomic_load(ts + TSEL_A, __ATOMIC_RELAXED, __HIP_MEMORY_SCOPE_AGENT), a1 = __hip_atomic_load(ts + TSEL_A + TSEL_A_N, __ATOMIC_RELAXED, __HIP_MEMORY_SCOPE_AGENT);
            const unsigned long long want = (a1 - a0) * TAMP, t0 = __builtin_amdgcn_s_memrealtime();
            while (__builtin_amdgcn_s_memrealtime() - t0 < want) __builtin_amdgcn_s_sleep(32);
        }
    }
#endif
#undef IN
#undef SEAM
}

extern "C" void kernel_launch(void* const* d_in, const int* in_sizes, int n_in, void* d_out, int out_size, void* d_ws, size_t ws_size, hipStream_t stream) {
    static int grid = 0;
    if (grid == 0) {
        if (n_in != 26 || out_size != SEQ * DM || ws_size < WS_END) { fprintf(stderr, "kernel_launch: unexpected shapes (n_in %d out %d ws %zu need %zu)\n", n_in, out_size, ws_size, (size_t)WS_END); grid = -1; return; }
        int dev = 0, cus = 0, per_cu = 0;
        if (hipGetDevice(&dev) != hipSuccess || hipDeviceGetAttribute(&cus, hipDeviceAttributeMultiprocessorCount, dev) != hipSuccess) { grid = -1; return; }
        if (hipFuncSetAttribute((const void*)fwd_kernel, hipFuncAttributeMaxDynamicSharedMemorySize, LDS_BYTES) != hipSuccess) { fprintf(stderr, "kernel_launch: hipFuncSetAttribute failed\n"); grid = -1; return; }
        if (hipOccupancyMaxActiveBlocksPerMultiprocessor(&per_cu, (const void*)fwd_kernel, NTHR, LDS_BYTES) != hipSuccess || per_cu < 1) { fprintf(stderr, "kernel_launch: occupancy query says %d\n", per_cu); }
        (void)hipGetLastError();
        grid = cus;
    }
    if (grid < 0) return;
    (void)hipMemsetAsync((char*)d_ws + WS_CTL, 0, CTL_ZERO_BYTES, stream);
    Args a{};
    for (int i = 0; i < 26; ++i) a.in[i] = (const float*)d_in[i];
    a.out = (float*)d_out; a.ws = (unsigned char*)d_ws;
    a.ph_lo = 0; a.ph_hi = N_PHASES_RUN;
    hipLaunchKernelGGL(fwd_kernel, dim3(grid), dim3(NTHR), LDS_BYTES, stream, a);
}
```

```cpp
#include <hip/hip_runtime.h>
#include <cstdio>
#include <cstdint>

#ifndef SELFCHECK
#define SELFCHECK 0
#endif
#ifndef N_PHASES_RUN
#define N_PHASES_RUN 24
#endif
#ifndef REP_MASK
#define REP_MASK 0u
#endif
#ifndef REP_N
#define REP_N 2
#endif
#ifndef FP8_QKV
#define FP8_QKV 1
#endif
#ifndef FP8_MIXOUT
#define FP8_MIXOUT 1
#endif
#ifndef TIMING
#define TIMING 0
#endif
#ifndef TBLK
#define TBLK 100
#endif
#ifndef TAMP
#define TAMP 8
#endif
#ifndef TSEL_A
#define TSEL_A 0
#define TSEL_A_N 1
#define TSEL_B 1
#define TSEL_B_N 1
#endif

#ifndef EN_MASK
#define EN_MASK 0xFFFFFFFFu
#endif
#define EN(b) ((EN_MASK >> (b)) & 1u)
#define GAS __attribute__((address_space(1)))
#define LAS __attribute__((address_space(3)))
typedef unsigned short bf16;
typedef short bf16x8 __attribute__((ext_vector_type(8)));
typedef short s16x4 __attribute__((ext_vector_type(4)));
typedef float f32x2 __attribute__((ext_vector_type(2)));
typedef float f32x4 __attribute__((ext_vector_type(4)));
typedef float f32x16 __attribute__((ext_vector_type(16)));
typedef unsigned u32x2 __attribute__((ext_vector_type(2)));
typedef unsigned u32x4 __attribute__((ext_vector_type(4)));
typedef short v4i16_t __attribute__((ext_vector_type(4)));

constexpr int SEQ = 8192, DM = 2048, FF = 5504, NGU = 2 * FF  , NMOD = 18432;
constexpr int NIN = 4608;
constexpr int C_U = 0, C_QT = 1024, C_KVL = 3072, C_QI = 3328, C_KI = 4352, C_WI = 4416;
constexpr int FFP = 5632;
constexpr int NCAT = 3072;
constexpr int NWAVES = 8, NTHR = 512;

constexpr size_t MiB = 1u << 20;
constexpr size_t WS_CTL = 0, CTL_ZERO_BYTES = 1 * MiB;
constexpr size_t WS_MOD = 1 * MiB;
constexpr size_t WS_S5T = WS_MOD + 256 * 1024;
constexpr size_t WS_DIAG = 3 * MiB;
constexpr size_t WS_WGU = 4 * MiB;
constexpr size_t WS_WD = WS_WGU + 172 * MiB;
constexpr size_t WS_WIN = WS_WD + 86 * MiB;
constexpr size_t WS_WQRAW = WS_WIN + 18 * MiB;
constexpr size_t WS_WUPRAW = WS_WQRAW + 8 * MiB;
constexpr size_t WS_WGLU = WS_WUPRAW + 1 * MiB;
constexpr size_t WS_WOUT = WS_WGLU + 2 * MiB;
constexpr size_t WS_WOUTB = WS_WOUT + 12 * MiB;
constexpr size_t WS_WQKV = WS_WOUTB + 8 * MiB;
constexpr size_t WS_WCOUT = WS_WQKV + 24 * MiB;
constexpr size_t WS_HN = WS_WCOUT + 8 * MiB;
constexpr size_t WS_HMID = WS_HN + 32 * MiB;
constexpr size_t WS_PROJ = WS_HMID + 86 * MiB;
constexpr size_t WS_KVN = WS_PROJ + 72 * MiB;
constexpr size_t WS_E = WS_KVN + 4 * MiB;
constexpr size_t WS_YAPRE = WS_E + 4 * MiB;
constexpr size_t WS_YCAT = WS_YAPRE + 16 * MiB;
constexpr size_t WS_SCORE = WS_YCAT + 48 * MiB;
constexpr size_t WS_Q = WS_SCORE, WS_K = WS_SCORE + 32 * MiB, WS_VT = WS_SCORE + 64 * MiB, WS_O = WS_SCORE + 96 * MiB;
constexpr size_t WS_END = WS_SCORE + 256 * MiB;
constexpr int S5_AR = 0, S5_AI = 4096, S5_A64R = 8192, S5_A64I = 12288, S5_BBR = 16384, S5_BBI = 16384 + 65536;

constexpr int CW_BAR = 4096;

constexpr int RING_BYTES = 131072;
constexpr int SCRATCH_BYTES = 155648;
constexpr int MISC_OFF = SCRATCH_BYTES;
constexpr int LDS_BYTES = SCRATCH_BYTES + 256;

#define LDS_WAIT() asm volatile("s_waitcnt lgkmcnt(0)" ::: "memory")
#define VM_WAIT() asm volatile("s_waitcnt vmcnt(0)" ::: "memory")

__device__ __forceinline__ unsigned f2bf(float f) { unsigned u = __builtin_bit_cast(unsigned, f); return (u + 0x7fffu + ((u >> 16) & 1u)) >> 16; }
__device__ __forceinline__ unsigned pk2(float lo, float hi) { unsigned r; asm volatile("v_cvt_pk_bf16_f32 %0, %1, %2" : "=v"(r) : "v"(lo), "v"(hi)); return r; }
__device__ __forceinline__ float clamp448(float x) { return __builtin_amdgcn_fmed3f(x, -448.0f, 448.0f); }
__device__ __forceinline__ unsigned pk4_fp8(float a, float b, float c, float d) {
    int w = 0; w = __builtin_amdgcn_cvt_pk_fp8_f32(clamp448(a), clamp448(b), w, false); w = __builtin_amdgcn_cvt_pk_fp8_f32(clamp448(c), clamp448(d), w, true); return (unsigned)w; }
__device__ __forceinline__ float bf2f(unsigned short b) { return __builtin_bit_cast(float, (unsigned)b << 16); }
__device__ __forceinline__ float bflo(unsigned w) { return __builtin_bit_cast(float, w << 16); }
__device__ __forceinline__ float bfhi(unsigned w) { return __builtin_bit_cast(float, w & 0xffff0000u); }
__device__ __forceinline__ float fast_exp2(float x) { return __builtin_amdgcn_exp2f(x); }
__device__ __forceinline__ float fast_rcp(float x) { return __builtin_amdgcn_rcpf(x); }
__device__ __forceinline__ float silu_f(float x) { return x * fast_rcp(1.0f + fast_exp2(-1.4426950408889634f * x)); }
__device__ __forceinline__ float sigmoid_f(float x) { return fast_rcp(1.0f + fast_exp2(-1.4426950408889634f * x)); }
__device__ __forceinline__ float gelu_tanh_f(float y) {
    const float z = 0.7978845608028654f * (y + 0.044715f * y * y * y);
    const float e = fast_exp2(2.0f * 1.4426950408889634f * z);
    const float th = 1.0f - 2.0f * fast_rcp(e + 1.0f);
    return 0.5f * y * (1.0f + th);
}
__device__ __forceinline__ float wave_sum(float v) {
#pragma unroll
    for (int o = 1; o < 64; o <<= 1) v += __shfl_xor(v, o);
    return v;
}

namespace pg8 {
constexpr int BM = 256, BK = 64, HALF = 128, HTB = HALF * BK * 2, STAGE_BYTES = 8 * HTB, NXCD = 8, WGM = 8;
__host__ __device__ __forceinline__ int lds_byte(int r, int c) { const int st = (r >> 4) * 2 + (c >> 5), rr = r & 15, cc = c & 31, ob = rr * 64 + cc * 2; return st * 1024 + (ob ^ (((ob >> 9) & 1) << 5)); }
__host__ __device__ __forceinline__ void stage_rc(int b, int& R, int& C) { const int st = b / 1024, sb = b % 1024, swz = sb ^ (((sb >> 9) & 1) << 5); R = (st >> 1) * 16 + swz / 64; C = (st & 1) * 32 + (swz % 64) / 2; }
__host__ __device__ __forceinline__ int perm32(int rho) { const int n = rho >> 4, i = rho & 15; return 8 * (i >> 2) + 4 * n + (i & 3); }

typedef int v4i_t __attribute__((ext_vector_type(4)));
typedef int v8i_t __attribute__((ext_vector_type(8)));
__device__ __forceinline__ v8i_t cat8(bf16x8 lo, bf16x8 hi) { return __builtin_shufflevector(__builtin_bit_cast(v4i_t, lo), __builtin_bit_cast(v4i_t, hi), 0, 1, 2, 3, 4, 5, 6, 7); }
__device__ __forceinline__ bf16x8 lo8(v8i_t v) { return __builtin_bit_cast(bf16x8, __builtin_shufflevector(v, v, 0, 1, 2, 3)); }
__device__ __forceinline__ bf16x8 hi8(v8i_t v) { return __builtin_bit_cast(bf16x8, __builtin_shufflevector(v, v, 4, 5, 6, 7)); }
struct Unit { int pm, pn, z, seg; };
struct Gemm { const bf16* A; const bf16* Bt; int M, N, K, lda, ldb, nz; size_t zA, zB; const bf16* A1; const bf16* Bt1; int M1, N1, nz1; size_t zA1, zB1; };

struct StaticOrder {
    int nM0, nN0, n0, nM1, nN1, ntot, G, c; int force = 0;
    __device__ void init(const Gemm& g, int G_, int c_) { nM0 = g.M / BM; nN0 = g.N / BM; n0 = nM0 * nN0 * g.nz; nM1 = g.M1 / BM; nN1 = g.N1 / BM; ntot = n0 + nM1 * nN1 * g.nz1; G = G_; c = c_; }
    __device__ bool next(int i, Unit& u) const {
        int L = i * G + c; if (L >= ntot) return false;
        const int seg = L >= n0 ? 1 : 0; if (seg) L -= n0;
        const int nM = seg ? nM1 : nM0, nN = seg ? nN1 : nN0, nwg = nM * nN;
        u.seg = seg; u.z = L / nwg;
        int wgid = L % nwg; { const int q = nwg / NXCD, r = nwg % NXCD, xcd = wgid % NXCD, off = wgid / NXCD; wgid = (xcd < r ? xcd * (q + 1) : r * (q + 1) + (xcd - r) * q) + off; }
        const int nig = WGM * nN, gid = wgid / nig, fm = gid * WGM, gsz = (nM - fm) < WGM ? (nM - fm) : WGM;
        u.pm = fm + ((wgid % nig) % gsz); u.pn = (wgid % nig) / gsz; if (force & 1) u.pm = 0; if (force & 2) u.pn = 0; return true;
    }
};

struct EpiBf16 {
    static constexpr bool PERM = true;
    bf16* O; int ldc; size_t zC; float scale; bf16* O1; int ldc1; size_t zC1; float scale1; int scale_a = 0, scale_w = 0; int fp8_1 = 0;
    __device__ __forceinline__ void operator()(const f32x4 (&acc)[2][2][4][2], const Unit& u, int wr, int wc, int fr, int fq) const {
        const int row0 = u.pm * BM + wr * 64 + fr; const int col0 = u.pn * BM + wc * 32 + 8 * fq;
        bf16* base = u.seg ? O1 + (size_t)u.z * zC1 : O + (size_t)u.z * zC; const int ldc = u.seg ? ldc1 : this->ldc; const float scale = u.seg ? scale1 : this->scale;
#pragma unroll
        for (int ai = 0; ai < 2; ++ai)
#pragma unroll
            for (int m = 0; m < 4; ++m) { bf16* rowp = base + (size_t)(row0 + ai * HALF + m * 16) * ldc + col0;
#pragma unroll
                for (int bj = 0; bj < 2; ++bj) { const f32x4 v0 = acc[ai][bj][m][0] * scale, v1 = acc[ai][bj][m][1] * scale;
                    if (u.seg && fp8_1) { u32x2 w8; w8.x = pk4_fp8(v0[0], v0[1], v0[2], v0[3]); w8.y = pk4_fp8(v1[0], v1[1], v1[2], v1[3]);
                        *(u32x2*)((unsigned char*)O1 + (size_t)u.z * zC1 + (size_t)(row0 + ai * HALF + m * 16) * ldc1 + col0 + bj * HALF) = w8; }
                    else { u32x4 w; w.x = pk2(v0[0], v0[1]); w.y = pk2(v0[2], v0[3]); w.z = pk2(v1[0], v1[1]); w.w = pk2(v1[2], v1[3]);
                    *(u32x4*)(rowp + bj * HALF) = w; } } }
    }
};
struct EpiSwiGLU {
    static constexpr bool PERM = true;
    unsigned char* O; int ldc; int scale_a, scale_w;
    __device__ __forceinline__ void operator()(const f32x4 (&acc)[2][2][4][2], const Unit& u, int wr, int wc, int fr, int fq) const {
        const int row0 = u.pm * BM + wr * 64 + fr; const int col0 = u.pn * HALF + wc * 32 + 8 * fq;
#pragma unroll
        for (int ai = 0; ai < 2; ++ai)
#pragma unroll
            for (int m = 0; m < 4; ++m) { unsigned char* rowp = O + (size_t)(row0 + ai * HALF + m * 16) * ldc + col0;
                const f32x4 g0 = acc[ai][0][m][0], g1 = acc[ai][0][m][1], u0 = acc[ai][1][m][0] * 8.0f, u1 = acc[ai][1][m][1] * 8.0f;
                u32x2 w; w.x = pk4_fp8(silu_f(g0[0]) * u0[0], silu_f(g0[1]) * u0[1], silu_f(g0[2]) * u0[2], silu_f(g0[3]) * u0[3]);
                w.y = pk4_fp8(silu_f(g1[0]) * u1[0], silu_f(g1[1]) * u1[1], silu_f(g1[2]) * u1[2], silu_f(g1[3]) * u1[3]);
                *(u32x2*)rowp = w; }
    }
};
struct EpiResid {
    static constexpr bool PERM = false;
    const float* hin; float* out; const float* gate; float coef; int scale_a, scale_w;
    __device__ __forceinline__ void operator()(const f32x4 (&acc)[2][2][4][2], const Unit& u, int wr, int wc, int fr, int fq) const {
        const int row0 = u.pm * BM + wr * 64 + fr; const int col0 = u.pn * BM + wc * 32 + 4 * fq;
        f32x4 gv[2][2];
#pragma unroll
        for (int bj = 0; bj < 2; ++bj)
#pragma unroll
            for (int n = 0; n < 2; ++n) gv[bj][n] = *(const f32x4*)(gate + col0 + bj * HALF + n * 16) * coef;
#pragma unroll
        for (int ai = 0; ai < 2; ++ai)
#pragma unroll
            for (int m = 0; m < 4; ++m) { const size_t off = (size_t)(row0 + ai * HALF + m * 16) * DM + col0;
#pragma unroll
                for (int bj = 0; bj < 2; ++bj)
#pragma unroll
                    for (int n = 0; n < 2; ++n) { const f32x4 b = *(const f32x4*)(hin + off + bj * HALF + n * 16);
                        *(f32x4*)(out + off + bj * HALF + n * 16) = b + gv[bj][n] * acc[ai][bj][m][n]; } }
    }
};
struct EpiGLU {
    static constexpr bool PERM = true;
    const bf16* yp; const float* bias; bf16* O; int ldc; int scale_a = 0, scale_w = 0;
    __device__ __forceinline__ void operator()(const f32x4 (&acc)[2][2][4][2], const Unit& u, int wr, int wc, int fr, int fq) const {
        const int row0 = u.pm * BM + wr * 64 + fr; const int col0 = u.pn * BM + wc * 32 + 8 * fq;
#pragma unroll
        for (int bj = 0; bj < 2; ++bj) { const f32x4 b0 = *(const f32x4*)(bias + col0 + bj * HALF), b1 = *(const f32x4*)(bias + col0 + bj * HALF + 4);
#pragma unroll
            for (int ai = 0; ai < 2; ++ai)
#pragma unroll
                for (int m = 0; m < 4; ++m) { const size_t r = (size_t)(row0 + ai * HALF + m * 16);
                    const u32x4 y = *(const u32x4*)(yp + r * 1024 + col0 + bj * HALF);
                    const f32x4 z0 = acc[ai][bj][m][0] + b0, z1 = acc[ai][bj][m][1] + b1;
#if FP8_MIXOUT
                    u32x2 w8; w8.x = pk4_fp8(8.f * bflo(y.x) * sigmoid_f(z0[0]), 8.f * bfhi(y.x) * sigmoid_f(z0[1]), 8.f * bflo(y.y) * sigmoid_f(z0[2]), 8.f * bfhi(y.y) * sigmoid_f(z0[3]));
                    w8.y = pk4_fp8(8.f * bflo(y.z) * sigmoid_f(z1[0]), 8.f * bfhi(y.z) * sigmoid_f(z1[1]), 8.f * bflo(y.w) * sigmoid_f(z1[2]), 8.f * bfhi(y.w) * sigmoid_f(z1[3]));
                    *(u32x2*)((unsigned char*)O + r * ldc + col0 + bj * HALF) = w8; } }
#else
                    u32x4 w; w.x = pk2(bflo(y.x) * sigmoid_f(z0[0]), bfhi(y.x) * sigmoid_f(z0[1])); w.y = pk2(bflo(y.y) * sigmoid_f(z0[2]), bfhi(y.y) * sigmoid_f(z0[3]));
                    w.z = pk2(bflo(y.z) * sigmoid_f(z1[0]), bfhi(y.z) * sigmoid_f(z1[1])); w.w = pk2(bflo(y.w) * sigmoid_f(z1[2]), bfhi(y.w) * sigmoid_f(z1[3]));
                    *(u32x4*)(O + r * ldc + col0 + bj * HALF) = w; } }
#endif
    }
};

template <class Epi, bool FP8 = false>
__device__ __forceinline__ void gemm_phase(LAS unsigned char* lds, const Gemm g, const StaticOrder& S, const Epi& E, int wave_s) {
    int lane_o = (int)__builtin_amdgcn_mbcnt_hi(~0u, __builtin_amdgcn_mbcnt_lo(~0u, 0u)); asm volatile("" : "+v"(lane_o));
    const int wid = wave_s, lane = lane_o, tid = wave_s * 64 + lane_o, wr = wid >> 2, wc = wid & 3, fr = lane & 15, fq = lane >> 4;
    const int K = g.K, nt = K / BK;
    unsigned voffA[2], voffB[2];
#pragma unroll
    for (int i = 0; i < 2; ++i) { int R, C; stage_rc(tid * 16 + i * 8192, R, C); const int Rb = Epi::PERM ? ((R & ~31) + perm32(R & 31)) : R;
        voffA[i] = (unsigned)(R * g.lda + C) * 2u; voffB[i] = (unsigned)(Rb * g.ldb + C) * 2u; }
    const size_t kstep = (size_t)(BK * 2);
    const size_t hstepA = (size_t)HALF * g.lda * 2, hstepB = (size_t)HALF * g.ldb * 2;
    const size_t tstepA = 2 * hstepA, tstepB = 2 * hstepB;
    const unsigned ldsw = (unsigned)wid * 1024u;
    const int aoff = lds_byte(wr * 64 + fr, fq * 8), boff = lds_byte(wc * 32 + fr, fq * 8);
#define PG8_SA(b, h) (((b) * 2 + (h)) * HTB)
#define PG8_SB(b, h) ((4 + (b) * 2 + (h)) * HTB)
#define PG8_STAGE(bufoff, gbase, voff) do { _Pragma("unroll") for (int _i = 0; _i < 2; ++_i) \
        __builtin_amdgcn_global_load_lds((const unsigned*)((const char*)(gbase) + (voff)[_i]), (LAS unsigned*)(lds + (bufoff) + ldsw + _i * 8192), 16, 0, 0); } while (0)
#define PG8_LDA(dst, b, h) do { _Pragma("unroll") for (int m = 0; m < 4; ++m) { const bf16x8 l_ = *(const LAS bf16x8*)(lds + PG8_SA(b, h) + aoff + m * 2048), h_ = *(const LAS bf16x8*)(lds + PG8_SA(b, h) + aoff + m * 2048 + 1024); dst[m] = cat8(l_, h_); } } while (0)
#define PG8_LDB(dst, b, h) do { _Pragma("unroll") for (int n = 0; n < 2; ++n) { const bf16x8 l_ = *(const LAS bf16x8*)(lds + PG8_SB(b, h) + boff + n * 2048), h_ = *(const LAS bf16x8*)(lds + PG8_SB(b, h) + boff + n * 2048 + 1024); dst[n] = cat8(l_, h_); } } while (0)
#define PG8_MMA(ai, bj, At, Bt) do { __builtin_amdgcn_s_setprio(1); _Pragma("unroll") for (int m = 0; m < 4; ++m) _Pragma("unroll") for (int n = 0; n < 2; ++n) { \
        if constexpr (FP8) asm volatile("v_mfma_scale_f32_16x16x128_f8f6f4 %0, %1, %2, %0, %3, %4 op_sel_hi:[0,0,0]" : "+v"(acc[ai][bj][m][n]) : "v"(Bt[n]), "v"(At[m]), "v"(sc_w), "v"(sc_a)); \
        else { acc[ai][bj][m][n] = __builtin_amdgcn_mfma_f32_16x16x32_bf16(lo8(Bt[n]), lo8(At[m]), acc[ai][bj][m][n], 0, 0, 0); acc[ai][bj][m][n] = __builtin_amdgcn_mfma_f32_16x16x32_bf16(hi8(Bt[n]), hi8(At[m]), acc[ai][bj][m][n], 0, 0, 0); } } __builtin_amdgcn_s_setprio(0); } while (0)
#define PG8_WAIT_V(n) asm volatile("s_waitcnt vmcnt(" #n ")" ::: "memory")
#define PG8_WAIT_L(n) asm volatile("s_waitcnt lgkmcnt(" #n ")" ::: "memory")
#define PG8_BAR __builtin_amdgcn_s_barrier()
#define PG8_SCHED __builtin_amdgcn_sched_barrier(0)
    Unit cur, nxt; int ui = 0;
    if (!S.next(0, cur)) return;
    f32x4 acc[2][2][4][2];
#pragma unroll
    for (int a = 0; a < 2; ++a)
#pragma unroll
        for (int b = 0; b < 2; ++b)
#pragma unroll
            for (int m = 0; m < 4; ++m)
#pragma unroll
                for (int n = 0; n < 2; ++n) acc[a][b][m][n] = (f32x4){0.f, 0.f, 0.f, 0.f};
    v8i_t At[4], B0[2], B1[2];
    int sc_w = E.scale_w, sc_a = E.scale_a;
#define PG8_ABASE(u) ((const char*)((u).seg ? g.A1 + (size_t)(u).z * g.zA1 : g.A + (size_t)(u).z * g.zA) + (size_t)(u).pm * tstepA)
#define PG8_BBASE(u) ((const char*)((u).seg ? g.Bt1 + (size_t)(u).z * g.zB1 : g.Bt + (size_t)(u).z * g.zB) + (size_t)(u).pn * tstepB)
    const char* cA = PG8_ABASE(cur); const char* cB = PG8_BBASE(cur);
    PG8_STAGE(PG8_SB(0, 0), cB, voffB); PG8_STAGE(PG8_SB(0, 1), cB + hstepB, voffB); PG8_STAGE(PG8_SA(0, 0), cA, voffA); PG8_STAGE(PG8_SA(0, 1), cA + hstepA, voffA);
    if (wr == 1) PG8_BAR;
    PG8_WAIT_V(2); PG8_BAR;
    PG8_STAGE(PG8_SB(1, 0), cB + kstep, voffB); PG8_STAGE(PG8_SA(1, 0), cA + kstep, voffA); PG8_STAGE(PG8_SB(1, 1), cB + hstepB + kstep, voffB);
    PG8_WAIT_V(6); PG8_BAR;
    for (;;) {
        const bool has_next = S.next(ui + 1, nxt);
        const char* nA = has_next ? PG8_ABASE(nxt) : cA; const char* nB = has_next ? PG8_BBASE(nxt) : cB;
        for (int t = 0; t < nt; t += 2) {
            const bool last = (t == nt - 2);
            const char* a1 = cA + (size_t)(t + 1) * kstep;
            const char* a2 = last ? nA : cA + (size_t)(t + 2) * kstep; const char* b2 = last ? nB : cB + (size_t)(t + 2) * kstep;
            const char* a3 = a2 + kstep; const char* b3 = b2 + kstep;
            PG8_LDB(B0, 0, 0); PG8_LDB(B1, 0, 1); PG8_SCHED; PG8_LDA(At, 0, 0); PG8_STAGE(PG8_SA(1, 1), a1 + hstepA, voffA);
            PG8_WAIT_V(8); PG8_WAIT_L(0); PG8_BAR; PG8_MMA(0, 0, At, B0); PG8_MMA(0, 1, At, B1); PG8_BAR; PG8_SCHED;
            PG8_LDA(At, 0, 1); PG8_STAGE(PG8_SB(0, 0), b2, voffB); PG8_STAGE(PG8_SB(0, 1), b2 + hstepB, voffB); PG8_STAGE(PG8_SA(0, 0), a2, voffA);
            PG8_WAIT_V(8); PG8_WAIT_L(0); PG8_BAR; PG8_MMA(1, 0, At, B0); PG8_MMA(1, 1, At, B1); PG8_BAR; PG8_SCHED;
            PG8_LDB(B0, 1, 0); PG8_LDB(B1, 1, 1); PG8_SCHED; PG8_LDA(At, 1, 0); PG8_STAGE(PG8_SA(0, 1), a2 + hstepA, voffA);
            PG8_WAIT_V(8); PG8_WAIT_L(0); PG8_BAR; PG8_MMA(0, 0, At, B0); PG8_MMA(0, 1, At, B1); PG8_BAR; PG8_SCHED;
            PG8_LDA(At, 1, 1); PG8_STAGE(PG8_SB(1, 0), b3, voffB); PG8_STAGE(PG8_SB(1, 1), b3 + hstepB, voffB); PG8_STAGE(PG8_SA(1, 0), a3, voffA);
            PG8_WAIT_V(8); PG8_WAIT_L(0); PG8_BAR; PG8_MMA(1, 0, At, B0); PG8_MMA(1, 1, At, B1); PG8_BAR; PG8_SCHED;
        }
        if (wr == 0) PG8_BAR;
        if constexpr (FP8) asm volatile("s_nop 15\n\ts_nop 15" ::: "memory");
        E(acc, cur, wr, wc, fr, fq);
        if (!has_next) break;
#pragma unroll
        for (int a = 0; a < 2; ++a)
#pragma unroll
            for (int b = 0; b < 2; ++b)
#pragma unroll
                for (int m = 0; m < 4; ++m)
#pragma unroll
                    for (int n = 0; n < 2; ++n) acc[a][b][m][n] = (f32x4){0.f, 0.f, 0.f, 0.f};
        cur = nxt; cA = nA; cB = nB; ++ui;
        if (wr == 1) PG8_BAR;
    }
    PG8_WAIT_V(0);
    PG8_BAR;
#undef PG8_ABASE
#undef PG8_BBASE
#undef PG8_SA
#undef PG8_SB
#undef PG8_STAGE
#undef PG8_LDA
#undef PG8_LDB
#undef PG8_MMA
#undef PG8_WAIT_V
#undef PG8_WAIT_L
#undef PG8_BAR
#undef PG8_SCHED
}
}

#define XB_TMO      128
#define XB_XCNT(j)  (256  + 64 * (j))
#define XB_XSUB(j)  (1280 + 64 * (j))
#define XB_XGEN(j)  (2304 + 64 * (j))
#define XB_TOP      3328
#define XB_TOPGEN   3392
#define XCD_BAR_WORDS 3456
#define XB_SPIN_CAP (1u << 18)
__device__ __forceinline__ unsigned xb_ld(unsigned* p)              { return __hip_atomic_load(p, __ATOMIC_RELAXED, __HIP_MEMORY_SCOPE_AGENT); }
__device__ __forceinline__ unsigned xb_add(unsigned* p, unsigned v) { return __hip_atomic_fetch_add(p, v, __ATOMIC_RELAXED, __HIP_MEMORY_SCOPE_AGENT); }
__device__ __forceinline__ unsigned xb_xcc_id() { return (unsigned)__builtin_amdgcn_s_getreg((3 << 11) | 20) & 0xFu; }
#define XB_SPIN(cond, bar) do { unsigned _sp = 0; while (cond) { __builtin_amdgcn_s_sleep(1); \
    if ((++_sp & 255u) == 0u) { if (xb_ld(&(bar)[XB_TMO])) break; if (_sp > XB_SPIN_CAP) { atomicAdd(&(bar)[XB_TMO], 1u); break; } } } } while (0)
struct XcdBarrier { unsigned* bar; unsigned x; volatile LAS unsigned* st; int wave; };
__device__ __forceinline__ XcdBarrier xcd_barrier_post(unsigned* bar, volatile LAS unsigned* st) {
    XcdBarrier b; b.bar = bar; b.x = xb_xcc_id(); b.st = st;
    if (threadIdx.x == 0) (void)xb_add(&bar[XB_XCNT(b.x)], 1u);
    return b;
}
__device__ __forceinline__ void xcd_barrier_complete(unsigned* bar, unsigned x, unsigned& nloc, unsigned& nx) {
    const unsigned G = gridDim.x * gridDim.y * gridDim.z;
    unsigned sum, cnt, mine, sp = 0u;
    for (;;) {
        sum = 0u; cnt = 0u; mine = 0u;
#pragma unroll
        for (unsigned j = 0; j < 16; ++j) { const unsigned c = xb_ld(&bar[XB_XCNT(j)]); sum += c; cnt += (c > 0u) ? 1u : 0u; mine = (j == x) ? c : mine; }
        if (sum == G) break;
        __builtin_amdgcn_s_sleep(1);
        if ((++sp & 255u) == 0u) { if (xb_ld(&bar[XB_TMO])) break; if (sp > XB_SPIN_CAP) { atomicAdd(&bar[XB_TMO], 1u); break; } }
    }
    nloc = mine > 0u ? mine : 1u; nx = cnt > 0u ? cnt : 1u;
}
__device__ __forceinline__ void xcd_barrier(const XcdBarrier& b) {
    asm volatile("s_waitcnt vmcnt(0)" ::: "memory");
    __syncthreads();
    if (b.wave == 0 && __builtin_amdgcn_mbcnt_hi(~0u, __builtin_amdgcn_mbcnt_lo(~0u, 0u)) == 0u) {
        unsigned* bar = b.bar;
        __builtin_amdgcn_s_waitcnt(0);
        unsigned nloc = b.st[0], nx = b.st[1];
        if (nloc == 0u) { xcd_barrier_complete(bar, b.x, nloc, nx); b.st[0] = nloc; b.st[1] = nx; }
        const unsigned old = xb_add(&bar[XB_XSUB(b.x)], 1u);
        const unsigned gen = old / nloc;
        if (old + 1u == (gen + 1u) * nloc) {
            __builtin_amdgcn_fence(__ATOMIC_RELEASE, "agent");
            asm volatile("s_waitcnt vmcnt(0)" ::: "memory");
            const unsigned og = xb_add(&bar[XB_TOP], 1u);
            const unsigned tg = og / nx;
            if (og + 1u == (tg + 1u) * nx) xb_add(&bar[XB_TOPGEN], 1u);
            else XB_SPIN(xb_ld(&bar[XB_TOPGEN]) == tg, bar);
            __builtin_amdgcn_fence(__ATOMIC_ACQUIRE, "agent");
            xb_add(&bar[XB_XGEN(b.x)], 1u);
            asm volatile("s_waitcnt vmcnt(0)" ::: "memory");
        } else {
            XB_SPIN(xb_ld(&bar[XB_XGEN(b.x)]) == gen, bar);
            __builtin_amdgcn_fence(__ATOMIC_ACQUIRE, "agent");
            asm volatile("s_waitcnt vmcnt(0)" ::: "memory");
        }
    }
    __syncthreads();
}

#ifndef DSA_XREP
#define DSA_XREP 0
#define DSA_XF 0
#endif
#ifndef DSA_REP_P1
#define DSA_REP_P1 1
#endif
#ifndef DSA_REP_P2
#define DSA_REP_P2 1
#endif
#ifndef DSA_REP_ATT
#define DSA_REP_ATT 1
#endif
__device__ __forceinline__ int opaque_int(int n) { asm volatile("" : "+s"(n)); return n; }
__device__ __forceinline__ int ph_reps(int k) { int n = ((REP_MASK >> k) & 1u) ? REP_N : 1; asm volatile("" : "+s"(n)); return n; }
struct Args { const float* in[26]; float* out; unsigned char* ws; int ph_lo, ph_hi; };
enum { I_X = 0, I_C, I_ADAW, I_ADAB, I_NORMG, I_WG, I_WU, I_WDN, I_ABWIN, I_LRE, I_LIM, I_LOGDT, I_BRE, I_BIM, I_CRE, I_CIM, I_S5D, I_WGLU, I_BGLU, I_KVG, I_WKVUP, I_ABWOUT,
       I_CWQKV, I_RELB, I_CWOUT, I_FING };

__device__ __forceinline__ void tr_item(const float* src, int ldsrc, int nvalid, int k0, int n0, bf16* dst, int lddst, LAS float* scr, int lane) {
    const int nn = n0 + (lane & 31); const bool ok = nn < nvalid;
#pragma unroll 8
    for (int i = 0; i < 32; ++i) { const int kk = 2 * i + (lane >> 5); scr[kk * 33 + (lane & 31)] = ok ? src[(size_t)(k0 + kk) * ldsrc + nn] : 0.f; }
    LDS_WAIT(); asm volatile("" ::: "memory");
    const int c = lane & 7;
#pragma unroll
    for (int j = 0; j < 4; ++j) { const int n = (lane >> 3) + 8 * j; const LAS float* s = scr + (8 * c) * 33 + n;
        u32x4 o; o.x = pk2(s[0 * 33], s[1 * 33]); o.y = pk2(s[2 * 33], s[3 * 33]); o.z = pk2(s[4 * 33], s[5 * 33]); o.w = pk2(s[6 * 33], s[7 * 33]);
        if (n0 + n < nvalid) *(u32x4*)(dst + (size_t)n * lddst + 8 * c) = o; }
    LDS_WAIT(); asm volatile("" ::: "memory");
}

__device__ __forceinline__ void tr_item8(const float* src, int ldsrc, int k0, int n0, unsigned char* dst, int lddst, float scale, LAS float* scr, int lane) {
    const int nn = n0 + (lane & 31);
#pragma unroll 8
    for (int i = 0; i < 32; ++i) { const int kk = 2 * i + (lane >> 5); scr[kk * 33 + (lane & 31)] = src[(size_t)(k0 + kk) * ldsrc + nn] * scale; }
    LDS_WAIT(); asm volatile("" ::: "memory");
    const int n = lane & 31, kh = lane >> 5; const LAS float* sp = scr + (32 * kh) * 33 + n;
    u32x4 o0, o1;
    o0.x = pk4_fp8(sp[0 * 33], sp[1 * 33], sp[2 * 33], sp[3 * 33]); o0.y = pk4_fp8(sp[4 * 33], sp[5 * 33], sp[6 * 33], sp[7 * 33]);
    o0.z = pk4_fp8(sp[8 * 33], sp[9 * 33], sp[10 * 33], sp[11 * 33]); o0.w = pk4_fp8(sp[12 * 33], sp[13 * 33], sp[14 * 33], sp[15 * 33]);
    o1.x = pk4_fp8(sp[16 * 33], sp[17 * 33], sp[18 * 33], sp[19 * 33]); o1.y = pk4_fp8(sp[20 * 33], sp[21 * 33], sp[22 * 33], sp[23 * 33]);
    o1.z = pk4_fp8(sp[24 * 33], sp[25 * 33], sp[26 * 33], sp[27 * 33]); o1.w = pk4_fp8(sp[28 * 33], sp[29 * 33], sp[30 * 33], sp[31 * 33]);
    unsigned char* d = dst + (size_t)n * lddst + 32 * kh;
    *(u32x4*)d = o0; *(u32x4*)(d + 16) = o1;
    LDS_WAIT(); asm volatile("" ::: "memory");
}

template <bool FP8>
__device__ __forceinline__ void tr_item64(const float* src, int ldsrc, int k0, int n0, void* dst, int lddst, float scale, LAS float* scr, int lane) {
    const float* sp = src + (size_t)(k0 + (lane >> 4)) * ldsrc + n0 + 4 * (lane & 15);
    f32x4 v[16];
#pragma unroll
    for (int i = 0; i < 16; ++i) v[i] = *(const f32x4*)(sp + (size_t)(4 * i) * ldsrc);
#pragma unroll
    for (int i = 0; i < 16; ++i) { LAS float* w = scr + (4 * i + (lane >> 4)) * 65 + 4 * (lane & 15); w[0] = v[i].x * scale; w[1] = v[i].y * scale; w[2] = v[i].z * scale; w[3] = v[i].w * scale; }
    LDS_WAIT(); asm volatile("" ::: "memory");
    if (FP8) {
        const int c = lane & 3;
#pragma unroll
        for (int j = 0; j < 4; ++j) { const int n = 16 * j + (lane >> 2); const LAS float* r = scr + (16 * c) * 65 + n;
            u32x4 o; o.x = pk4_fp8(r[0], r[65], r[130], r[195]); o.y = pk4_fp8(r[260], r[325], r[390], r[455]); o.z = pk4_fp8(r[520], r[585], r[650], r[715]); o.w = pk4_fp8(r[780], r[845], r[910], r[975]);
            *(u32x4*)((unsigned char*)dst + (size_t)n * lddst + 16 * c) = o; }
    } else {
        const int c = lane & 7;
#pragma unroll
        for (int j = 0; j < 8; ++j) { const int n = 8 * j + (lane >> 3); const LAS float* r = scr + (8 * c) * 65 + n;
            u32x4 o; o.x = pk2(r[0], r[65]); o.y = pk2(r[130], r[195]); o.z = pk2(r[260], r[325]); o.w = pk2(r[390], r[455]);
            *(u32x4*)((bf16*)dst + (size_t)n * lddst + 8 * c) = o; }
    }
    LDS_WAIT(); asm volatile("" ::: "memory");
}

__device__ __forceinline__ void p0_prologue(const Args& a, LAS unsigned char* lds, int G, int wave_s) {
    int lane_o = (int)__builtin_amdgcn_mbcnt_hi(~0u, __builtin_amdgcn_mbcnt_lo(~0u, 0u)); asm volatile("" : "+v"(lane_o)); const int lane = lane_o, wave = wave_s, tid_o = wave_s * 64 + lane_o;
    unsigned char* ws = a.ws;
    const int tid = tid_o;
    {
        LAS float* cond = (LAS float*)(lds + 131072); LAS float* red = (LAS float*)(lds + 131072 + 8192);
        for (int k = tid; k < DM; k += NTHR) cond[k] = silu_f(a.in[I_C][k]);
        __syncthreads();
        float* mod = (float*)(ws + WS_MOD);
        for (int u = blockIdx.x; u < 144; u += G) {
            const int layer = u / 72, col0 = (u % 72) * 256 + 4 * lane;
            const float* w = a.in[I_ADAW] + (size_t)layer * DM * NMOD + (size_t)(wave * 256) * NMOD + col0;
            f32x4 s4 = (f32x4){0.f, 0.f, 0.f, 0.f};
#pragma unroll 16
            for (int k = 0; k < 256; ++k) { const f32x4 v = *(const f32x4*)(w + (size_t)k * NMOD); s4 += v * cond[wave * 256 + k]; }
            *(LAS f32x4*)(red + wave * 256 + 4 * lane) = s4;
            __syncthreads();
            if (tid < 256) { float s = 0.f;
#pragma unroll
                for (int w8 = 0; w8 < 8; ++w8) s += red[w8 * 256 + tid];
                const int n = (u % 72) * 256 + tid; mod[layer * NMOD + n] = s + a.in[I_ADAB][layer * NMOD + n]; }
            __syncthreads();
        }
    }
    LAS float* scr = (LAS float*)(lds + wave * 16640);
    const int gw = blockIdx.x * NWAVES + wave, NGW = G * NWAVES;
    unsigned char* Wgu = ws + WS_WGU; unsigned char* Wd = ws + WS_WD; bf16* Win = (bf16*)(ws + WS_WIN); bf16* Wglu = (bf16*)(ws + WS_WGLU);
    bf16* Wout = (bf16*)(ws + WS_WOUT); bf16* Woutb = (bf16*)(ws + WS_WOUTB); bf16* Wqkv = (bf16*)(ws + WS_WQKV); bf16* Wcout = (bf16*)(ws + WS_WCOUT);
    constexpr int I_FFN = 4 * 3 * 2752, I_IN = 32 * 107, I_GLU = 16 * 16, I_OUT = 32 * 32, I_QKV = 32 * 96, I_CO = 32 * 32;
    constexpr int NITEMS = I_FFN + I_IN + I_GLU + I_OUT + I_QKV + I_CO;
    for (int it = gw; it < NITEMS; it += NGW) {
        int r = it;
        if (r < I_FFN) {
            const int f = r / 8256, rr = r % 8256, which = rr / 2752, q = rr % 2752;
            if (which < 2) { const int kb = q / 86, nb = q % 86, n0 = 64 * nb, k0 = 64 * kb;
                const float* src = a.in[which ? I_WU : I_WG] + (size_t)f * DM * FF;
                const int row = 256 * (n0 / 128) + (n0 % 128) + 128 * which;
                tr_item64<true>(src, FF, k0, n0, Wgu + (size_t)f * NGU * DM + (size_t)row * DM + k0, DM, 64.0f, scr, lane);
            } else { const int kb = q / 32, nb = q % 32, n0 = 64 * nb, k0 = 64 * kb;
                const float* src = a.in[I_WDN] + (size_t)f * FF * DM;
                tr_item64<true>(src, DM, k0, n0, Wd + (size_t)f * DM * FFP + (size_t)n0 * FFP + k0, FFP, 128.0f, scr, lane); }
            continue; }
        r -= I_FFN;
        if (r < I_IN) { const int kb = r / 107, nb = r % 107, n0 = 32 * nb, k0 = 64 * kb;
            if (n0 >= 1024 && n0 < 2048) continue;
            const int row = n0 + (n0 >= 2048 ? 1024 : 0);
            tr_item(a.in[I_ABWIN], 3408, 3408, k0, n0, Win + (size_t)row * DM + k0, DM, scr, lane); continue; }
        r -= I_IN;
        if (r < I_GLU) { const int kb = r / 16, nb = r % 16, n0 = 64 * nb, k0 = 64 * kb;
            tr_item64<false>(a.in[I_WGLU], 1024, k0, n0, Wglu + (size_t)n0 * 1024 + k0, 1024, 1.0f, scr, lane); continue; }
        r -= I_GLU;
        if (r < I_OUT) { const int kb = r / 32, nb = r % 32, n0 = 64 * nb, k0 = 64 * kb;
#if FP8_MIXOUT
            if (k0 < 1024) tr_item64<true>(a.in[I_ABWOUT], DM, k0, n0, (unsigned char*)Wout + (size_t)n0 * NCAT + k0, NCAT, 64.0f, scr, lane);
#else
            if (k0 < 1024) tr_item64<false>(a.in[I_ABWOUT], DM, k0, n0, Wout + (size_t)n0 * NCAT + k0, NCAT, 1.0f, scr, lane);
#endif
            else           tr_item64<false>(a.in[I_ABWOUT], DM, k0, n0, Woutb + (size_t)n0 * DM + k0, DM, 1.0f, scr, lane);
            continue; }
        r -= I_OUT;
        if (r < I_QKV) { const int kb = r / 96, nb = r % 96, n0 = 64 * nb, k0 = 64 * kb;
#if FP8_QKV
            tr_item64<true>(a.in[I_CWQKV], 6144, k0, n0, (unsigned char*)Wqkv + (size_t)n0 * DM + k0, DM, 64.0f, scr, lane); continue; }
#else
            tr_item64<false>(a.in[I_CWQKV], 6144, k0, n0, Wqkv + (size_t)n0 * DM + k0, DM, 1.0f, scr, lane); continue; }
#endif
        r -= I_QKV;
        { const int kb = r / 32, nb = r % 32, n0 = 64 * nb, k0 = 64 * kb;
#if FP8_MIXOUT
            tr_item64<true>(a.in[I_CWOUT], DM, k0, n0, (unsigned char*)Wcout + (size_t)n0 * DM + k0, DM, 64.0f, scr, lane); }
#else
            tr_item64<false>(a.in[I_CWOUT], DM, k0, n0, Wcout + (size_t)n0 * DM + k0, DM, 1.0f, scr, lane); }
#endif
    }
    {
        const int gt = blockIdx.x * NTHR + tid, NGT = G * NTHR;
        bf16* Wqraw = (bf16*)(ws + WS_WQRAW); bf16* Wupraw = (bf16*)(ws + WS_WUPRAW);
        for (int i = gt; i < 2048 * 256; i += NGT) { const int k = i >> 8, d4 = (i & 255) * 4; const f32x4 v = *(const f32x4*)(a.in[I_ABWIN] + (size_t)k * 3408 + 1024 + d4);
            u32x2 o; o.x = pk2(v.x, v.y); o.y = pk2(v.z, v.w); *(u32x2*)(Wqraw + (size_t)k * DM + d4) = o; }
        for (int i = gt; i < 256 * 512; i += NGT) { const f32x4 v = *(const f32x4*)(a.in[I_WKVUP] + (size_t)i * 4);
            u32x2 o; o.x = pk2(v.x, v.y); o.y = pk2(v.z, v.w); *(u32x2*)(Wupraw + (size_t)i * 4) = o; }
        for (int i = gt; i < (NIN - 4432) * DM / 8; i += NGT) *(u32x4*)(Win + (size_t)4432 * DM + (size_t)i * 8) = (u32x4){0u, 0u, 0u, 0u};
        for (int i = gt; i < 4 * DM * 8; i += NGT) *(u32x4*)(Wd + (size_t)(i >> 3) * FFP + FF + 16 * (i & 7)) = (u32x4){0u, 0u, 0u, 0u};
        for (int i = gt; i < SEQ * 8; i += NGT) *(u32x4*)(ws + WS_HMID + (size_t)(i >> 3) * FFP + FF + 16 * (i & 7)) = (u32x4){0u, 0u, 0u, 0u};
        if (gt < 4096) { const int g = gt >> 6;
            const double dt = exp((double)a.in[I_LOGDT][g]); const double lr = a.in[I_LRE][gt], li = a.in[I_LIM][gt];
            const double mag = exp(lr * dt), ar = mag * cos(li * dt), ai = mag * sin(li * dt);
            const double den = lr * lr + li * li, nr = ar - 1.0, fre = (nr * lr + ai * li) / den, fim = (ai * lr - nr * li) / den;
            const double m64 = exp(64.0 * lr * dt), a64r = m64 * cos(64.0 * li * dt), a64i = m64 * sin(64.0 * li * dt);
            float* T = (float*)(ws + WS_S5T);
            T[S5_AR + gt] = (float)ar; T[S5_AI + gt] = (float)ai; T[S5_A64R + gt] = (float)a64r; T[S5_A64I + gt] = (float)a64i;
            for (int c = 0; c < 16; ++c) { const double br = a.in[I_BRE][gt * 16 + c], bi = a.in[I_BIM][gt * 16 + c];
                T[S5_BBR + gt * 16 + c] = (float)(fre * br - fim * bi); T[S5_BBI + gt * 16 + c] = (float)(fre * bi + fim * br); }
        }
    }
}

template <bool FINAL, bool OUT8 = false>
__device__ __forceinline__ void norm_phase(const float* hin, const float* gvec, const float* shift, const float* scale, bf16* hn, float* fout, int G, int wave_s) {
    int lane_o = (int)__builtin_amdgcn_mbcnt_hi(~0u, __builtin_amdgcn_mbcnt_lo(~0u, 0u)); asm volatile("" : "+v"(lane_o)); const int lane = lane_o, wave = wave_s, tid_o = wave_s * 64 + lane_o;
    const int gw = blockIdx.x * NWAVES + wave, NGW = G * NWAVES;
    f32x4 gs[8], sh[8];
#pragma unroll
    for (int j = 0; j < 8; ++j) { const int c = 4 * lane + 256 * j; const f32x4 gg = *(const f32x4*)(gvec + c);
        if (FINAL) { gs[j] = gg; sh[j] = (f32x4){0.f, 0.f, 0.f, 0.f}; }
        else { const f32x4 sc = *(const f32x4*)(scale + c); gs[j] = gg * (sc + 1.0f); sh[j] = *(const f32x4*)(shift + c); } }
    for (int m = gw; m < SEQ; m += NGW) {
        const f32x4* xr = (const f32x4*)(hin + (size_t)m * DM) + lane;
        f32x4 v[8]; float s = 0.f;
#pragma unroll
        for (int j = 0; j < 8; ++j) { v[j] = xr[64 * j]; s += (v[j].x * v[j].x + v[j].y * v[j].y) + (v[j].z * v[j].z + v[j].w * v[j].w); }
        const float rstd = 1.0f / sqrtf(wave_sum(s) * (1.0f / DM) + 1e-6f);
        if (FINAL) { f32x4* o = (f32x4*)(fout + (size_t)m * DM) + lane;
#pragma unroll
            for (int j = 0; j < 8; ++j) o[64 * j] = v[j] * rstd * gs[j];
        } else if (OUT8) { unsigned* o = (unsigned*)((unsigned char*)hn + (size_t)m * DM) + lane;
#pragma unroll
            for (int j = 0; j < 8; ++j) { const f32x4 y = (v[j] * rstd * gs[j] + sh[j]) * 8.0f; o[64 * j] = pk4_fp8(y.x, y.y, y.z, y.w); }
        } else { u32x2* o = (u32x2*)(hn + (size_t)m * DM) + lane;
#pragma unroll
            for (int j = 0; j < 8; ++j) { const f32x4 y = v[j] * rstd * gs[j] + sh[j]; u32x2 w; w.x = pk2(y.x, y.y); w.y = pk2(y.z, y.w); o[64 * j] = w; } }
    }
}

__device__ __forceinline__ void s5_stage_u(const bf16* proj, int g, int j, LAS float* ut, int lane) {
    const u32x4* p = (const u32x4*)(proj + (size_t)(64 * j + lane) * NIN + C_U + 16 * g);
    const u32x4 a = p[0], b = p[1];
    LAS f32x4* o = (LAS f32x4*)(ut + lane * 16);
    o[0] = (f32x4){bflo(a.x), bfhi(a.x), bflo(a.y), bfhi(a.y)}; o[1] = (f32x4){bflo(a.z), bfhi(a.z), bflo(a.w), bfhi(a.w)};
    o[2] = (f32x4){bflo(b.x), bfhi(b.x), bflo(b.y), bfhi(b.y)}; o[3] = (f32x4){bflo(b.z), bfhi(b.z), bflo(b.w), bfhi(b.w)};
    LDS_WAIT(); asm volatile("" ::: "memory");
}
__device__ __forceinline__ void phase_a2(const Args& a, LAS unsigned char* lds, int G, int wave_s) {
    int lane_o = (int)__builtin_amdgcn_mbcnt_hi(~0u, __builtin_amdgcn_mbcnt_lo(~0u, 0u)); asm volatile("" : "+v"(lane_o)); const int lane = lane_o, wave = wave_s, tid_o = wave_s * 64 + lane_o;
    unsigned char* ws = a.ws; const bf16* proj = (const bf16*)(ws + WS_PROJ);
    const int gw = blockIdx.x * NWAVES + wave, NGW = G * NWAVES;
    { bf16* kvn = (bf16*)(ws + WS_KVN); const f32x4 gg = *(const f32x4*)(a.in[I_KVG] + 4 * lane);
      for (int m = gw; m < SEQ; m += NGW) { const u32x2 w = *(const u32x2*)(proj + (size_t)m * NIN + C_KVL + 4 * lane);
          const f32x4 v = (f32x4){bflo(w.x), bfhi(w.x), bflo(w.y), bfhi(w.y)};
          const float s = wave_sum((v.x * v.x + v.y * v.y) + (v.z * v.z + v.w * v.w)); const float rstd = 1.0f / sqrtf(s * (1.0f / 256.0f) + 1e-6f);
          const f32x4 y = v * rstd * gg; u32x2 o; o.x = pk2(y.x, y.y); o.y = pk2(y.z, y.w); *(u32x2*)(kvn + (size_t)m * 256 + 4 * lane) = o; } }
    const float* T = (const float*)(ws + WS_S5T); float* E = (float*)(ws + WS_E);
    LAS float* ut = (LAS float*)(lds + wave * 8192);
    for (int u = gw; u < 64 * 128; u += NGW) { const int g = u & 63, j = u >> 6, sp = g * 64 + lane;
        s5_stage_u(proj, g, j, ut, lane);
        const float ar = T[S5_AR + sp], ai = T[S5_AI + sp];
        float bbr[16], bbi[16];
#pragma unroll
        for (int c4 = 0; c4 < 4; ++c4) { const f32x4 r = *(const f32x4*)(T + S5_BBR + sp * 16 + 4 * c4), i = *(const f32x4*)(T + S5_BBI + sp * 16 + 4 * c4);
            bbr[4 * c4] = r.x; bbr[4 * c4 + 1] = r.y; bbr[4 * c4 + 2] = r.z; bbr[4 * c4 + 3] = r.w; bbi[4 * c4] = i.x; bbi[4 * c4 + 1] = i.y; bbi[4 * c4 + 2] = i.z; bbi[4 * c4 + 3] = i.w; }
        float xr = 0.f, xi = 0.f;
        for (int t = 0; t < 64; ++t) { const LAS f32x4* up = (const LAS f32x4*)(ut + t * 16); float bur = 0.f, bui = 0.f;
#pragma unroll
            for (int c4 = 0; c4 < 4; ++c4) { const f32x4 uv = up[c4];
                bur += bbr[4 * c4] * uv.x + bbr[4 * c4 + 1] * uv.y + bbr[4 * c4 + 2] * uv.z + bbr[4 * c4 + 3] * uv.w;
                bui += bbi[4 * c4] * uv.x + bbi[4 * c4 + 1] * uv.y + bbi[4 * c4 + 2] * uv.z + bbi[4 * c4 + 3] * uv.w; }
            const float nr = ar * xr - ai * xi + bur, ni = ar * xi + ai * xr + bui; xr = nr; xi = ni; }
        E[(size_t)(g * 128 + j) * 64 + lane] = xr; E[(size_t)(64 * 128 * 64) + (size_t)(g * 128 + j) * 64 + lane] = xi;
        LDS_WAIT(); asm volatile("" ::: "memory");
    }
}

__device__ __forceinline__ void s5_scan_out(const Args& a, LAS unsigned char* lds, int G, int wave_s) {
    int lane_o = (int)__builtin_amdgcn_mbcnt_hi(~0u, __builtin_amdgcn_mbcnt_lo(~0u, 0u)); asm volatile("" : "+v"(lane_o)); const int lane = lane_o, wave = wave_s, tid_o = wave_s * 64 + lane_o;
    unsigned char* ws = a.ws; const bf16* proj = (const bf16*)(ws + WS_PROJ);
    const int gw = blockIdx.x * NWAVES + wave, NGW = G * NWAVES;
    const float* T = (const float*)(ws + WS_S5T); const float* E = (const float*)(ws + WS_E); bf16* yap = (bf16*)(ws + WS_YAPRE);
    LAS float* ut = (LAS float*)(lds + wave * 16384);
    LAS unsigned char* X = lds + wave * 16384 + 4096;
    const int fr = lane & 15, fq = lane >> 4;
    for (int wu = gw; wu < 2048; wu += NGW) { const int g = wu & 63, jb = (wu >> 6) * 4, sp = g * 64 + lane;
        const float ar = T[S5_AR + sp], ai = T[S5_AI + sp], a64r = T[S5_A64R + sp], a64i = T[S5_A64I + sp];
        float bbr[16], bbi[16];
#pragma unroll
        for (int c4 = 0; c4 < 4; ++c4) { const f32x4 r = *(const f32x4*)(T + S5_BBR + sp * 16 + 4 * c4), i = *(const f32x4*)(T + S5_BBI + sp * 16 + 4 * c4);
            bbr[4 * c4] = r.x; bbr[4 * c4 + 1] = r.y; bbr[4 * c4 + 2] = r.z; bbr[4 * c4 + 3] = r.w; bbi[4 * c4] = i.x; bbi[4 * c4 + 1] = i.y; bbi[4 * c4 + 2] = i.z; bbi[4 * c4 + 3] = i.w; }
        bf16x8 cf[4];
#pragma unroll
        for (int ks = 0; ks < 4; ++ks) { const int k0 = 32 * ks + 8 * fq; const bool im = k0 >= 64; const float* src = a.in[im ? I_CIM : I_CRE] + (size_t)(g * 16 + fr) * 64 + (k0 & 63);
            const f32x4 v0 = *(const f32x4*)src, v1 = *(const f32x4*)(src + 4); const float sg = im ? -1.f : 1.f;
            u32x4 w; w.x = pk2(sg * v0.x, sg * v0.y); w.y = pk2(sg * v0.z, sg * v0.w); w.z = pk2(sg * v1.x, sg * v1.y); w.w = pk2(sg * v1.z, sg * v1.w);
            cf[ks] = __builtin_bit_cast(bf16x8, w); }
        const float dsk = a.in[I_S5D][g * 16 + fr];
        float xr = 0.f, xi = 0.f;
        for (int i = 0; i < jb; i += 4) { float er[4], ei[4];
#pragma unroll
            for (int q = 0; q < 4; ++q) { er[q] = E[(size_t)(g * 128 + i + q) * 64 + lane]; ei[q] = E[(size_t)(64 * 128 * 64) + (size_t)(g * 128 + i + q) * 64 + lane]; }
#pragma unroll
            for (int q = 0; q < 4; ++q) { const float nr = a64r * xr - a64i * xi + er[q], ni = a64r * xi + a64i * xr + ei[q]; xr = nr; xi = ni; } }
#pragma unroll 1
        for (int jj = 0; jj < 4; ++jj) { const int j = jb + jj;
        s5_stage_u(proj, g, j, ut, lane);
        for (int tt = 0; tt < 4; ++tt) {
            for (int t16 = 0; t16 < 16; ++t16) { const LAS f32x4* up = (const LAS f32x4*)(ut + (16 * tt + t16) * 16); float bur = 0.f, bui = 0.f;
#pragma unroll
                for (int c4 = 0; c4 < 4; ++c4) { const f32x4 uv = up[c4];
                    bur += bbr[4 * c4] * uv.x + bbr[4 * c4 + 1] * uv.y + bbr[4 * c4 + 2] * uv.z + bbr[4 * c4 + 3] * uv.w;
                    bui += bbi[4 * c4] * uv.x + bbi[4 * c4 + 1] * uv.y + bbi[4 * c4 + 2] * uv.z + bbi[4 * c4 + 3] * uv.w; }
                const float nr = ar * xr - ai * xi + bur, ni = ar * xi + ai * xr + bui; xr = nr; xi = ni;
                *(LAS unsigned short*)(X + t16 * 272 + 2 * lane) = (unsigned short)f2bf(xr); *(LAS unsigned short*)(X + t16 * 272 + 128 + 2 * lane) = (unsigned short)f2bf(xi); }
            LDS_WAIT(); asm volatile("" ::: "memory");
            f32x4 acc = (f32x4){0.f, 0.f, 0.f, 0.f};
#pragma unroll
            for (int ks = 0; ks < 4; ++ks) { const bf16x8 af = *(const LAS bf16x8*)(X + fr * 272 + 64 * ks + 16 * fq); acc = __builtin_amdgcn_mfma_f32_16x16x32_bf16(af, cf[ks], acc, 0, 0, 0); }
#pragma unroll
            for (int r = 0; r < 4; ++r) { const int tl = 16 * tt + 4 * fq + r; const float y = acc[r] + dsk * ut[tl * 16 + fr];
                yap[(size_t)(64 * j + tl) * 1024 + 16 * g + fr] = (bf16)f2bf(gelu_tanh_f(y)); }
            LDS_WAIT(); asm volatile("" ::: "memory");
        }
        }
    }
}

__device__ __forceinline__ void lds_add(LAS unsigned* p, unsigned v) { (void)__hip_atomic_fetch_add(p, v, __ATOMIC_RELAXED, __HIP_MEMORY_SCOPE_WORKGROUP); }
__device__ __forceinline__ float relu_i(float x) { int xi = __builtin_bit_cast(int, x); xi = xi > 0 ? xi : 0; return __builtin_bit_cast(float, xi); }
__device__ __forceinline__ unsigned ord_key(float s) { const unsigned u = __builtin_bit_cast(unsigned, s); return u ^ ((u >> 31) ? 0xFFFFFFFFu : 0x80000000u); }
template <int NB, bool PACKED>
__device__ __forceinline__ void hist_search(const LAS unsigned* hist, int field, unsigned need, int lane, int& bstar, unsigned& above) {
    constexpr int PER = NB / 64;
    const int sh = PACKED ? 16 * field : 0; const unsigned fm = PACKED ? 0xffffu : 0xffffffffu;
    unsigned tot = 0;
#pragma unroll 4
    for (int i = 0; i < PER; i += 4) { const u32x4 h = *(const LAS u32x4*)(hist + lane * PER + i); tot += ((h.x >> sh) & fm) + ((h.y >> sh) & fm) + ((h.z >> sh) & fm) + ((h.w >> sh) & fm); }
    unsigned incl = tot;
#pragma unroll
    for (int o = 1; o < 64; o <<= 1) { const unsigned v = __shfl_down(incl, o); if (lane + o < 64) incl += v; }
    const unsigned excl = incl - tot;
    const unsigned long long mask = __ballot(incl >= need);
    const int lstar = 63 - __builtin_clzll(mask | 1ull);
    unsigned cum = excl; int b = -1; unsigned ab = 0;
#pragma unroll 1
    for (int i = PER - 4; i >= 0; i -= 4) { const u32x4 h = *(const LAS u32x4*)(hist + lane * PER + i);
        const unsigned c3 = (h.w >> sh) & fm, c2 = (h.z >> sh) & fm, c1 = (h.y >> sh) & fm, c0 = (h.x >> sh) & fm;
        if (b < 0) { if (cum + c3 >= need) { b = lane * PER + i + 3; ab = cum; } else cum += c3; }
        if (b < 0) { if (cum + c2 >= need) { b = lane * PER + i + 2; ab = cum; } else cum += c2; }
        if (b < 0) { if (cum + c1 >= need) { b = lane * PER + i + 1; ab = cum; } else cum += c1; }
        if (b < 0) { if (cum + c0 >= need) { b = lane * PER + i + 0; ab = cum; } else cum += c0; } }
    bstar = __shfl(b, lstar); above = __shfl(ab, lstar);
}

__device__ __forceinline__ void dsa_p1_chunk(LAS unsigned char* lds, LAS unsigned* hist, int ch, int buf, int nadm, int l31, int hh, const bf16x8 (&qa)[4], const float (&wv)[16], float* srow) {
    const bool full = 128 * ch + 64 < nadm;
    const LAS unsigned char* tb = lds + (buf * 4) * 18944 + 8192 + l31 * 128;
    f32x16 acc[4];
#pragma unroll
    for (int tl = 0; tl < 4; ++tl)
#pragma unroll
        for (int i = 0; i < 16; ++i) acc[tl][i] = 0.f;
#pragma unroll
    for (int tl = 0; tl < 4; ++tl) {
#pragma unroll
        for (int ks = 0; ks < 4; ++ks) { const bf16x8 kf = *(const LAS bf16x8*)(tb + tl * 18944 + (((2 * ks + hh) ^ (l31 & 7)) * 16));
            acc[tl] = __builtin_amdgcn_mfma_f32_32x32x16_bf16(qa[ks], kf, acc[tl], 0, 0, 0); } }
#pragma unroll
    for (int tl = 0; tl < 4; ++tl) {
        float s0 = 0.f, s1 = 0.f;
#pragma unroll
        for (int i = 0; i < 16; i += 2) { s0 += wv[i] * relu_i(acc[tl][i]); s1 += wv[i + 1] * relu_i(acc[tl][i + 1]); }
        const unsigned ok = ord_key(s0 + s1), bin = ok >> 21;
        if (tl < 2 || full) lds_add(&hist[bin], 1u << (16 * hh));
        __builtin_nontemporal_store(s0 + s1, srow + 128 * ch + 32 * tl + l31);
    }
}
__device__ __forceinline__ void dsa_pass1(const bf16* proj, LAS unsigned char* lds, LAS unsigned char* wl, int nadm, int tid, int lane, const bf16x8 (&qa)[4], const float (&wv)[16], float* srow) {
    const int l31 = lane & 31, hh = lane >> 5;
    LAS unsigned* hist = (LAS unsigned*)wl;
    const int skey = tid >> 3, ssub = tid & 7;
    const bf16* gsrc = proj + (size_t)skey * NIN + C_KI + 8 * ssub;
    const int sdst = ((skey >> 5) * 18944) + 8192 + (skey & 31) * 128 + ((ssub ^ (skey & 7)) * 16);
    const int nch = (nadm + 127) / 128;
#define DSA_LD(c_, r0_, r1_) do { const int cc_ = (c_) < nch ? (c_) : nch - 1; r0_ = *(const u32x4*)(gsrc + (size_t)(128 * cc_) * NIN); r1_ = *(const u32x4*)(gsrc + (size_t)(128 * cc_ + 64) * NIN); } while (0)
#define DSA_ST(b_, r0_, r1_) do { const int bo_ = (b_) * 4 * 18944; *(LAS u32x4*)(lds + sdst + bo_) = r0_; *(LAS u32x4*)(lds + sdst + bo_ + 2 * 18944) = r1_; } while (0)
#define DSA_STEP(c_, b_, l0_, l1_, w0_, w1_) do { DSA_LD((c_) + 4, l0_, l1_); dsa_p1_chunk(lds, hist, (c_), (b_), nadm, l31, hh, qa, wv, srow); if ((c_) + 1 < nch) DSA_ST((b_) ^ 1, w0_, w1_); __syncthreads(); } while (0)
    u32x4 ra0, ra1, rb0, rb1, rc0, rc1, rd0, rd1;
    DSA_LD(0, ra0, ra1); DSA_LD(1, rb0, rb1); DSA_LD(2, rc0, rc1); DSA_LD(3, rd0, rd1);
    DSA_ST(0, ra0, ra1);
    __syncthreads();
#pragma unroll 1
    for (int ch = 0; ch < nch; ch += 4) {
        DSA_STEP(ch, 0, ra0, ra1, rb0, rb1);
        if (ch + 1 >= nch) break;
        DSA_STEP(ch + 1, 1, rb0, rb1, rc0, rc1);
        if (ch + 2 >= nch) break;
        DSA_STEP(ch + 2, 0, rc0, rc1, rd0, rd1);
        if (ch + 3 >= nch) break;
        DSA_STEP(ch + 3, 1, rd0, rd1, ra0, ra1);
    }
#undef DSA_LD
#undef DSA_ST
#undef DSA_STEP
}

__device__ __forceinline__ void dsa_phase(const Args& a, LAS unsigned char* lds, int G, int wave_s) {
    int lane_o = (int)__builtin_amdgcn_mbcnt_hi(~0u, __builtin_amdgcn_mbcnt_lo(~0u, 0u)); asm volatile("" : "+v"(lane_o)); const int lane = lane_o, wave = wave_s, tid_o = wave_s * 64 + lane_o;
    unsigned char* ws = a.ws; const bf16* proj = (const bf16*)(ws + WS_PROJ); const bf16* kvn = (const bf16*)(ws + WS_KVN);
    bf16* ycat = (bf16*)(ws + WS_YCAT);
    constexpr int WREG = 18944;
    LAS unsigned char* wl = lds + wave * WREG;
    LAS unsigned* hist = (LAS unsigned*)wl; LAS int* sel = (LAS int*)(wl + 16896);
    const int l31 = lane & 31, hh = lane >> 5, fr = lane & 15, fq = lane >> 4;
    for (int un = blockIdx.x; un < 512; un += G) {
        __syncthreads();
        const int unit = (un < 256) ? un : 767 - un;
        const int t0 = unit * 16, tq = t0 + 2 * wave;
        const int nadm = ((t0 >> 6) + 1) * 64;
        if (nadm > 256) {
            {
                bf16x8 qa[4];
                { const int r = l31, qq = (r >> 2) & 1, head = (r & 3) + 4 * (r >> 3);
                  const bf16* qp = proj + (size_t)(tq + qq) * NIN + C_QI + head * 64 + 8 * hh;
#pragma unroll
                  for (int ks = 0; ks < 4; ++ks) qa[ks] = *(const bf16x8*)(qp + 16 * ks); }
                float wv[16];
                { const u32x4 w0 = *(const u32x4*)(proj + (size_t)(tq + hh) * NIN + C_WI), w1 = *(const u32x4*)(proj + (size_t)(tq + hh) * NIN + C_WI + 8);
                  const float sc = 1.0f / 32.0f;
                  wv[0] = bflo(w0.x) * sc; wv[1] = bfhi(w0.x) * sc; wv[2] = bflo(w0.y) * sc; wv[3] = bfhi(w0.y) * sc; wv[4] = bflo(w0.z) * sc; wv[5] = bfhi(w0.z) * sc; wv[6] = bflo(w0.w) * sc; wv[7] = bfhi(w0.w) * sc;
                  wv[8] = bflo(w1.x) * sc; wv[9] = bfhi(w1.x) * sc; wv[10] = bflo(w1.y) * sc; wv[11] = bfhi(w1.y) * sc; wv[12] = bflo(w1.z) * sc; wv[13] = bfhi(w1.z) * sc; wv[14] = bflo(w1.w) * sc; wv[15] = bfhi(w1.w) * sc; }
                for (int i = lane; i < 2048; i += 64) hist[i] = 0u;
                dsa_pass1(proj, lds, wl, nadm, tid_o, lane, qa, wv, (float*)(ws + WS_SCORE) + (size_t)(tq + hh) * SEQ);
            }
            int b1[2]; unsigned ab1[2];
            hist_search<2048, true>(hist, 0, 256u, lane, b1[0], ab1[0]);
            hist_search<2048, true>(hist, 1, 256u, lane, b1[1], ab1[1]);
            asm volatile("" ::: "memory");
            LAS unsigned* cok = (LAS unsigned*)wl; LAS int* cix = (LAS int*)(wl + 4096);
            VM_WAIT();
#pragma unroll 1
            for (int qq = 0; qq < 2; ++qq) {
                const float* sr = (const float*)(ws + WS_SCORE) + (size_t)(tq + qq) * SEQ + 4 * lane;
                const unsigned bq = (unsigned)(qq ? b1[1] : b1[0]); unsigned ns = 0, nc = 0;
                const unsigned long long lowm = (1ull << lane) - 1ull;
                for (int k0 = 0; k0 < nadm; k0 += 2048) {
                    f32x4 v[8];
#pragma unroll
                    for (int u = 0; u < 8; ++u) { const int kk = k0 + 256 * u + 4 * lane; v[u] = kk < nadm ? __builtin_nontemporal_load((const f32x4*)(sr + k0 + 256 * u)) : (f32x4){0.f, 0.f, 0.f, 0.f}; }
#pragma unroll
                    for (int u = 0; u < 8; ++u) { if (k0 + 256 * u < nadm) {
                        const int kk = k0 + 256 * u + 4 * lane; const bool vld = kk < nadm;
#pragma unroll
                        for (int c = 0; c < 4; ++c) {
                            const unsigned ok = ord_key(v[u][c]), bin = ok >> 21; const bool isel = vld && bin > bq, icand = vld && bin == bq;
                            const unsigned long long ms = __ballot(isel), mc = __ballot(icand);
                            const unsigned ps = ns + (unsigned)__builtin_popcountll(ms & lowm), pc = nc + (unsigned)__builtin_popcountll(mc & lowm);
                            if (isel && ps < 256u) sel[qq * 256 + ps] = kk + c;
                            if (icand && pc < 512u) { cok[qq * 512 + pc] = ok; cix[qq * 512 + pc] = kk + c; }
                            ns += (unsigned)__builtin_popcountll(ms); nc += (unsigned)__builtin_popcountll(mc); } } }
                }
                LDS_WAIT(); asm volatile("" ::: "memory");
                const unsigned C = nc > 512u ? 512u : nc;
                const unsigned need = ns < 256u ? 256u - ns : 0u;
                unsigned kk8[8]; int ix8[8];
#pragma unroll
                for (int j = 0; j < 8; ++j) { const unsigned i = lane + 64 * j; const bool act = i < C; kk8[j] = act ? cok[qq * 512 + i] : 0u; ix8[j] = act ? cix[qq * 512 + i] : 0x7fffffff; }
                unsigned kstar = 0u; int istar = 0x7fffffff;
                if (need < C) {
                    unsigned prefix = bq << 21;
#pragma unroll 1
                    for (int bit = 20; bit >= 0; --bit) { const unsigned trial = prefix | (1u << bit); unsigned cnt = 0;
#pragma unroll
                        for (int j = 0; j < 8; ++j) cnt += (unsigned)__builtin_popcountll(__ballot(kk8[j] >= trial));
                        if (cnt >= need) prefix = trial; }
                    kstar = prefix;
                    unsigned ngt = 0, neq = 0;
#pragma unroll
                    for (int j = 0; j < 8; ++j) { ngt += (unsigned)__builtin_popcountll(__ballot(kk8[j] > kstar)); neq += (unsigned)__builtin_popcountll(__ballot(kk8[j] == kstar)); }
                    const unsigned m = need - ngt;
                    if (m < neq) { int ans = 0;
#pragma unroll 1
                        for (int bit = 12; bit >= 0; --bit) { const int tr = ans | (1 << bit); unsigned cnt = 0;
#pragma unroll
                            for (int j = 0; j < 8; ++j) cnt += (unsigned)__builtin_popcountll(__ballot(kk8[j] == kstar && ix8[j] < tr));
                            if (cnt < m) ans = tr; }
                        istar = ans; }
                }
                unsigned base = ns;
#pragma unroll
                for (int j = 0; j < 8; ++j) { const bool act = lane + 64u * j < C; const bool pred = act && (kk8[j] > kstar || (kk8[j] == kstar && ix8[j] <= istar));
                    const unsigned long long mk = __ballot(pred); const unsigned pos = base + (unsigned)__builtin_popcountll(mk & lowm);
                    if (pred && pos < 256u) sel[qq * 256 + pos] = ix8[j];
                    base += (unsigned)__builtin_popcountll(mk); }
                for (unsigned i = base + lane; i < 256u; i += 64) sel[qq * 256 + i] = -1;
            }
            LDS_WAIT(); asm volatile("" ::: "memory");
        } else {
            for (int i = lane; i < 512; i += 64) { const int k = i & 255; sel[i] = k < nadm ? k : -1; }
            LDS_WAIT(); asm volatile("" ::: "memory");
        }
#pragma unroll 1
        for (int qq = 0; qq < 2; ++qq) {
            const int t = tq + (qq & 1); const int head = fr & 7;
            const float slope = fast_exp2(-(float)(head + 1));
            bf16x8 qf[8];
            { const bf16* qp = proj + (size_t)t * NIN + C_QT + head * 256 + 8 * fq;
#pragma unroll
              for (int ks = 0; ks < 8; ++ks) qf[ks] = *(const bf16x8*)(qp + 32 * ks); }
            f32x4 oacc[16];
#pragma unroll
            for (int i = 0; i < 16; ++i) oacc[i] = (f32x4){0.f, 0.f, 0.f, 0.f};
            float mrun = -1e30f, lrun = 0.f;
            u32x4 gr[16];
#pragma unroll
            for (int i = 0; i < 16; ++i) { int s = sel[(qq & 1) * 256 + hh + 2 * i]; s = s < 0 ? 0 : s; gr[i] = *(const u32x4*)(kvn + (size_t)s * 256 + 8 * l31); }
            for (int kt = 0; kt < 8; ++kt) {
                asm volatile("" ::: "memory");
#pragma unroll
                for (int i = 0; i < 16; ++i) *(LAS u32x4*)(wl + (hh + 2 * i) * 528 + 16 * l31) = gr[i];
                if (kt + 1 < 8) {
#pragma unroll
                    for (int i = 0; i < 16; ++i) { int s = sel[(qq & 1) * 256 + 32 * (kt + 1) + hh + 2 * i]; s = s < 0 ? 0 : s; gr[i] = *(const u32x4*)(kvn + (size_t)s * 256 + 8 * l31); } }
                LDS_WAIT(); asm volatile("" ::: "memory");
                f32x4 sacc[2];
#pragma unroll
                for (int sb = 0; sb < 2; ++sb) { f32x4 c4 = (f32x4){0.f, 0.f, 0.f, 0.f};
#pragma unroll
                    for (int ks = 0; ks < 8; ++ks) { const bf16x8 af = *(const LAS bf16x8*)(wl + (16 * sb + fr) * 528 + 64 * ks + 16 * fq); c4 = __builtin_amdgcn_mfma_f32_16x16x32_bf16(af, qf[ks], c4, 0, 0, 0); }
                    sacc[sb] = c4; }
                float lg[8]; float mx = -1e30f;
#pragma unroll
                for (int sb = 0; sb < 2; ++sb) { const LAS int* sp = sel + (qq & 1) * 256 + 32 * kt + 16 * sb + 4 * fq;
#pragma unroll
                    for (int r = 0; r < 4; ++r) { const int s = sp[r]; const float d = (float)(t - s); float v = sacc[sb][r] - slope * fabsf(d); v = s < 0 ? -1e30f : v; lg[4 * sb + r] = v; mx = fmaxf(mx, v); } }
                mx = fmaxf(mx, __shfl_xor(mx, 16)); mx = fmaxf(mx, __shfl_xor(mx, 32));
                const float mnew = fmaxf(mrun, mx); const float alpha = fast_exp2((mrun - mnew) * 1.4426950408889634f);
                float ps = 0.f; float p[8];
#pragma unroll
                for (int i = 0; i < 8; ++i) { p[i] = lg[i] <= -1e29f ? 0.f : fast_exp2((lg[i] - mnew) * 1.4426950408889634f); ps += p[i]; }
                lrun = lrun * alpha + ps; mrun = mnew;
#pragma unroll
                for (int i = 0; i < 16; ++i) oacc[i] = oacc[i] * alpha;
                u32x4 pw; pw.x = pk2(p[0], p[1]); pw.y = pk2(p[2], p[3]); pw.z = pk2(p[4], p[5]); pw.w = pk2(p[6], p[7]);
                const bf16x8 pf = __builtin_bit_cast(bf16x8, pw);
#pragma unroll
                for (int rt = 0; rt < 16; ++rt) {
                    const LAS unsigned char* p0 = wl + (4 * fq + (fr >> 2)) * 528 + (16 * rt + 4 * (fr & 3)) * 2;
                    const v4i16_t a0 = __builtin_amdgcn_ds_read_tr16_b64_v4i16((LAS v4i16_t*)p0);
                    const v4i16_t a1 = __builtin_amdgcn_ds_read_tr16_b64_v4i16((LAS v4i16_t*)(p0 + 16 * 528));
                    bf16x8 af; af[0] = a0[0]; af[1] = a0[1]; af[2] = a0[2]; af[3] = a0[3]; af[4] = a1[0]; af[5] = a1[1]; af[6] = a1[2]; af[7] = a1[3];
                    oacc[rt] = __builtin_amdgcn_mfma_f32_16x16x32_bf16(af, pf, oacc[rt], 0, 0, 0); }
                LDS_WAIT(); asm volatile("" ::: "memory");
            }
            float lt = lrun; lt += __shfl_xor(lt, 16); lt += __shfl_xor(lt, 32);
            const float inv = 1.0f / lt;
#if FP8_MIXOUT
            if (fr < 8) { unsigned char* op = (unsigned char*)ycat + (size_t)t * NCAT + 1024 + fr * 256 + 4 * fq; const float inv8 = inv * 8.0f;
#pragma unroll
                for (int rt = 0; rt < 16; ++rt) { const f32x4 v = oacc[rt] * inv8; *(unsigned*)(op + 16 * rt) = pk4_fp8(v.x, v.y, v.z, v.w); } }
#else
            if (fr < 8) { bf16* op = ycat + (size_t)t * NCAT + 1024 + fr * 256 + 4 * fq;
#pragma unroll
                for (int rt = 0; rt < 16; ++rt) { const f32x4 v = oacc[rt] * inv; u32x2 w; w.x = pk2(v.x, v.y); w.y = pk2(v.z, v.w); *(u32x2*)(op + 16 * rt) = w; } }
#endif
        }
        LDS_WAIT(); asm volatile("" ::: "memory");
    }
}

__device__ __forceinline__ void attn_c_phase(const Args& a, LAS unsigned char* lds, int G, int wave_s) {
    int lane_o = (int)__builtin_amdgcn_mbcnt_hi(~0u, __builtin_amdgcn_mbcnt_lo(~0u, 0u)); asm volatile("" : "+v"(lane_o)); const int lane = lane_o, wave = wave_s, tid_o = wave_s * 64 + lane_o;
    unsigned char* ws = a.ws; const bf16* Q = (const bf16*)(ws + WS_Q); const bf16* K = (const bf16*)(ws + WS_K); const bf16* VT = (const bf16*)(ws + WS_VT); bf16* O = (bf16*)(ws + WS_O);
    LAS float* btab = (LAS float*)(lds + 65536);
    const int l31 = lane & 31, hh = lane >> 5;
    const float sc = 0.08838834764831845f * 1.4426950408889634f;
    const int kkey = tid_o >> 4, kc = tid_o & 15, vd = tid_o >> 3, vc = tid_o & 7;
    for (int un = blockIdx.x; un < 512; un += G) {
        const int head = un >> 5, cg = un & 31, ci = wave >> 1, chunk = 4 * cg + ci;
        __syncthreads();
        for (int i = tid_o; i < 513; i += NTHR) btab[i] = a.in[I_RELB][head * 513 + i] * 1.4426950408889634f;
        const int t = 64 * chunk + 32 * (wave & 1) + l31;
        bf16x8 qf[8];
        { const bf16* qp = Q + (size_t)t * DM + head * 128 + 8 * hh;
#pragma unroll
          for (int ks = 0; ks < 8; ++ks) qf[ks] = *(const bf16x8*)(qp + 16 * ks); }
        f32x16 oacc[4];
#pragma unroll
        for (int d = 0; d < 4; ++d)
#pragma unroll
            for (int i = 0; i < 16; ++i) oacc[d][i] = 0.f;
        float mrun = -1e30f, lrun = 0.f;
        const int cb0 = 4 * cg - 8;
        const int j0 = cb0 < 0 ? -cb0 : 0;
        const bf16* kg = K + (size_t)kkey * DM + head * 128 + kc * 8; const bf16* vg = VT + (size_t)(head * 128 + vd) * SEQ + vc * 8;
        const int kdst = kkey * 256 + ((kc ^ (kkey & 15)) * 16), vdst = 16384 + vd * 128 + ((vc ^ ((vd >> 1) & 7)) * 16);
        u32x4 sk0, sk1, sv0, sv1;
#define ATC_LD(j_) do { const size_t s0_ = (size_t)(64 * (cb0 + (j_))); sk0 = *(const u32x4*)(kg + s0_ * DM); sk1 = *(const u32x4*)(kg + (s0_ + 32) * DM); sv0 = *(const u32x4*)(vg + s0_); sv1 = *(const u32x4*)(vg + s0_ + (size_t)64 * SEQ); } while (0)
#define ATC_ST(b_) do { LAS unsigned char* d_ = lds + (b_) * 32768; *(LAS u32x4*)(d_ + kdst) = sk0; *(LAS u32x4*)(d_ + kdst + 32 * 256) = sk1; *(LAS u32x4*)(d_ + vdst) = sv0; *(LAS u32x4*)(d_ + vdst + 64 * 128) = sv1; } while (0)
        ATC_LD(j0); ATC_ST(j0 & 1);
        __syncthreads();
        for (int j = j0; j < 12; ++j) {
            if (j + 1 < 12) ATC_LD(j + 1);
            if (j >= ci && j <= ci + 8) {
                const LAS unsigned char* kb = lds + (j & 1) * 32768; const LAS unsigned char* vb = kb + 16384;
                const int s0 = 64 * (cb0 + j);
#pragma unroll
                for (int sub = 0; sub < 2; ++sub) {
                    f32x16 sa;
#pragma unroll
                    for (int i = 0; i < 16; ++i) sa[i] = 0.f;
                    const int krow = 32 * sub + l31;
#pragma unroll
                    for (int ks = 0; ks < 8; ++ks) { const bf16x8 kf = *(const LAS bf16x8*)(kb + krow * 256 + (((2 * ks + hh) ^ (krow & 15)) * 16)); sa = __builtin_amdgcn_mfma_f32_32x32x16_bf16(kf, qf[ks], sa, 0, 0, 0); }
                    float mx = -1e30f; float lg[16];
#pragma unroll
                    for (int i = 0; i < 16; ++i) { const int s = s0 + 32 * sub + (i & 3) + 8 * (i >> 2) + 4 * hh; int rel = t - s; rel = rel > 256 ? 256 : rel; lg[i] = sa[i] * sc + btab[rel + 256]; mx = fmaxf(mx, lg[i]); }
                    mx = fmaxf(mx, __shfl_xor(mx, 32));
                    const float mnew = fmaxf(mrun, mx), alpha = fast_exp2(mrun - mnew);
                    float ps = 0.f; float p[16];
#pragma unroll
                    for (int i = 0; i < 16; ++i) { p[i] = fast_exp2(lg[i] - mnew); ps += p[i]; }
                    lrun = lrun * alpha + ps; mrun = mnew;
#pragma unroll
                    for (int d = 0; d < 4; ++d)
#pragma unroll
                        for (int i = 0; i < 16; ++i) oacc[d][i] *= alpha;
#pragma unroll
                    for (int s = 0; s < 2; ++s) {
                        u32x4 pw; pw.x = pk2(p[8 * s], p[8 * s + 1]); pw.y = pk2(p[8 * s + 2], p[8 * s + 3]); pw.z = pk2(p[8 * s + 4], p[8 * s + 5]); pw.w = pk2(p[8 * s + 6], p[8 * s + 7]);
                        const bf16x8 pf = __builtin_bit_cast(bf16x8, pw);
                        const int q0 = 8 * sub + 4 * s + hh;
#pragma unroll
                        for (int d = 0; d < 4; ++d) { const int dr = 32 * d + l31; const LAS unsigned char* vr = vb + dr * 128 + (q0 & 1) * 8; const int sw = (dr >> 1) & 7;
                            const u32x2 v0 = *(const LAS u32x2*)(vr + (((q0 >> 1) ^ sw) * 16)), v1 = *(const LAS u32x2*)(vr + ((((q0 >> 1) + 1) ^ sw) * 16));
                            u32x4 vw; vw.x = v0.x; vw.y = v0.y; vw.z = v1.x; vw.w = v1.y;
                            oacc[d] = __builtin_amdgcn_mfma_f32_32x32x16_bf16(__builtin_bit_cast(bf16x8, vw), pf, oacc[d], 0, 0, 0); }
                    }
                }
            }
            if (j + 1 < 12) ATC_ST((j + 1) & 1);
            __syncthreads();
        }
#undef ATC_LD
#undef ATC_ST
        float lt = lrun + __shfl_xor(lrun, 32); const float inv = 1.0f / lt;
#if FP8_MIXOUT
        unsigned char* op = (unsigned char*)O + (size_t)t * DM + head * 128 + 4 * hh; const float inv8 = inv * 8.0f;
#pragma unroll
        for (int d = 0; d < 4; ++d)
#pragma unroll
            for (int gq = 0; gq < 4; ++gq) *(unsigned*)(op + 32 * d + 8 * gq) = pk4_fp8(oacc[d][4 * gq] * inv8, oacc[d][4 * gq + 1] * inv8, oacc[d][4 * gq + 2] * inv8, oacc[d][4 * gq + 3] * inv8);
#else
        bf16* op = O + (size_t)t * DM + head * 128 + 4 * hh;
#pragma unroll
        for (int d = 0; d < 4; ++d)
#pragma unroll
            for (int gq = 0; gq < 4; ++gq) { u32x2 w; w.x = pk2(oacc[d][4 * gq] * inv, oacc[d][4 * gq + 1] * inv); w.y = pk2(oacc[d][4 * gq + 2] * inv, oacc[d][4 * gq + 3] * inv);
                *(u32x2*)(op + 32 * d + 8 * gq) = w; }
#endif
    }
    __syncthreads();
}

__global__ void __launch_bounds__(NTHR, 2) fwd_kernel(Args args) {
    extern __shared__ __attribute__((aligned(16))) unsigned char lds_raw[];
    LAS unsigned char* lds = (LAS unsigned char*)lds_raw;
    volatile LAS unsigned* MISC = (volatile LAS unsigned*)(lds + MISC_OFF);
    const int wave_s = __builtin_amdgcn_readfirstlane((int)threadIdx.x >> 6);
    const int G = gridDim.x;
    unsigned char* ws = args.ws;
    if (threadIdx.x < 64) MISC[threadIdx.x] = 0u;
    __syncthreads();
    const int lo = args.ph_lo, hi = args.ph_hi;
    const bool multi = (hi - lo) > 1;
    XcdBarrier bar; bar.bar = (unsigned*)(ws + WS_CTL) + CW_BAR; bar.x = 0; bar.st = nullptr;
    if (multi) bar = xcd_barrier_post((unsigned*)(ws + WS_CTL) + CW_BAR, MISC + 8);
    bar.wave = wave_s;
#define IN(k) (lo <= (k) && (k) < hi)
#if TIMING
#define STAMP(k) do { if (blockIdx.x == 0 && wave_s == 0 && __builtin_amdgcn_mbcnt_hi(~0u, __builtin_amdgcn_mbcnt_lo(~0u, 0u)) == 0u) __hip_atomic_store((unsigned long long*)(ws + WS_DIAG) + (k), __builtin_amdgcn_s_memrealtime(), __ATOMIC_RELAXED, __HIP_MEMORY_SCOPE_AGENT); } while (0)
#define SEAM(k) do { if (IN((k) + 1)) xcd_barrier(bar); STAMP((k) + 1); } while (0)
#else
#define STAMP(k) do { } while (0)
#define SEAM(k) do { if (IN((k) + 1)) xcd_barrier(bar); } while (0)
#endif

 #if REP_MASK
#define PH_LOOP(k) _Pragma("unroll") for (int r_ = 0; r_ < ((((REP_MASK) >> (k)) & 1u) ? REP_N : 1); ++r_)
#else
#define PH_LOOP(k)
#endif
    float* H = args.out;
    float* mod = (float*)(ws + WS_MOD);
    bf16* hn = (bf16*)(ws + WS_HN); bf16* hmid = (bf16*)(ws + WS_HMID); bf16* proj = (bf16*)(ws + WS_PROJ);

    STAMP(0);
    PH_LOOP(0) { if (EN(0) && IN(0)) p0_prologue(args, lds, G, wave_s);
    if (IN(0)) SEAM(0); }

#define FFN_PHASES(S_, PB_) do { \
        constexpr int layer_ = (S_) >> 1, sub_ = ((S_) & 1) ? 2 : 0; \
        const float* hin_ = ((S_) == 0) ? args.in[I_X] : H; \
        const float* mvec_ = mod + layer_ * NMOD + sub_ * 3 * DM; \
        PH_LOOP(PB_) { if (EN(1) && IN(PB_)) norm_phase<false, true>(hin_, args.in[I_NORMG] + (layer_ * 3 + sub_) * DM, mvec_, mvec_ + DM, hn, nullptr, G, wave_s); \
        if ((S_) == 0 && EN(2) && IN(PB_)) { \
              \
            pg8::Gemm g{(const bf16*)(ws + WS_WUPRAW), (const bf16*)(ws + WS_WQRAW), 256, 2048, 128, 2048, 2048, 8, 128, 128, \
                        (const bf16*)(ws + WS_WOUTB) + 1024, (const bf16*)(ws + WS_WUPRAW) + 1024, 2048, 256, 8, 128, 128}; \
            pg8::StaticOrder S; S.init(g, G, (int)blockIdx.x); \
            pg8::EpiBf16 E{(bf16*)(ws + WS_WIN) + (size_t)1024 * DM, DM, (size_t)256 * DM, 0.08838834764831845f, FP8_MIXOUT ? (bf16*)(ws + WS_WOUT + 1024) : (bf16*)(ws + WS_WOUT) + 1024, NCAT, (size_t)256, FP8_MIXOUT ? 64.0f : 1.0f, 0, 0, FP8_MIXOUT}; \
            pg8::gemm_phase<pg8::EpiBf16>(lds, g, S, E, wave_s); } \
        if (IN(PB_)) SEAM(PB_); } \
        PH_LOOP((PB_) + 1) { if (EN(3) && IN((PB_) + 1)) { \
            pg8::Gemm g{hn, (const bf16*)(ws + WS_WGU + (size_t)(S_) * NGU * DM), SEQ, NGU, DM / 2, DM / 2, DM / 2, 1, 0, 0, nullptr, nullptr, 0, 0, 0, 0, 0}; \
            pg8::StaticOrder S; S.init(g, G, (int)blockIdx.x); \
            pg8::EpiSwiGLU E{(unsigned char*)hmid, FFP, 0x7c7c7c7c, 0x79797979};     \
            pg8::gemm_phase<pg8::EpiSwiGLU, true>(lds, g, S, E, wave_s); } \
        if (IN((PB_) + 1)) SEAM((PB_) + 1); } \
        PH_LOOP((PB_) + 2) { if (EN(4) && IN((PB_) + 2)) { \
            pg8::Gemm g{hmid, (const bf16*)(ws + WS_WD + (size_t)(S_) * DM * FFP), SEQ, DM, FFP / 2, FFP / 2, FFP / 2, 1, 0, 0, nullptr, nullptr, 0, 0, 0, 0, 0}; \
            pg8::StaticOrder S; S.init(g, G, (int)blockIdx.x); \
            pg8::EpiResid E{hin_, H, mvec_ + 2 * DM, 0.5f, 0x7c7c7c7c, 0x78787878};     \
            pg8::gemm_phase<pg8::EpiResid, true>(lds, g, S, E, wave_s); } \
        if (IN((PB_) + 2)) SEAM((PB_) + 2); } \
    } while (0)
#define MIXOUT_PHASE(LYR_, PM_, APTR_, BPTR_, K_) do { \
        if (EN(12) && IN(PM_)) { \
            const float* m1_ = mod + (LYR_) * NMOD + 1 * 3 * DM; \
            constexpr int KU_ = FP8_MIXOUT ? (K_) / 2 : (K_); \
            pg8::Gemm g{(const bf16*)(APTR_), (const bf16*)(BPTR_), SEQ, DM, KU_, KU_, KU_, 1, 0, 0, nullptr, nullptr, 0, 0, 0, 0, 0}; \
            pg8::StaticOrder S; S.init(g, G, (int)blockIdx.x); \
            pg8::EpiResid E{H, H, m1_ + 2 * DM, 1.0f, 0x7c7c7c7c, 0x79797979}; \
            pg8::gemm_phase<pg8::EpiResid, FP8_MIXOUT != 0>(lds, g, S, E, wave_s); } \
        if (IN(PM_)) SEAM(PM_); \
    } while (0)

    FFN_PHASES(0, 1);
    {
        const float* m1 = mod + 0 * NMOD + 1 * 3 * DM;
        PH_LOOP(4) { if (EN(1) && IN(4)) norm_phase<false>(H, args.in[I_NORMG] + (0 * 3 + 1) * DM, m1, m1 + DM, hn, nullptr, G, wave_s);
        if (IN(4)) SEAM(4); }
        PH_LOOP(5) { if (EN(5) && IN(5)) {
            pg8::Gemm g{hn, (const bf16*)(ws + WS_WIN), SEQ, NIN, DM, DM, DM, 1, 0, 0, nullptr, nullptr, 0, 0, 0, 0, 0};
            pg8::StaticOrder S; S.init(g, G, (int)blockIdx.x);
            pg8::EpiBf16 E{proj, NIN, 0, 1.0f, nullptr, 0, 0, 0.f};
            pg8::gemm_phase<pg8::EpiBf16>(lds, g, S, E, wave_s);
        }
        if (IN(5)) SEAM(5); }
        PH_LOOP(6) { if (EN(6) && IN(6)) phase_a2(args, lds, G, wave_s);
        if (IN(6)) SEAM(6); }
        PH_LOOP(24) { if (EN(7) && IN(7)) { s5_scan_out(args, lds, G, wave_s); __syncthreads(); } }
        STAMP(25);
        PH_LOOP(25) { if (EN(8) && IN(7)) dsa_phase(args, lds, G, wave_s); }
        if (IN(7)) SEAM(7);
        PH_LOOP(8) { if (EN(9) && IN(8)) {
            pg8::Gemm g{(const bf16*)(ws + WS_YAPRE), (const bf16*)(ws + WS_WGLU), SEQ, 1024, 1024, 1024, 1024, 1, 0, 0, nullptr, nullptr, 0, 0, 0, 0, 0};
            pg8::StaticOrder S; S.init(g, G, (int)blockIdx.x);
            pg8::EpiGLU E{(const bf16*)(ws + WS_YAPRE), args.in[I_BGLU], (bf16*)(ws + WS_YCAT), NCAT};
            pg8::gemm_phase<pg8::EpiGLU>(lds, g, S, E, wave_s);
        }
        if (IN(8)) SEAM(8); }
    }
#ifdef EXTRA_BARRIERS
    for (int xb_ = 0; xb_ < EXTRA_BARRIERS; ++xb_) xcd_barrier(bar);
#endif
#ifdef EXP_GEMM
    {
        xcd_barrier(bar);
#if EXP_GEMM == 1
        pg8::Gemm g{hmid, (const bf16*)(ws + WS_WD), SEQ, DM, FFP / 2, FFP / 2, FFP / 2, 1, 0, 0, nullptr, nullptr, 0, 0, 0, 0, 0};
        pg8::StaticOrder S; S.init(g, G, (int)blockIdx.x); S.force = EXP_FORCE;
        pg8::EpiBf16 E{(bf16*)(ws + WS_SCORE), DM, 0, 1.0f, nullptr, 0, 0, 0.f, 0x7c7c7c7c, 0x78787878};
        pg8::gemm_phase<pg8::EpiBf16, true>(lds, g, S, E, wave_s);
#elif EXP_GEMM == 3
        pg8::Gemm g{hmid, (const bf16*)(ws + WS_WD), SEQ, DM, FFP / 2, FFP / 2, FFP / 2, 1, 0, 0, nullptr, nullptr, 0, 0, 0, 0, 0};
        pg8::StaticOrder S; S.init(g, G, (int)blockIdx.x); S.force = EXP_FORCE;
        pg8::EpiResid E{H, (float*)(ws + WS_SCORE), mod + 2 * DM, 0.5f, 0x7c7c7c7c, 0x78787878};
        pg8::gemm_phase<pg8::EpiResid, true>(lds, g, S, E, wave_s);
#elif EXP_GEMM == 2
        pg8::Gemm g{hn, (const bf16*)(ws + WS_WGU), SEQ, NGU, DM / 2, DM / 2, DM / 2, 1, 0, 0, nullptr, nullptr, 0, 0, 0, 0, 0};
        pg8::StaticOrder S; S.init(g, G, (int)blockIdx.x); S.force = EXP_FORCE;
        pg8::EpiBf16 E{(bf16*)(ws + WS_SCORE), NGU, 0, 1.0f, nullptr, 0, 0, 0.f, 0x7c7c7c7c, 0x79797979};
        pg8::gemm_phase<pg8::EpiBf16, true>(lds, g, S, E, wave_s);
#endif
        xcd_barrier(bar);
    }
#endif
    MIXOUT_PHASE(0, 9, ws + WS_YCAT, ws + WS_WOUT, NCAT);
    FFN_PHASES(1, 10);
    FFN_PHASES(2, 13);
    {
        const float* m1 = mod + 1 * NMOD + 1 * 3 * DM;
        PH_LOOP(16) { if (EN(1) && IN(16)) norm_phase<false, FP8_QKV != 0>(H, args.in[I_NORMG] + (1 * 3 + 1) * DM, m1, m1 + DM, hn, nullptr, G, wave_s);
        if (IN(16)) SEAM(16); }
        PH_LOOP(17) { if (EN(10) && IN(17)) {
            constexpr int KU = FP8_QKV ? DM / 2 : DM;
            pg8::Gemm g{hn, (const bf16*)(ws + WS_WQKV), SEQ, 2048, KU, KU, KU, 2, 0, (size_t)2048 * KU,
                        (const bf16*)(ws + WS_WQKV) + (size_t)4096 * KU, hn, 2048, SEQ, 1, 0, 0};
            pg8::StaticOrder S; S.init(g, G, (int)blockIdx.x);
            pg8::EpiBf16 E{(bf16*)(ws + WS_Q), DM, (size_t)SEQ * DM, 1.0f, (bf16*)(ws + WS_VT), SEQ, 0, 1.0f, 0x7c7c7c7c, 0x79797979};
            pg8::gemm_phase<pg8::EpiBf16, FP8_QKV != 0>(lds, g, S, E, wave_s);
        }
        if (IN(17)) SEAM(17); }
        PH_LOOP(18) { if (EN(11) && IN(18)) attn_c_phase(args, lds, G, wave_s);
        if (IN(18)) SEAM(18); }
    }
    MIXOUT_PHASE(1, 19, ws + WS_O, ws + WS_WCOUT, DM);
    FFN_PHASES(3, 20);
    if (EN(13) && IN(23)) { norm_phase<true>(H, args.in[I_FING], nullptr, nullptr, nullptr, args.out, G, wave_s); }
#if TIMING
    {
        xcd_barrier(bar); STAMP(24);
        if (blockIdx.x == 0 && wave_s == 0) {
            const unsigned long long* ts = (const unsigned long long*)(ws + WS_DIAG);
            const unsigned long long a0 = __hip_atomic_load(ts + TSEL_A, __ATOMIC_RELAXED, __HIP_MEMORY_SCOPE_AGENT), a1 = __hip_atomic_load(ts + TSEL_A + TSEL_A_N, __ATOMIC_RELAXED, __HIP_MEMORY_SCOPE_AGENT);
            const unsigned long long want = (a1 - a0) * TAMP, t0 = __builtin_amdgcn_s_memrealtime();
            while (__builtin_amdgcn_s_memrealtime() - t0 < want) __builtin_amdgcn_s_sleep(32);
        }
    }
#endif
#undef IN
#undef SEAM
}

extern "C" void kernel_launch(void* const* d_in, const int* in_sizes, int n_in, void* d_out, int out_size, void* d_ws, size_t ws_size, hipStream_t stream) {
    static int grid = 0;
    if (grid == 0) {
        if (n_in != 26 || out_size != SEQ * DM || ws_size < WS_END) { fprintf(stderr, "kernel_launch: unexpected shapes (n_in %d out %d ws %zu need %zu)\n", n_in, out_size, ws_size, (size_t)WS_END); grid = -1; return; }
        int dev = 0, cus = 0, per_cu = 0;
        if (hipGetDevice(&dev) != hipSuccess || hipDeviceGetAttribute(&cus, hipDeviceAttributeMultiprocessorCount, dev) != hipSuccess) { grid = -1; return; }
        if (hipFuncSetAttribute((const void*)fwd_kernel, hipFuncAttributeMaxDynamicSharedMemorySize, LDS_BYTES) != hipSuccess) { fprintf(stderr, "kernel_launch: hipFuncSetAttribute failed\n"); grid = -1; return; }
        if (hipOccupancyMaxActiveBlocksPerMultiprocessor(&per_cu, (const void*)fwd_kernel, NTHR, LDS_BYTES) != hipSuccess || per_cu < 1) { fprintf(stderr, "kernel_launch: occupancy query says %d\n", per_cu); }
        (void)hipGetLastError();
        grid = cus;
    }
    if (grid < 0) return;
    (void)hipMemsetAsync((char*)d_ws + WS_CTL, 0, CTL_ZERO_BYTES, stream);
    Args a{};
    for (int i = 0; i < 26; ++i) a.in[i] = (const float*)d_in[i];
    a.out = (float*)d_out; a.ws = (unsigned char*)d_ws;
    a.ph_lo = 0; a.ph_hi = N_PHASES_RUN;
    hipLaunchKernelGGL(fwd_kernel, dim3(grid), dim3(NTHR), LDS_BYTES, stream, a);
}
```

```cpp
#include <hip/hip_runtime.h>
#include <cstdio>
#include <cstdint>

#ifndef SELFCHECK
#define SELFCHECK 0
#endif
#ifndef N_PHASES_RUN
#define N_PHASES_RUN 24
#endif
#ifndef REP_MASK
#define REP_MASK 0u
#endif
#ifndef REP_N
#define REP_N 2
#endif
#ifndef FP8_QKV
#define FP8_QKV 1
#endif
#ifndef FP8_MIXOUT
#define FP8_MIXOUT 1
#endif
#ifndef TIMING
#define TIMING 0
#endif
#ifndef TBLK
#define TBLK 100
#endif
#ifndef TAMP
#define TAMP 8
#endif
#ifndef TSEL_A
#define TSEL_A 0
#define TSEL_A_N 1
#define TSEL_B 1
#define TSEL_B_N 1
#endif

#ifndef EN_MASK
#define EN_MASK 0xFFFFFFFFu
#endif
#define EN(b) ((EN_MASK >> (b)) & 1u)
#define GAS __attribute__((address_space(1)))
#define LAS __attribute__((address_space(3)))
typedef unsigned short bf16;
typedef short bf16x8 __attribute__((ext_vector_type(8)));
typedef short s16x4 __attribute__((ext_vector_type(4)));
typedef float f32x2 __attribute__((ext_vector_type(2)));
typedef float f32x4 __attribute__((ext_vector_type(4)));
typedef float f32x16 __attribute__((ext_vector_type(16)));
typedef unsigned u32x2 __attribute__((ext_vector_type(2)));
typedef unsigned u32x4 __attribute__((ext_vector_type(4)));
typedef short v4i16_t __attribute__((ext_vector_type(4)));

constexpr int SEQ = 8192, DM = 2048, FF = 5504, NGU = 2 * FF  , NMOD = 18432;
constexpr int NIN = 4608;
constexpr int C_U = 0, C_QT = 1024, C_KVL = 3072, C_QI = 3328, C_KI = 4352, C_WI = 4416;
constexpr int FFP = 5632;
constexpr int NCAT = 3072;
constexpr int NWAVES = 8, NTHR = 512;

constexpr size_t MiB = 1u << 20;
constexpr size_t WS_CTL = 0, CTL_ZERO_BYTES = 1 * MiB;
constexpr size_t WS_MOD = 1 * MiB;
constexpr size_t WS_S5T = WS_MOD + 256 * 1024;
constexpr size_t WS_DIAG = 3 * MiB;
constexpr size_t WS_WGU = 4 * MiB;
constexpr size_t WS_WD = WS_WGU + 172 * MiB;
constexpr size_t WS_WIN = WS_WD + 86 * MiB;
constexpr size_t WS_WQRAW = WS_WIN + 18 * MiB;
constexpr size_t WS_WUPRAW = WS_WQRAW + 8 * MiB;
constexpr size_t WS_WGLU = WS_WUPRAW + 1 * MiB;
constexpr size_t WS_WOUT = WS_WGLU + 2 * MiB;
constexpr size_t WS_WOUTB = WS_WOUT + 12 * MiB;
constexpr size_t WS_WQKV = WS_WOUTB + 8 * MiB;
constexpr size_t WS_WCOUT = WS_WQKV + 24 * MiB;
constexpr size_t WS_HN = WS_WCOUT + 8 * MiB;
constexpr size_t WS_HMID = WS_HN + 32 * MiB;
constexpr size_t WS_PROJ = WS_HMID + 86 * MiB;
constexpr size_t WS_KVN = WS_PROJ + 72 * MiB;
constexpr size_t WS_E = WS_KVN + 4 * MiB;
constexpr size_t WS_YAPRE = WS_E + 4 * MiB;
constexpr size_t WS_YCAT = WS_YAPRE + 16 * MiB;
constexpr size_t WS_SCORE = WS_YCAT + 48 * MiB;
constexpr size_t WS_Q = WS_SCORE, WS_K = WS_SCORE + 32 * MiB, WS_VT = WS_SCORE + 64 * MiB, WS_O = WS_SCORE + 96 * MiB;
constexpr size_t WS_END = WS_SCORE + 256 * MiB;
constexpr int S5_AR = 0, S5_AI = 4096, S5_A64R = 8192, S5_A64I = 12288, S5_BBR = 16384, S5_BBI = 16384 + 65536;

constexpr int CW_BAR = 4096;

constexpr int RING_BYTES = 131072;
constexpr int SCRATCH_BYTES = 155648;
constexpr int MISC_OFF = SCRATCH_BYTES;
constexpr int LDS_BYTES = SCRATCH_BYTES + 256;

#define LDS_WAIT() asm volatile("s_waitcnt lgkmcnt(0)" ::: "memory")
#define VM_WAIT() asm volatile("s_waitcnt vmcnt(0)" ::: "memory")

__device__ __forceinline__ unsigned f2bf(float f) { unsigned u = __builtin_bit_cast(unsigned, f); return (u + 0x7fffu + ((u >> 16) & 1u)) >> 16; }
__device__ __forceinline__ unsigned pk2(float lo, float hi) { unsigned r; asm volatile("v_cvt_pk_bf16_f32 %0, %1, %2" : "=v"(r) : "v"(lo), "v"(hi)); return r; }
__device__ __forceinline__ float clamp448(float x) { return __builtin_amdgcn_fmed3f(x, -448.0f, 448.0f); }
__device__ __forceinline__ unsigned pk4_fp8(float a, float b, float c, float d) {
    int w = 0; w = __builtin_amdgcn_cvt_pk_fp8_f32(clamp448(a), clamp448(b), w, false); w = __builtin_amdgcn_cvt_pk_fp8_f32(clamp448(c), clamp448(d), w, true); return (unsigned)w; }
__device__ __forceinline__ float bf2f(unsigned short b) { return __builtin_bit_cast(float, (unsigned)b << 16); }
__device__ __forceinline__ float bflo(unsigned w) { return __builtin_bit_cast(float, w << 16); }
__device__ __forceinline__ float bfhi(unsigned w) { return __builtin_bit_cast(float, w & 0xffff0000u); }
__device__ __forceinline__ float fast_exp2(float x) { return __builtin_amdgcn_exp2f(x); }
__device__ __forceinline__ float fast_rcp(float x) { return __builtin_amdgcn_rcpf(x); }
__device__ __forceinline__ float silu_f(float x) { return x * fast_rcp(1.0f + fast_exp2(-1.4426950408889634f * x)); }
__device__ __forceinline__ float sigmoid_f(float x) { return fast_rcp(1.0f + fast_exp2(-1.4426950408889634f * x)); }
__device__ __forceinline__ float gelu_tanh_f(float y) {
    const float z = 0.7978845608028654f * (y + 0.044715f * y * y * y);
    const float e = fast_exp2(2.0f * 1.4426950408889634f * z);
    const float th = 1.0f - 2.0f * fast_rcp(e + 1.0f);
    return 0.5f * y * (1.0f + th);
}
__device__ __forceinline__ float wave_sum(float v) {
#pragma unroll
    for (int o = 1; o < 64; o <<= 1) v += __shfl_xor(v, o);
    return v;
}

namespace pg8 {
constexpr int BM = 256, BK = 64, HALF = 128, HTB = HALF * BK * 2, STAGE_BYTES = 8 * HTB, NXCD = 8, WGM = 8;
__host__ __device__ __forceinline__ int lds_byte(int r, int c) { const int st = (r >> 4) * 2 + (c >> 5), rr = r & 15, cc = c & 31, ob = rr * 64 + cc * 2; return st * 1024 + (ob ^ (((ob >> 9) & 1) << 5)); }
__host__ __device__ __forceinline__ void stage_rc(int b, int& R, int& C) { const int st = b / 1024, sb = b % 1024, swz = sb ^ (((sb >> 9) & 1) << 5); R = (st >> 1) * 16 + swz / 64; C = (st & 1) * 32 + (swz % 64) / 2; }
__host__ __device__ __forceinline__ int perm32(int rho) { const int n = rho >> 4, i = rho & 15; return 8 * (i >> 2) + 4 * n + (i & 3); }

typedef int v4i_t __attribute__((ext_vector_type(4)));
typedef int v8i_t __attribute__((ext_vector_type(8)));
__device__ __forceinline__ v8i_t cat8(bf16x8 lo, bf16x8 hi) { return __builtin_shufflevector(__builtin_bit_cast(v4i_t, lo), __builtin_bit_cast(v4i_t, hi), 0, 1, 2, 3, 4, 5, 6, 7); }
__device__ __forceinline__ bf16x8 lo8(v8i_t v) { return __builtin_bit_cast(bf16x8, __builtin_shufflevector(v, v, 0, 1, 2, 3)); }
__device__ __forceinline__ bf16x8 hi8(v8i_t v) { return __builtin_bit_cast(bf16x8, __builtin_shufflevector(v, v, 4, 5, 6, 7)); }
struct Unit { int pm, pn, z, seg; };
struct Gemm { const bf16* A; const bf16* Bt; int M, N, K, lda, ldb, nz; size_t zA, zB; const bf16* A1; const bf16* Bt1; int M1, N1, nz1; size_t zA1, zB1; };

struct StaticOrder {
    int nM0, nN0, n0, nM1, nN1, ntot, G, c; int force = 0;
    __device__ void init(const Gemm& g, int G_, int c_) { nM0 = g.M / BM; nN0 = g.N / BM; n0 = nM0 * nN0 * g.nz; nM1 = g.M1 / BM; nN1 = g.N1 / BM; ntot = n0 + nM1 * nN1 * g.nz1; G = G_; c = c_; }
    __device__ bool next(int i, Unit& u) const {
        int L = i * G + c; if (L >= ntot) return false;
        const int seg = L >= n0 ? 1 : 0; if (seg) L -= n0;
        const int nM = seg ? nM1 : nM0, nN = seg ? nN1 : nN0, nwg = nM * nN;
        u.seg = seg; u.z = L / nwg;
        int wgid = L % nwg; { const int q = nwg / NXCD, r = nwg % NXCD, xcd = wgid % NXCD, off = wgid / NXCD; wgid = (xcd < r ? xcd * (q + 1) : r * (q + 1) + (xcd - r) * q) + off; }
        const int nig = WGM * nN, gid = wgid / nig, fm = gid * WGM, gsz = (nM - fm) < WGM ? (nM - fm) : WGM;
        u.pm = fm + ((wgid % nig) % gsz); u.pn = (wgid % nig) / gsz; if (force & 1) u.pm = 0; if (force & 2) u.pn = 0; return true;
    }
};

struct EpiBf16 {
    static constexpr bool PERM = true;
    bf16* O; int ldc; size_t zC; float scale; bf16* O1; int ldc1; size_t zC1; float scale1; int scale_a = 0, scale_w = 0; int fp8_1 = 0;
    __device__ __forceinline__ void operator()(const f32x4 (&acc)[2][2][4][2], const Unit& u, int wr, int wc, int fr, int fq) const {
        const int row0 = u.pm * BM + wr * 64 + fr; const int col0 = u.pn * BM + wc * 32 + 8 * fq;
        bf16* base = u.seg ? O1 + (size_t)u.z * zC1 : O + (size_t)u.z * zC; const int ldc = u.seg ? ldc1 : this->ldc; const float scale = u.seg ? scale1 : this->scale;
#pragma unroll
        for (int ai = 0; ai < 2; ++ai)
#pragma unroll
            for (int m = 0; m < 4; ++m) { bf16* rowp = base + (size_t)(row0 + ai * HALF + m * 16) * ldc + col0;
#pragma unroll
                for (int bj = 0; bj < 2; ++bj) { const f32x4 v0 = acc[ai][bj][m][0] * scale, v1 = acc[ai][bj][m][1] * scale;
                    if (u.seg && fp8_1) { u32x2 w8; w8.x = pk4_fp8(v0[0], v0[1], v0[2], v0[3]); w8.y = pk4_fp8(v1[0], v1[1], v1[2], v1[3]);
                        *(u32x2*)((unsigned char*)O1 + (size_t)u.z * zC1 + (size_t)(row0 + ai * HALF + m * 16) * ldc1 + col0 + bj * HALF) = w8; }
                    else { u32x4 w; w.x = pk2(v0[0], v0[1]); w.y = pk2(v0[2], v0[3]); w.z = pk2(v1[0], v1[1]); w.w = pk2(v1[2], v1[3]);
                    *(u32x4*)(rowp + bj * HALF) = w; } } }
    }
};
struct EpiSwiGLU {
    static constexpr bool PERM = true;
    unsigned char* O; int ldc; int scale_a, scale_w;
    __device__ __forceinline__ void operator()(const f32x4 (&acc)[2][2][4][2], const Unit& u, int wr, int wc, int fr, int fq) const {
        const int row0 = u.pm * BM + wr * 64 + fr; const int col0 = u.pn * HALF + wc * 32 + 8 * fq;
#pragma unroll
        for (int ai = 0; ai < 2; ++ai)
#pragma unroll
            for (int m = 0; m < 4; ++m) { unsigned char* rowp = O + (size_t)(row0 + ai * HALF + m * 16) * ldc + col0;
                const f32x4 g0 = acc[ai][0][m][0], g1 = acc[ai][0][m][1], u0 = acc[ai][1][m][0] * 8.0f, u1 = acc[ai][1][m][1] * 8.0f;
                u32x2 w; w.x = pk4_fp8(silu_f(g0[0]) * u0[0], silu_f(g0[1]) * u0[1], silu_f(g0[2]) * u0[2], silu_f(g0[3]) * u0[3]);
                w.y = pk4_fp8(silu_f(g1[0]) * u1[0], silu_f(g1[1]) * u1[1], silu_f(g1[2]) * u1[2], silu_f(g1[3]) * u1[3]);
                *(u32x2*)rowp = w; }
    }
};
struct EpiResid {
    static constexpr bool PERM = false;
    const float* hin; float* out; const float* gate; float coef; int scale_a, scale_w;
    __device__ __forceinline__ void operator()(const f32x4 (&acc)[2][2][4][2], const Unit& u, int wr, int wc, int fr, int fq) const {
        const int row0 = u.pm * BM + wr * 64 + fr; const int col0 = u.pn * BM + wc * 32 + 4 * fq;
        f32x4 gv[2][2];
#pragma unroll
        for (int bj = 0; bj < 2; ++bj)
#pragma unroll
            for (int n = 0; n < 2; ++n) gv[bj][n] = *(const f32x4*)(gate + col0 + bj * HALF + n * 16) * coef;
#pragma unroll
        for (int ai = 0; ai < 2; ++ai)
#pragma unroll
            for (int m = 0; m < 4; ++m) { const size_t off = (size_t)(row0 + ai * HALF + m * 16) * DM + col0;
#pragma unroll
                for (int bj = 0; bj < 2; ++bj)
#pragma unroll
                    for (int n = 0; n < 2; ++n) { const f32x4 b = *(const f32x4*)(hin + off + bj * HALF + n * 16);
                        *(f32x4*)(out + off + bj * HALF + n * 16) = b + gv[bj][n] * acc[ai][bj][m][n]; } }
    }
};
struct EpiGLU {
    static constexpr bool PERM = true;
    const bf16* yp; const float* bias; bf16* O; int ldc; int scale_a = 0, scale_w = 0;
    __device__ __forceinline__ void operator()(const f32x4 (&acc)[2][2][4][2], const Unit& u, int wr, int wc, int fr, int fq) const {
        const int row0 = u.pm * BM + wr * 64 + fr; const int col0 = u.pn * BM + wc * 32 + 8 * fq;
#pragma unroll
        for (int bj = 0; bj < 2; ++bj) { const f32x4 b0 = *(const f32x4*)(bias + col0 + bj * HALF), b1 = *(const f32x4*)(bias + col0 + bj * HALF + 4);
#pragma unroll
            for (int ai = 0; ai < 2; ++ai)
#pragma unroll
                for (int m = 0; m < 4; ++m) { const size_t r = (size_t)(row0 + ai * HALF + m * 16);
                    const u32x4 y = *(const u32x4*)(yp + r * 1024 + col0 + bj * HALF);
                    const f32x4 z0 = acc[ai][bj][m][0] + b0, z1 = acc[ai][bj][m][1] + b1;
#if FP8_MIXOUT
                    u32x2 w8; w8.x = pk4_fp8(8.f * bflo(y.x) * sigmoid_f(z0[0]), 8.f * bfhi(y.x) * sigmoid_f(z0[1]), 8.f * bflo(y.y) * sigmoid_f(z0[2]), 8.f * bfhi(y.y) * sigmoid_f(z0[3]));
                    w8.y = pk4_fp8(8.f * bflo(y.z) * sigmoid_f(z1[0]), 8.f * bfhi(y.z) * sigmoid_f(z1[1]), 8.f * bflo(y.w) * sigmoid_f(z1[2]), 8.f * bfhi(y.w) * sigmoid_f(z1[3]));
                    *(u32x2*)((unsigned char*)O + r * ldc + col0 + bj * HALF) = w8; } }
#else
                    u32x4 w; w.x = pk2(bflo(y.x) * sigmoid_f(z0[0]), bfhi(y.x) * sigmoid_f(z0[1])); w.y = pk2(bflo(y.y) * sigmoid_f(z0[2]), bfhi(y.y) * sigmoid_f(z0[3]));
                    w.z = pk2(bflo(y.z) * sigmoid_f(z1[0]), bfhi(y.z) * sigmoid_f(z1[1])); w.w = pk2(bflo(y.w) * sigmoid_f(z1[2]), bfhi(y.w) * sigmoid_f(z1[3]));
                    *(u32x4*)(O + r * ldc + col0 + bj * HALF) = w; } }
#endif
    }
};

template <class Epi, bool FP8 = false>
__device__ __forceinline__ void gemm_phase(LAS unsigned char* lds, const Gemm g, const StaticOrder& S, const Epi& E, int wave_s) {
    int lane_o = (int)__builtin_amdgcn_mbcnt_hi(~0u, __builtin_amdgcn_mbcnt_lo(~0u, 0u)); asm volatile("" : "+v"(lane_o));
    const int wid = wave_s, lane = lane_o, tid = wave_s * 64 + lane_o, wr = wid >> 2, wc = wid & 3, fr = lane & 15, fq = lane >> 4;
    const int K = g.K, nt = K / BK;
    unsigned voffA[2], voffB[2];
#pragma unroll
    for (int i = 0; i < 2; ++i) { int R, C; stage_rc(tid * 16 + i * 8192, R, C); const int Rb = Epi::PERM ? ((R & ~31) + perm32(R & 31)) : R;
        voffA[i] = (unsigned)(R * g.lda + C) * 2u; voffB[i] = (unsigned)(Rb * g.ldb + C) * 2u; }
    const size_t kstep = (size_t)(BK * 2);
    const size_t hstepA = (size_t)HALF * g.lda * 2, hstepB = (size_t)HALF * g.ldb * 2;
    const size_t tstepA = 2 * hstepA, tstepB = 2 * hstepB;
    const unsigned ldsw = (unsigned)wid * 1024u;
    const int aoff = lds_byte(wr * 64 + fr, fq * 8), boff = lds_byte(wc * 32 + fr, fq * 8);
#define PG8_SA(b, h) (((b) * 2 + (h)) * HTB)
#define PG8_SB(b, h) ((4 + (b) * 2 + (h)) * HTB)
#define PG8_STAGE(bufoff, gbase, voff) do { _Pragma("unroll") for (int _i = 0; _i < 2; ++_i) \
        __builtin_amdgcn_global_load_lds((const unsigned*)((const char*)(gbase) + (voff)[_i]), (LAS unsigned*)(lds + (bufoff) + ldsw + _i * 8192), 16, 0, 0); } while (0)
#define PG8_LDA(dst, b, h) do { _Pragma("unroll") for (int m = 0; m < 4; ++m) { const bf16x8 l_ = *(const LAS bf16x8*)(lds + PG8_SA(b, h) + aoff + m * 2048), h_ = *(const LAS bf16x8*)(lds + PG8_SA(b, h) + aoff + m * 2048 + 1024); dst[m] = cat8(l_, h_); } } while (0)
#define PG8_LDB(dst, b, h) do { _Pragma("unroll") for (int n = 0; n < 2; ++n) { const bf16x8 l_ = *(const LAS bf16x8*)(lds + PG8_SB(b, h) + boff + n * 2048), h_ = *(const LAS bf16x8*)(lds + PG8_SB(b, h) + boff + n * 2048 + 1024); dst[n] = cat8(l_, h_); } } while (0)
#define PG8_MMA(ai, bj, At, Bt) do { __builtin_amdgcn_s_setprio(1); _Pragma("unroll") for (int m = 0; m < 4; ++m) _Pragma("unroll") for (int n = 0; n < 2; ++n) { \
        if constexpr (FP8) asm volatile("v_mfma_scale_f32_16x16x128_f8f6f4 %0, %1, %2, %0, %3, %4 op_sel_hi:[0,0,0]" : "+v"(acc[ai][bj][m][n]) : "v"(Bt[n]), "v"(At[m]), "v"(sc_w), "v"(sc_a)); \
        else { acc[ai][bj][m][n] = __builtin_amdgcn_mfma_f32_16x16x32_bf16(lo8(Bt[n]), lo8(At[m]), acc[ai][bj][m][n], 0, 0, 0); acc[ai][bj][m][n] = __builtin_amdgcn_mfma_f32_16x16x32_bf16(hi8(Bt[n]), hi8(At[m]), acc[ai][bj][m][n], 0, 0, 0); } } __builtin_amdgcn_s_setprio(0); } while (0)
#define PG8_WAIT_V(n) asm volatile("s_waitcnt vmcnt(" #n ")" ::: "memory")
#define PG8_WAIT_L(n) asm volatile("s_waitcnt lgkmcnt(" #n ")" ::: "memory")
#define PG8_BAR __builtin_amdgcn_s_barrier()
#define PG8_SCHED __builtin_amdgcn_sched_barrier(0)
    Unit cur, nxt; int ui = 0;
    if (!S.next(0, cur)) return;
    f32x4 acc[2][2][4][2];
#pragma unroll
    for (int a = 0; a < 2; ++a)
#pragma unroll
        for (int b = 0; b < 2; ++b)
#pragma unroll
            for (int m = 0; m < 4; ++m)
#pragma unroll
                for (int n = 0; n < 2; ++n) acc[a][b][m][n] = (f32x4){0.f, 0.f, 0.f, 0.f};
    v8i_t At[4], B0[2], B1[2];
    int sc_w = E.scale_w, sc_a = E.scale_a;
#define PG8_ABASE(u) ((const char*)((u).seg ? g.A1 + (size_t)(u).z * g.zA1 : g.A + (size_t)(u).z * g.zA) + (size_t)(u).pm * tstepA)
#define PG8_BBASE(u) ((const char*)((u).seg ? g.Bt1 + (size_t)(u).z * g.zB1 : g.Bt + (size_t)(u).z * g.zB) + (size_t)(u).pn * tstepB)
    const char* cA = PG8_ABASE(cur); const char* cB = PG8_BBASE(cur);
    PG8_STAGE(PG8_SB(0, 0), cB, voffB); PG8_STAGE(PG8_SB(0, 1), cB + hstepB, voffB); PG8_STAGE(PG8_SA(0, 0), cA, voffA); PG8_STAGE(PG8_SA(0, 1), cA + hstepA, voffA);
    if (wr == 1) PG8_BAR;
    PG8_WAIT_V(2); PG8_BAR;
    PG8_STAGE(PG8_SB(1, 0), cB + kstep, voffB); PG8_STAGE(PG8_SA(1, 0), cA + kstep, voffA); PG8_STAGE(PG8_SB(1, 1), cB + hstepB + kstep, voffB);
    PG8_WAIT_V(6); PG8_BAR;
    for (;;) {
        const bool has_next = S.next(ui + 1, nxt);
        const char* nA = has_next ? PG8_ABASE(nxt) : cA; const char* nB = has_next ? PG8_BBASE(nxt) : cB;
        for (int t = 0; t < nt; t += 2) {
            const bool last = (t == nt - 2);
            const char* a1 = cA + (size_t)(t + 1) * kstep;
            const char* a2 = last ? nA : cA + (size_t)(t + 2) * kstep; const char* b2 = last ? nB : cB + (size_t)(t + 2) * kstep;
            const char* a3 = a2 + kstep; const char* b3 = b2 + kstep;
            PG8_LDB(B0, 0, 0); PG8_LDB(B1, 0, 1); PG8_SCHED; PG8_LDA(At, 0, 0); PG8_STAGE(PG8_SA(1, 1), a1 + hstepA, voffA);
            PG8_WAIT_V(8); PG8_WAIT_L(0); PG8_BAR; PG8_MMA(0, 0, At, B0); PG8_MMA(0, 1, At, B1); PG8_BAR; PG8_SCHED;
            PG8_LDA(At, 0, 1); PG8_STAGE(PG8_SB(0, 0), b2, voffB); PG8_STAGE(PG8_SB(0, 1), b2 + hstepB, voffB); PG8_STAGE(PG8_SA(0, 0), a2, voffA);
            PG8_WAIT_V(8); PG8_WAIT_L(0); PG8_BAR; PG8_MMA(1, 0, At, B0); PG8_MMA(1, 1, At, B1); PG8_BAR; PG8_SCHED;
            PG8_LDB(B0, 1, 0); PG8_LDB(B1, 1, 1); PG8_SCHED; PG8_LDA(At, 1, 0); PG8_STAGE(PG8_SA(0, 1), a2 + hstepA, voffA);
            PG8_WAIT_V(8); PG8_WAIT_L(0); PG8_BAR; PG8_MMA(0, 0, At, B0); PG8_MMA(0, 1, At, B1); PG8_BAR; PG8_SCHED;
            PG8_LDA(At, 1, 1); PG8_STAGE(PG8_SB(1, 0), b3, voffB); PG8_STAGE(PG8_SB(1, 1), b3 + hstepB, voffB); PG8_STAGE(PG8_SA(1, 0), a3, voffA);
            PG8_WAIT_V(8); PG8_WAIT_L(0); PG8_BAR; PG8_MMA(1, 0, At, B0); PG8_MMA(1, 1, At, B1); PG8_BAR; PG8_SCHED;
        }
        if (wr == 0) PG8_BAR;
        if constexpr (FP8) asm volatile("s_nop 15\n\ts_nop 15" ::: "memory");
        E(acc, cur, wr, wc, fr, fq);
        if (!has_next) break;
#pragma unroll
        for (int a = 0; a < 2; ++a)
#pragma unroll
            for (int b = 0; b < 2; ++b)
#pragma unroll
                for (int m = 0; m < 4; ++m)
#pragma unroll
                    for (int n = 0; n < 2; ++n) acc[a][b][m][n] = (f32x4){0.f, 0.f, 0.f, 0.f};
        cur = nxt; cA = nA; cB = nB; ++ui;
        if (wr == 1) PG8_BAR;
    }
    PG8_WAIT_V(0);
    PG8_BAR;
#undef PG8_ABASE
#undef PG8_BBASE
#undef PG8_SA
#undef PG8_SB
#undef PG8_STAGE
#undef PG8_LDA
#undef PG8_LDB
#undef PG8_MMA
#undef PG8_WAIT_V
#undef PG8_WAIT_L
#undef PG8_BAR
#undef PG8_SCHED
}
}

#define XB_TMO      128
#define XB_XCNT(j)  (256  + 64 * (j))
#define XB_XSUB(j)  (1280 + 64 * (j))
#define XB_XGEN(j)  (2304 + 64 * (j))
#define XB_TOP      3328
#define XB_TOPGEN   3392
#define XCD_BAR_WORDS 3456
#define XB_SPIN_CAP (1u << 18)
__device__ __forceinline__ unsigned xb_ld(unsigned* p)              { return __hip_atomic_load(p, __ATOMIC_RELAXED, __HIP_MEMORY_SCOPE_AGENT); }
__device__ __forceinline__ unsigned xb_add(unsigned* p, unsigned v) { return __hip_atomic_fetch_add(p, v, __ATOMIC_RELAXED, __HIP_MEMORY_SCOPE_AGENT); }
__device__ __forceinline__ unsigned xb_xcc_id() { return (unsigned)__builtin_amdgcn_s_getreg((3 << 11) | 20) & 0xFu; }
#define XB_SPIN(cond, bar) do { unsigned _sp = 0; while (cond) { __builtin_amdgcn_s_sleep(1); \
    if ((++_sp & 255u) == 0u) { if (xb_ld(&(bar)[XB_TMO])) break; if (_sp > XB_SPIN_CAP) { atomicAdd(&(bar)[XB_TMO], 1u); break; } } } } while (0)
struct XcdBarrier { unsigned* bar; unsigned x; volatile LAS unsigned* st; int wave; };
__device__ __forceinline__ XcdBarrier xcd_barrier_post(unsigned* bar, volatile LAS unsigned* st) {
    XcdBarrier b; b.bar = bar; b.x = xb_xcc_id(); b.st = st;
    if (threadIdx.x == 0) (void)xb_add(&bar[XB_XCNT(b.x)], 1u);
    return b;
}
__device__ __forceinline__ void xcd_barrier_complete(unsigned* bar, unsigned x, unsigned& nloc, unsigned& nx) {
    const unsigned G = gridDim.x * gridDim.y * gridDim.z;
    unsigned sum, cnt, mine, sp = 0u;
    for (;;) {
        sum = 0u; cnt = 0u; mine = 0u;
#pragma unroll
        for (unsigned j = 0; j < 16; ++j) { const unsigned c = xb_ld(&bar[XB_XCNT(j)]); sum += c; cnt += (c > 0u) ? 1u : 0u; mine = (j == x) ? c : mine; }
        if (sum == G) break;
        __builtin_amdgcn_s_sleep(1);
        if ((++sp & 255u) == 0u) { if (xb_ld(&bar[XB_TMO])) break; if (sp > XB_SPIN_CAP) { atomicAdd(&bar[XB_TMO], 1u); break; } }
    }
    nloc = mine > 0u ? mine : 1u; nx = cnt > 0u ? cnt : 1u;
}
__device__ __forceinline__ void xcd_barrier(const XcdBarrier& b) {
    asm volatile("s_waitcnt vmcnt(0)" ::: "memory");
    __syncthreads();
    if (b.wave == 0 && __builtin_amdgcn_mbcnt_hi(~0u, __builtin_amdgcn_mbcnt_lo(~0u, 0u)) == 0u) {
        unsigned* bar = b.bar;
        __builtin_amdgcn_s_waitcnt(0);
        unsigned nloc = b.st[0], nx = b.st[1];
        if (nloc == 0u) { xcd_barrier_complete(bar, b.x, nloc, nx); b.st[0] = nloc; b.st[1] = nx; }
        const unsigned old = xb_add(&bar[XB_XSUB(b.x)], 1u);
        const unsigned gen = old / nloc;
        if (old + 1u == (gen + 1u) * nloc) {
            __builtin_amdgcn_fence(__ATOMIC_RELEASE, "agent");
            asm volatile("s_waitcnt vmcnt(0)" ::: "memory");
            const unsigned og = xb_add(&bar[XB_TOP], 1u);
            const unsigned tg = og / nx;
            if (og + 1u == (tg + 1u) * nx) xb_add(&bar[XB_TOPGEN], 1u);
            else XB_SPIN(xb_ld(&bar[XB_TOPGEN]) == tg, bar);
            __builtin_amdgcn_fence(__ATOMIC_ACQUIRE, "agent");
            xb_add(&bar[XB_XGEN(b.x)], 1u);
            asm volatile("s_waitcnt vmcnt(0)" ::: "memory");
        } else {
            XB_SPIN(xb_ld(&bar[XB_XGEN(b.x)]) == gen, bar);
            __builtin_amdgcn_fence(__ATOMIC_ACQUIRE, "agent");
            asm volatile("s_waitcnt vmcnt(0)" ::: "memory");
        }
    }
    __syncthreads();
}

#ifndef DSA_XREP
#define DSA_XREP 0
#define DSA_XF 0
#endif
#ifndef DSA_REP_P1
#define DSA_REP_P1 1
#endif
#ifndef DSA_REP_P2
#define DSA_REP_P2 1
#endif
#ifndef DSA_REP_ATT
#define DSA_REP_ATT 1
#endif
__device__ __forceinline__ int opaque_int(int n) { asm volatile("" : "+s"(n)); return n; }
__device__ __forceinline__ int ph_reps(int k) { int n = ((REP_MASK >> k) & 1u) ? REP_N : 1; asm volatile("" : "+s"(n)); return n; }
struct Args { const float* in[26]; float* out; unsigned char* ws; int ph_lo, ph_hi; };
enum { I_X = 0, I_C, I_ADAW, I_ADAB, I_NORMG, I_WG, I_WU, I_WDN, I_ABWIN, I_LRE, I_LIM, I_LOGDT, I_BRE, I_BIM, I_CRE, I_CIM, I_S5D, I_WGLU, I_BGLU, I_KVG, I_WKVUP, I_ABWOUT,
       I_CWQKV, I_RELB, I_CWOUT, I_FING };

__device__ __forceinline__ void tr_item(const float* src, int ldsrc, int nvalid, int k0, int n0, bf16* dst, int lddst, LAS float* scr, int lane) {
    const int nn = n0 + (lane & 31); const bool ok = nn < nvalid;
#pragma unroll 8
    for (int i = 0; i < 32; ++i) { const int kk = 2 * i + (lane >> 5); scr[kk * 33 + (lane & 31)] = ok ? src[(size_t)(k0 + kk) * ldsrc + nn] : 0.f; }
    LDS_WAIT(); asm volatile("" ::: "memory");
    const int c = lane & 7;
#pragma unroll
    for (int j = 0; j < 4; ++j) { const int n = (lane >> 3) + 8 * j; const LAS float* s = scr + (8 * c) * 33 + n;
        u32x4 o; o.x = pk2(s[0 * 33], s[1 * 33]); o.y = pk2(s[2 * 33], s[3 * 33]); o.z = pk2(s[4 * 33], s[5 * 33]); o.w = pk2(s[6 * 33], s[7 * 33]);
        if (n0 + n < nvalid) *(u32x4*)(dst + (size_t)n * lddst + 8 * c) = o; }
    LDS_WAIT(); asm volatile("" ::: "memory");
}

__device__ __forceinline__ void tr_item8(const float* src, int ldsrc, int k0, int n0, unsigned char* dst, int lddst, float scale, LAS float* scr, int lane) {
    const int nn = n0 + (lane & 31);
#pragma unroll 8
    for (int i = 0; i < 32; ++i) { const int kk = 2 * i + (lane >> 5); scr[kk * 33 + (lane & 31)] = src[(size_t)(k0 + kk) * ldsrc + nn] * scale; }
    LDS_WAIT(); asm volatile("" ::: "memory");
    const int n = lane & 31, kh = lane >> 5; const LAS float* sp = scr + (32 * kh) * 33 + n;
    u32x4 o0, o1;
    o0.x = pk4_fp8(sp[0 * 33], sp[1 * 33], sp[2 * 33], sp[3 * 33]); o0.y = pk4_fp8(sp[4 * 33], sp[5 * 33], sp[6 * 33], sp[7 * 33]);
    o0.z = pk4_fp8(sp[8 * 33], sp[9 * 33], sp[10 * 33], sp[11 * 33]); o0.w = pk4_fp8(sp[12 * 33], sp[13 * 33], sp[14 * 33], sp[15 * 33]);
    o1.x = pk4_fp8(sp[16 * 33], sp[17 * 33], sp[18 * 33], sp[19 * 33]); o1.y = pk4_fp8(sp[20 * 33], sp[21 * 33], sp[22 * 33], sp[23 * 33]);
    o1.z = pk4_fp8(sp[24 * 33], sp[25 * 33], sp[26 * 33], sp[27 * 33]); o1.w = pk4_fp8(sp[28 * 33], sp[29 * 33], sp[30 * 33], sp[31 * 33]);
    unsigned char* d = dst + (size_t)n * lddst + 32 * kh;
    *(u32x4*)d = o0; *(u32x4*)(d + 16) = o1;
    LDS_WAIT(); asm volatile("" ::: "memory");
}

template <bool FP8>
__device__ __forceinline__ void tr_item64(const float* src, int ldsrc, int k0, int n0, void* dst, int lddst, float scale, LAS float* scr, int lane) {
    const float* sp = src + (size_t)(k0 + (lane >> 4)) * ldsrc + n0 + 4 * (lane & 15);
    f32x4 v[16];
#pragma unroll
    for (int i = 0; i < 16; ++i) v[i] = *(const f32x4*)(sp + (size_t)(4 * i) * ldsrc);
#pragma unroll
    for (int i = 0; i < 16; ++i) { LAS float* w = scr + (4 * i + (lane >> 4)) * 65 + 4 * (lane & 15); w[0] = v[i].x * scale; w[1] = v[i].y * scale; w[2] = v[i].z * scale; w[3] = v[i].w * scale; }
    LDS_WAIT(); asm volatile("" ::: "memory");
    if (FP8) {
        const int c = lane & 3;
#pragma unroll
        for (int j = 0; j < 4; ++j) { const int n = 16 * j + (lane >> 2); const LAS float* r = scr + (16 * c) * 65 + n;
            u32x4 o; o.x = pk4_fp8(r[0], r[65], r[130], r[195]); o.y = pk4_fp8(r[260], r[325], r[390], r[455]); o.z = pk4_fp8(r[520], r[585], r[650], r[715]); o.w = pk4_fp8(r[780], r[845], r[910], r[975]);
            *(u32x4*)((unsigned char*)dst + (size_t)n * lddst + 16 * c) = o; }
    } else {
        const int c = lane & 7;
#pragma unroll
        for (int j = 0; j < 8; ++j) { const int n = 8 * j + (lane >> 3); const LAS float* r = scr + (8 * c) * 65 + n;
            u32x4 o; o.x = pk2(r[0], r[65]); o.y = pk2(r[130], r[195]); o.z = pk2(r[260], r[325]); o.w = pk2(r[390], r[455]);
            *(u32x4*)((bf16*)dst + (size_t)n * lddst + 8 * c) = o; }
    }
    LDS_WAIT(); asm volatile("" ::: "memory");
}

constexpr int CI_NFFN = 4 * 3 * 2752, CI_NIN = 32 * 107, CI_NGLU = 16 * 16, CI_NOUT = 32 * 32, CI_NQKV = 32 * 96, CI_NCO = 32 * 32;
constexpr int CI_IN = CI_NFFN, CI_GLU = CI_IN + CI_NIN, CI_OUT = CI_GLU + CI_NGLU, CI_QKV = CI_OUT + CI_NOUT, CI_CO = CI_QKV + CI_NQKV, CI_END = CI_CO + CI_NCO;
#define CI_FFN(f) ((f) * 8256)
__device__ __forceinline__ void conv_item(const Args& a, int it, LAS float* scr, int lane) {
    unsigned char* ws = a.ws;
    unsigned char* Wgu = ws + WS_WGU; unsigned char* Wd = ws + WS_WD; bf16* Win = (bf16*)(ws + WS_WIN); bf16* Wglu = (bf16*)(ws + WS_WGLU);
    bf16* Wout = (bf16*)(ws + WS_WOUT); bf16* Woutb = (bf16*)(ws + WS_WOUTB); bf16* Wqkv = (bf16*)(ws + WS_WQKV); bf16* Wcout = (bf16*)(ws + WS_WCOUT);
    constexpr int I_FFN = CI_NFFN, I_IN = CI_NIN, I_GLU = CI_NGLU, I_OUT = CI_NOUT, I_QKV = CI_NQKV;
    do {
        int r = it;
        if (r < I_FFN) {
            const int f = r / 8256, rr = r % 8256, which = rr / 2752, q = rr % 2752;
            if (which < 2) { const int kb = q / 86, nb = q % 86, n0 = 64 * nb, k0 = 64 * kb;
                const float* src = a.in[which ? I_WU : I_WG] + (size_t)f * DM * FF;
                const int row = 256 * (n0 / 128) + (n0 % 128) + 128 * which;
                tr_item64<true>(src, FF, k0, n0, Wgu + (size_t)f * NGU * DM + (size_t)row * DM + k0, DM, 64.0f, scr, lane);
            } else { const int kb = q / 32, nb = q % 32, n0 = 64 * nb, k0 = 64 * kb;
                const float* src = a.in[I_WDN] + (size_t)f * FF * DM;
                tr_item64<true>(src, DM, k0, n0, Wd + (size_t)f * DM * FFP + (size_t)n0 * FFP + k0, FFP, 128.0f, scr, lane); }
            break; }
        r -= I_FFN;
        if (r < I_IN) { const int kb = r / 107, nb = r % 107, n0 = 32 * nb, k0 = 64 * kb;
            if (n0 >= 1024 && n0 < 2048) break;
            const int row = n0 + (n0 >= 2048 ? 1024 : 0);
            tr_item(a.in[I_ABWIN], 3408, 3408, k0, n0, Win + (size_t)row * DM + k0, DM, scr, lane); break; }
        r -= I_IN;
        if (r < I_GLU) { const int kb = r / 16, nb = r % 16, n0 = 64 * nb, k0 = 64 * kb;
            tr_item64<false>(a.in[I_WGLU], 1024, k0, n0, Wglu + (size_t)n0 * 1024 + k0, 1024, 1.0f, scr, lane); break; }
        r -= I_GLU;
        if (r < I_OUT) { const int kb = r / 32, nb = r % 32, n0 = 64 * nb, k0 = 64 * kb;
#if FP8_MIXOUT
            if (k0 < 1024) tr_item64<true>(a.in[I_ABWOUT], DM, k0, n0, (unsigned char*)Wout + (size_t)n0 * NCAT + k0, NCAT, 64.0f, scr, lane);
#else
            if (k0 < 1024) tr_item64<false>(a.in[I_ABWOUT], DM, k0, n0, Wout + (size_t)n0 * NCAT + k0, NCAT, 1.0f, scr, lane);
#endif
            else           tr_item64<false>(a.in[I_ABWOUT], DM, k0, n0, Woutb + (size_t)n0 * DM + k0, DM, 1.0f, scr, lane);
            break; }
        r -= I_OUT;
        if (r < I_QKV) { const int kb = r / 96, nb = r % 96, n0 = 64 * nb, k0 = 64 * kb;
#if FP8_QKV
            tr_item64<true>(a.in[I_CWQKV], 6144, k0, n0, (unsigned char*)Wqkv + (size_t)n0 * DM + k0, DM, 64.0f, scr, lane); break; }
#else
            tr_item64<false>(a.in[I_CWQKV], 6144, k0, n0, Wqkv + (size_t)n0 * DM + k0, DM, 1.0f, scr, lane); break; }
#endif
        r -= I_QKV;
        { const int kb = r / 32, nb = r % 32, n0 = 64 * nb, k0 = 64 * kb;
#if FP8_MIXOUT
            tr_item64<true>(a.in[I_CWOUT], DM, k0, n0, (unsigned char*)Wcout + (size_t)n0 * DM + k0, DM, 64.0f, scr, lane); }
#else
            tr_item64<false>(a.in[I_CWOUT], DM, k0, n0, Wcout + (size_t)n0 * DM + k0, DM, 1.0f, scr, lane); }
#endif
    } while (0);
}
template <int L0, int N0, int L1 = 0, int N1 = 0, int L2 = 0, int N2 = 0, int L3 = 0, int N3 = 0>
__device__ __forceinline__ void conv_ranges(const Args& a, LAS unsigned char* lds, int wkr, int nwkr, int wave, int lane) {
    LAS float* scr = (LAS float*)(lds + wave * 16640);
    constexpr int tot = N0 + N1 + N2 + N3;
    for (int v = wkr; v < tot; v += nwkr) {
        int it;
        if (v < N0) it = L0 + v; else if (v < N0 + N1) it = L1 + (v - N0); else if (v < N0 + N1 + N2) it = L2 + (v - N0 - N1); else it = L3 + (v - N0 - N1 - N2);
        conv_item(a, it, scr, lane); }
}
template <int L0, int N0, int L1 = 0, int N1 = 0, int L2 = 0, int N2 = 0, int L3 = 0, int N3 = 0>
__device__ __forceinline__ void conv_fill(const Args& a, LAS unsigned char* lds, int G, int ntot, int wave_s) {
    const int rem = ntot % G;
    if (rem == 0 || (int)blockIdx.x < rem) return;
    int lane_o = (int)__builtin_amdgcn_mbcnt_hi(~0u, __builtin_amdgcn_mbcnt_lo(~0u, 0u)); asm volatile("" : "+v"(lane_o));
    conv_ranges<L0, N0, L1, N1, L2, N2, L3, N3>(a, lds, ((int)blockIdx.x - rem) * NWAVES + wave_s, (G - rem) * NWAVES, wave_s, lane_o);
}

__device__ __forceinline__ void p0_prologue(const Args& a, LAS unsigned char* lds, int G, int wave_s) {
    int lane_o = (int)__builtin_amdgcn_mbcnt_hi(~0u, __builtin_amdgcn_mbcnt_lo(~0u, 0u)); asm volatile("" : "+v"(lane_o)); const int lane = lane_o, wave = wave_s, tid_o = wave_s * 64 + lane_o;
    unsigned char* ws = a.ws;
    const int tid = tid_o;
    {
        LAS float* cond = (LAS float*)(lds + 131072); LAS float* red = (LAS float*)(lds + 131072 + 8192);
        for (int k = tid; k < DM; k += NTHR) cond[k] = silu_f(a.in[I_C][k]);
        __syncthreads();
        float* mod = (float*)(ws + WS_MOD);
        for (int u = blockIdx.x; u < 144; u += G) {
            const int layer = u / 72, col0 = (u % 72) * 256 + 4 * lane;
            const float* w = a.in[I_ADAW] + (size_t)layer * DM * NMOD + (size_t)(wave * 256) * NMOD + col0;
            f32x4 s4 = (f32x4){0.f, 0.f, 0.f, 0.f};
#pragma unroll 16
            for (int k = 0; k < 256; ++k) { const f32x4 v = *(const f32x4*)(w + (size_t)k * NMOD); s4 += v * cond[wave * 256 + k]; }
            *(LAS f32x4*)(red + wave * 256 + 4 * lane) = s4;
            __syncthreads();
            if (tid < 256) { float s = 0.f;
#pragma unroll
                for (int w8 = 0; w8 < 8; ++w8) s += red[w8 * 256 + tid];
                const int n = (u % 72) * 256 + tid; mod[layer * NMOD + n] = s + a.in[I_ADAB][layer * NMOD + n]; }
            __syncthreads();
        }
    }
    conv_ranges<CI_FFN(0), 5504, CI_OUT + 512, 512>(a, lds, blockIdx.x * NWAVES + wave, G * NWAVES, wave, lane);
    {
        const int gt = blockIdx.x * NTHR + tid, NGT = G * NTHR;
        bf16* Wqraw = (bf16*)(ws + WS_WQRAW); bf16* Wupraw = (bf16*)(ws + WS_WUPRAW); bf16* Win = (bf16*)(ws + WS_WIN); unsigned char* Wd = ws + WS_WD;
        for (int i = gt; i < 2048 * 256; i += NGT) { const int k = i >> 8, d4 = (i & 255) * 4; const f32x4 v = *(const f32x4*)(a.in[I_ABWIN] + (size_t)k * 3408 + 1024 + d4);
            u32x2 o; o.x = pk2(v.x, v.y); o.y = pk2(v.z, v.w); *(u32x2*)(Wqraw + (size_t)k * DM + d4) = o; }
        for (int i = gt; i < 256 * 512; i += NGT) { const f32x4 v = *(const f32x4*)(a.in[I_WKVUP] + (size_t)i * 4);
            u32x2 o; o.x = pk2(v.x, v.y); o.y = pk2(v.z, v.w); *(u32x2*)(Wupraw + (size_t)i * 4) = o; }
        for (int i = gt; i < (NIN - 4432) * DM / 8; i += NGT) *(u32x4*)(Win + (size_t)4432 * DM + (size_t)i * 8) = (u32x4){0u, 0u, 0u, 0u};
        for (int i = gt; i < 4 * DM * 8; i += NGT) *(u32x4*)(Wd + (size_t)(i >> 3) * FFP + FF + 16 * (i & 7)) = (u32x4){0u, 0u, 0u, 0u};
        for (int i = gt; i < SEQ * 8; i += NGT) *(u32x4*)(ws + WS_HMID + (size_t)(i >> 3) * FFP + FF + 16 * (i & 7)) = (u32x4){0u, 0u, 0u, 0u};
        if (gt < 4096) { const int g = gt >> 6;
            const double dt = exp((double)a.in[I_LOGDT][g]); const double lr = a.in[I_LRE][gt], li = a.in[I_LIM][gt];
            const double mag = exp(lr * dt), ar = mag * cos(li * dt), ai = mag * sin(li * dt);
            const double den = lr * lr + li * li, nr = ar - 1.0, fre = (nr * lr + ai * li) / den, fim = (ai * lr - nr * li) / den;
            const double m64 = exp(64.0 * lr * dt), a64r = m64 * cos(64.0 * li * dt), a64i = m64 * sin(64.0 * li * dt);
            float* T = (float*)(ws + WS_S5T);
            T[S5_AR + gt] = (float)ar; T[S5_AI + gt] = (float)ai; T[S5_A64R + gt] = (float)a64r; T[S5_A64I + gt] = (float)a64i;
            for (int c = 0; c < 16; ++c) { const double br = a.in[I_BRE][gt * 16 + c], bi = a.in[I_BIM][gt * 16 + c];
                T[S5_BBR + gt * 16 + c] = (float)(fre * br - fim * bi); T[S5_BBI + gt * 16 + c] = (float)(fre * bi + fim * br); }
        }
    }
}

template <bool FINAL, bool OUT8 = false>
__device__ __forceinline__ void norm_phase(const float* hin, const float* gvec, const float* shift, const float* scale, bf16* hn, float* fout, int G, int wave_s) {
    int lane_o = (int)__builtin_amdgcn_mbcnt_hi(~0u, __builtin_amdgcn_mbcnt_lo(~0u, 0u)); asm volatile("" : "+v"(lane_o)); const int lane = lane_o, wave = wave_s, tid_o = wave_s * 64 + lane_o;
    const int gw = blockIdx.x * NWAVES + wave, NGW = G * NWAVES;
    f32x4 gs[8], sh[8];
#pragma unroll
    for (int j = 0; j < 8; ++j) { const int c = 4 * lane + 256 * j; const f32x4 gg = *(const f32x4*)(gvec + c);
        if (FINAL) { gs[j] = gg; sh[j] = (f32x4){0.f, 0.f, 0.f, 0.f}; }
        else { const f32x4 sc = *(const f32x4*)(scale + c); gs[j] = gg * (sc + 1.0f); sh[j] = *(const f32x4*)(shift + c); } }
    for (int m = gw; m < SEQ; m += NGW) {
        const f32x4* xr = (const f32x4*)(hin + (size_t)m * DM) + lane;
        f32x4 v[8]; float s = 0.f;
#pragma unroll
        for (int j = 0; j < 8; ++j) { v[j] = xr[64 * j]; s += (v[j].x * v[j].x + v[j].y * v[j].y) + (v[j].z * v[j].z + v[j].w * v[j].w); }
        const float rstd = 1.0f / sqrtf(wave_sum(s) * (1.0f / DM) + 1e-6f);
        if (FINAL) { f32x4* o = (f32x4*)(fout + (size_t)m * DM) + lane;
#pragma unroll
            for (int j = 0; j < 8; ++j) o[64 * j] = v[j] * rstd * gs[j];
        } else if (OUT8) { unsigned* o = (unsigned*)((unsigned char*)hn + (size_t)m * DM) + lane;
#pragma unroll
            for (int j = 0; j < 8; ++j) { const f32x4 y = (v[j] * rstd * gs[j] + sh[j]) * 8.0f; o[64 * j] = pk4_fp8(y.x, y.y, y.z, y.w); }
        } else { u32x2* o = (u32x2*)(hn + (size_t)m * DM) + lane;
#pragma unroll
            for (int j = 0; j < 8; ++j) { const f32x4 y = v[j] * rstd * gs[j] + sh[j]; u32x2 w; w.x = pk2(y.x, y.y); w.y = pk2(y.z, y.w); o[64 * j] = w; } }
    }
}

__device__ __forceinline__ void s5_stage_u(const bf16* proj, int g, int j, LAS float* ut, int lane) {
    const u32x4* p = (const u32x4*)(proj + (size_t)(64 * j + lane) * NIN + C_U + 16 * g);
    const u32x4 a = p[0], b = p[1];
    LAS f32x4* o = (LAS f32x4*)(ut + lane * 16);
    o[0] = (f32x4){bflo(a.x), bfhi(a.x), bflo(a.y), bfhi(a.y)}; o[1] = (f32x4){bflo(a.z), bfhi(a.z), bflo(a.w), bfhi(a.w)};
    o[2] = (f32x4){bflo(b.x), bfhi(b.x), bflo(b.y), bfhi(b.y)}; o[3] = (f32x4){bflo(b.z), bfhi(b.z), bflo(b.w), bfhi(b.w)};
    LDS_WAIT(); asm volatile("" ::: "memory");
}
__device__ __forceinline__ void phase_a2(const Args& a, LAS unsigned char* lds, int G, int wave_s) {
    int lane_o = (int)__builtin_amdgcn_mbcnt_hi(~0u, __builtin_amdgcn_mbcnt_lo(~0u, 0u)); asm volatile("" : "+v"(lane_o)); const int lane = lane_o, wave = wave_s, tid_o = wave_s * 64 + lane_o;
    unsigned char* ws = a.ws; const bf16* proj = (const bf16*)(ws + WS_PROJ);
    const int gw = blockIdx.x * NWAVES + wave, NGW = G * NWAVES;
    { bf16* kvn = (bf16*)(ws + WS_KVN); const f32x4 gg = *(const f32x4*)(a.in[I_KVG] + 4 * lane);
      for (int m = gw; m < SEQ; m += NGW) { const u32x2 w = *(const u32x2*)(proj + (size_t)m * NIN + C_KVL + 4 * lane);
          const f32x4 v = (f32x4){bflo(w.x), bfhi(w.x), bflo(w.y), bfhi(w.y)};
          const float s = wave_sum((v.x * v.x + v.y * v.y) + (v.z * v.z + v.w * v.w)); const float rstd = 1.0f / sqrtf(s * (1.0f / 256.0f) + 1e-6f);
          const f32x4 y = v * rstd * gg; u32x2 o; o.x = pk2(y.x, y.y); o.y = pk2(y.z, y.w); *(u32x2*)(kvn + (size_t)m * 256 + 4 * lane) = o; } }
    const float* T = (const float*)(ws + WS_S5T); float* E = (float*)(ws + WS_E);
    LAS float* ut = (LAS float*)(lds + wave * 8192);
    for (int u = gw; u < 64 * 128; u += NGW) { const int g = u & 63, j = u >> 6, sp = g * 64 + lane;
        s5_stage_u(proj, g, j, ut, lane);
        const float ar = T[S5_AR + sp], ai = T[S5_AI + sp];
        float bbr[16], bbi[16];
#pragma unroll
        for (int c4 = 0; c4 < 4; ++c4) { const f32x4 r = *(const f32x4*)(T + S5_BBR + sp * 16 + 4 * c4), i = *(const f32x4*)(T + S5_BBI + sp * 16 + 4 * c4);
            bbr[4 * c4] = r.x; bbr[4 * c4 + 1] = r.y; bbr[4 * c4 + 2] = r.z; bbr[4 * c4 + 3] = r.w; bbi[4 * c4] = i.x; bbi[4 * c4 + 1] = i.y; bbi[4 * c4 + 2] = i.z; bbi[4 * c4 + 3] = i.w; }
        float xr = 0.f, xi = 0.f;
        for (int t = 0; t < 64; ++t) { const LAS f32x4* up = (const LAS f32x4*)(ut + t * 16); float bur = 0.f, bui = 0.f;
#pragma unroll
            for (int c4 = 0; c4 < 4; ++c4) { const f32x4 uv = up[c4];
                bur += bbr[4 * c4] * uv.x + bbr[4 * c4 + 1] * uv.y + bbr[4 * c4 + 2] * uv.z + bbr[4 * c4 + 3] * uv.w;
                bui += bbi[4 * c4] * uv.x + bbi[4 * c4 + 1] * uv.y + bbi[4 * c4 + 2] * uv.z + bbi[4 * c4 + 3] * uv.w; }
            const float nr = ar * xr - ai * xi + bur, ni = ar * xi + ai * xr + bui; xr = nr; xi = ni; }
        E[(size_t)(g * 128 + j) * 64 + lane] = xr; E[(size_t)(64 * 128 * 64) + (size_t)(g * 128 + j) * 64 + lane] = xi;
        LDS_WAIT(); asm volatile("" ::: "memory");
    }
}

__device__ __forceinline__ void s5_scan_out(const Args& a, LAS unsigned char* lds, int G, int wave_s) {
    int lane_o = (int)__builtin_amdgcn_mbcnt_hi(~0u, __builtin_amdgcn_mbcnt_lo(~0u, 0u)); asm volatile("" : "+v"(lane_o)); const int lane = lane_o, wave = wave_s, tid_o = wave_s * 64 + lane_o;
    unsigned char* ws = a.ws; const bf16* proj = (const bf16*)(ws + WS_PROJ);
    const int gw = blockIdx.x * NWAVES + wave, NGW = G * NWAVES;
    const float* T = (const float*)(ws + WS_S5T); const float* E = (const float*)(ws + WS_E); bf16* yap = (bf16*)(ws + WS_YAPRE);
    LAS float* ut = (LAS float*)(lds + wave * 16384);
    LAS unsigned char* X = lds + wave * 16384 + 4096;
    const int fr = lane & 15, fq = lane >> 4;
    for (int wu = gw; wu < 2048; wu += NGW) { const int g = wu & 63, jb = (wu >> 6) * 4, sp = g * 64 + lane;
        const float ar = T[S5_AR + sp], ai = T[S5_AI + sp], a64r = T[S5_A64R + sp], a64i = T[S5_A64I + sp];
        float bbr[16], bbi[16];
#pragma unroll
        for (int c4 = 0; c4 < 4; ++c4) { const f32x4 r = *(const f32x4*)(T + S5_BBR + sp * 16 + 4 * c4), i = *(const f32x4*)(T + S5_BBI + sp * 16 + 4 * c4);
            bbr[4 * c4] = r.x; bbr[4 * c4 + 1] = r.y; bbr[4 * c4 + 2] = r.z; bbr[4 * c4 + 3] = r.w; bbi[4 * c4] = i.x; bbi[4 * c4 + 1] = i.y; bbi[4 * c4 + 2] = i.z; bbi[4 * c4 + 3] = i.w; }
        bf16x8 cf[4];
#pragma unroll
        for (int ks = 0; ks < 4; ++ks) { const int k0 = 32 * ks + 8 * fq; const bool im = k0 >= 64; const float* src = a.in[im ? I_CIM : I_CRE] + (size_t)(g * 16 + fr) * 64 + (k0 & 63);
            const f32x4 v0 = *(const f32x4*)src, v1 = *(const f32x4*)(src + 4); const float sg = im ? -1.f : 1.f;
            u32x4 w; w.x = pk2(sg * v0.x, sg * v0.y); w.y = pk2(sg * v0.z, sg * v0.w); w.z = pk2(sg * v1.x, sg * v1.y); w.w = pk2(sg * v1.z, sg * v1.w);
            cf[ks] = __builtin_bit_cast(bf16x8, w); }
        const float dsk = a.in[I_S5D][g * 16 + fr];
        float xr = 0.f, xi = 0.f;
        for (int i = 0; i < jb; i += 4) { float er[4], ei[4];
#pragma unroll
            for (int q = 0; q < 4; ++q) { er[q] = E[(size_t)(g * 128 + i + q) * 64 + lane]; ei[q] = E[(size_t)(64 * 128 * 64) + (size_t)(g * 128 + i + q) * 64 + lane]; }
#pragma unroll
            for (int q = 0; q < 4; ++q) { const float nr = a64r * xr - a64i * xi + er[q], ni = a64r * xi + a64i * xr + ei[q]; xr = nr; xi = ni; } }
#pragma unroll 1
        for (int jj = 0; jj < 4; ++jj) { const int j = jb + jj;
        s5_stage_u(proj, g, j, ut, lane);
        for (int tt = 0; tt < 4; ++tt) {
            for (int t16 = 0; t16 < 16; ++t16) { const LAS f32x4* up = (const LAS f32x4*)(ut + (16 * tt + t16) * 16); float bur = 0.f, bui = 0.f;
#pragma unroll
                for (int c4 = 0; c4 < 4; ++c4) { const f32x4 uv = up[c4];
                    bur += bbr[4 * c4] * uv.x + bbr[4 * c4 + 1] * uv.y + bbr[4 * c4 + 2] * uv.z + bbr[4 * c4 + 3] * uv.w;
                    bui += bbi[4 * c4] * uv.x + bbi[4 * c4 + 1] * uv.y + bbi[4 * c4 + 2] * uv.z + bbi[4 * c4 + 3] * uv.w; }
                const float nr = ar * xr - ai * xi + bur, ni = ar * xi + ai * xr + bui; xr = nr; xi = ni;
                *(LAS unsigned short*)(X + t16 * 272 + 2 * lane) = (unsigned short)f2bf(xr); *(LAS unsigned short*)(X + t16 * 272 + 128 + 2 * lane) = (unsigned short)f2bf(xi); }
            LDS_WAIT(); asm volatile("" ::: "memory");
            f32x4 acc = (f32x4){0.f, 0.f, 0.f, 0.f};
#pragma unroll
            for (int ks = 0; ks < 4; ++ks) { const bf16x8 af = *(const LAS bf16x8*)(X + fr * 272 + 64 * ks + 16 * fq); acc = __builtin_amdgcn_mfma_f32_16x16x32_bf16(af, cf[ks], acc, 0, 0, 0); }
#pragma unroll
            for (int r = 0; r < 4; ++r) { const int tl = 16 * tt + 4 * fq + r; const float y = acc[r] + dsk * ut[tl * 16 + fr];
                yap[(size_t)(64 * j + tl) * 1024 + 16 * g + fr] = (bf16)f2bf(gelu_tanh_f(y)); }
            LDS_WAIT(); asm volatile("" ::: "memory");
        }
        }
    }
}

__device__ __forceinline__ void lds_add(LAS unsigned* p, unsigned v) { (void)__hip_atomic_fetch_add(p, v, __ATOMIC_RELAXED, __HIP_MEMORY_SCOPE_WORKGROUP); }
__device__ __forceinline__ float relu_i(float x) { int xi = __builtin_bit_cast(int, x); xi = xi > 0 ? xi : 0; return __builtin_bit_cast(float, xi); }
__device__ __forceinline__ unsigned ord_key(float s) { const unsigned u = __builtin_bit_cast(unsigned, s); return u ^ ((u >> 31) ? 0xFFFFFFFFu : 0x80000000u); }
template <int NB, bool PACKED>
__device__ __forceinline__ void hist_search(const LAS unsigned* hist, int field, unsigned need, int lane, int& bstar, unsigned& above) {
    constexpr int PER = NB / 64;
    const int sh = PACKED ? 16 * field : 0; const unsigned fm = PACKED ? 0xffffu : 0xffffffffu;
    unsigned tot = 0;
#pragma unroll 4
    for (int i = 0; i < PER; i += 4) { const u32x4 h = *(const LAS u32x4*)(hist + lane * PER + i); tot += ((h.x >> sh) & fm) + ((h.y >> sh) & fm) + ((h.z >> sh) & fm) + ((h.w >> sh) & fm); }
    unsigned incl = tot;
#pragma unroll
    for (int o = 1; o < 64; o <<= 1) { const unsigned v = __shfl_down(incl, o); if (lane + o < 64) incl += v; }
    const unsigned excl = incl - tot;
    const unsigned long long mask = __ballot(incl >= need);
    const int lstar = 63 - __builtin_clzll(mask | 1ull);
    unsigned cum = excl; int b = -1; unsigned ab = 0;
#pragma unroll 1
    for (int i = PER - 4; i >= 0; i -= 4) { const u32x4 h = *(const LAS u32x4*)(hist + lane * PER + i);
        const unsigned c3 = (h.w >> sh) & fm, c2 = (h.z >> sh) & fm, c1 = (h.y >> sh) & fm, c0 = (h.x >> sh) & fm;
        if (b < 0) { if (cum + c3 >= need) { b = lane * PER + i + 3; ab = cum; } else cum += c3; }
        if (b < 0) { if (cum + c2 >= need) { b = lane * PER + i + 2; ab = cum; } else cum += c2; }
        if (b < 0) { if (cum + c1 >= need) { b = lane * PER + i + 1; ab = cum; } else cum += c1; }
        if (b < 0) { if (cum + c0 >= need) { b = lane * PER + i + 0; ab = cum; } else cum += c0; } }
    bstar = __shfl(b, lstar); above = __shfl(ab, lstar);
}

__device__ __forceinline__ void dsa_p1_chunk(LAS unsigned char* lds, LAS unsigned* hist, int ch, int buf, int nadm, int l31, int hh, const bf16x8 (&qa)[4], const float (&wv)[16], float* srow) {
    const bool full = 128 * ch + 64 < nadm;
    const LAS unsigned char* tb = lds + (buf * 4) * 18944 + 8192 + l31 * 128;
    f32x16 acc[4];
#pragma unroll
    for (int tl = 0; tl < 4; ++tl)
#pragma unroll
        for (int i = 0; i < 16; ++i) acc[tl][i] = 0.f;
#pragma unroll
    for (int tl = 0; tl < 4; ++tl) {
#pragma unroll
        for (int ks = 0; ks < 4; ++ks) { const bf16x8 kf = *(const LAS bf16x8*)(tb + tl * 18944 + (((2 * ks + hh) ^ (l31 & 7)) * 16));
            acc[tl] = __builtin_amdgcn_mfma_f32_32x32x16_bf16(qa[ks], kf, acc[tl], 0, 0, 0); } }
#pragma unroll
    for (int tl = 0; tl < 4; ++tl) {
        float s0 = 0.f, s1 = 0.f;
#pragma unroll
        for (int i = 0; i < 16; i += 2) { s0 += wv[i] * relu_i(acc[tl][i]); s1 += wv[i + 1] * relu_i(acc[tl][i + 1]); }
        const unsigned ok = ord_key(s0 + s1), bin = ok >> 21;
        if (tl < 2 || full) lds_add(&hist[bin], 1u << (16 * hh));
        __builtin_nontemporal_store(s0 + s1, srow + 128 * ch + 32 * tl + l31);
    }
}
__device__ __forceinline__ void dsa_pass1(const bf16* proj, LAS unsigned char* lds, LAS unsigned char* wl, int nadm, int tid, int lane, const bf16x8 (&qa)[4], const float (&wv)[16], float* srow) {
    const int l31 = lane & 31, hh = lane >> 5;
    LAS unsigned* hist = (LAS unsigned*)wl;
    const int skey = tid >> 3, ssub = tid & 7;
    const bf16* gsrc = proj + (size_t)skey * NIN + C_KI + 8 * ssub;
    const int sdst = ((skey >> 5) * 18944) + 8192 + (skey & 31) * 128 + ((ssub ^ (skey & 7)) * 16);
    const int nch = (nadm + 127) / 128;
#define DSA_LD(c_, r0_, r1_) do { const int cc_ = (c_) < nch ? (c_) : nch - 1; r0_ = *(const u32x4*)(gsrc + (size_t)(128 * cc_) * NIN); r1_ = *(const u32x4*)(gsrc + (size_t)(128 * cc_ + 64) * NIN); } while (0)
#define DSA_ST(b_, r0_, r1_) do { const int bo_ = (b_) * 4 * 18944; *(LAS u32x4*)(lds + sdst + bo_) = r0_; *(LAS u32x4*)(lds + sdst + bo_ + 2 * 18944) = r1_; } while (0)
#define DSA_STEP(c_, b_, l0_, l1_, w0_, w1_) do { DSA_LD((c_) + 4, l0_, l1_); dsa_p1_chunk(lds, hist, (c_), (b_), nadm, l31, hh, qa, wv, srow); if ((c_) + 1 < nch) DSA_ST((b_) ^ 1, w0_, w1_); __syncthreads(); } while (0)
    u32x4 ra0, ra1, rb0, rb1, rc0, rc1, rd0, rd1;
    DSA_LD(0, ra0, ra1); DSA_LD(1, rb0, rb1); DSA_LD(2, rc0, rc1); DSA_LD(3, rd0, rd1);
    DSA_ST(0, ra0, ra1);
    __syncthreads();
#pragma unroll 1
    for (int ch = 0; ch < nch; ch += 4) {
        DSA_STEP(ch, 0, ra0, ra1, rb0, rb1);
        if (ch + 1 >= nch) break;
        DSA_STEP(ch + 1, 1, rb0, rb1, rc0, rc1);
        if (ch + 2 >= nch) break;
        DSA_STEP(ch + 2, 0, rc0, rc1, rd0, rd1);
        if (ch + 3 >= nch) break;
        DSA_STEP(ch + 3, 1, rd0, rd1, ra0, ra1);
    }
#undef DSA_LD
#undef DSA_ST
#undef DSA_STEP
}

__device__ __forceinline__ void dsa_phase(const Args& a, LAS unsigned char* lds, int G, int wave_s) {
    int lane_o = (int)__builtin_amdgcn_mbcnt_hi(~0u, __builtin_amdgcn_mbcnt_lo(~0u, 0u)); asm volatile("" : "+v"(lane_o)); const int lane = lane_o, wave = wave_s, tid_o = wave_s * 64 + lane_o;
    unsigned char* ws = a.ws; const bf16* proj = (const bf16*)(ws + WS_PROJ); const bf16* kvn = (const bf16*)(ws + WS_KVN);
    bf16* ycat = (bf16*)(ws + WS_YCAT);
    constexpr int WREG = 18944;
    LAS unsigned char* wl = lds + wave * WREG;
    LAS unsigned* hist = (LAS unsigned*)wl; LAS int* sel = (LAS int*)(wl + 16896);
    const int l31 = lane & 31, hh = lane >> 5, fr = lane & 15, fq = lane >> 4;
    for (int un = blockIdx.x; un < 512; un += G) {
        __syncthreads();
        const int unit = (un < 256) ? un : 767 - un;
        const int t0 = unit * 16, tq = t0 + 2 * wave;
        const int nadm = ((t0 >> 6) + 1) * 64;
        if (nadm > 256) {
            {
                bf16x8 qa[4];
                { const int r = l31, qq = (r >> 2) & 1, head = (r & 3) + 4 * (r >> 3);
                  const bf16* qp = proj + (size_t)(tq + qq) * NIN + C_QI + head * 64 + 8 * hh;
#pragma unroll
                  for (int ks = 0; ks < 4; ++ks) qa[ks] = *(const bf16x8*)(qp + 16 * ks); }
                float wv[16];
                { const u32x4 w0 = *(const u32x4*)(proj + (size_t)(tq + hh) * NIN + C_WI), w1 = *(const u32x4*)(proj + (size_t)(tq + hh) * NIN + C_WI + 8);
                  const float sc = 1.0f / 32.0f;
                  wv[0] = bflo(w0.x) * sc; wv[1] = bfhi(w0.x) * sc; wv[2] = bflo(w0.y) * sc; wv[3] = bfhi(w0.y) * sc; wv[4] = bflo(w0.z) * sc; wv[5] = bfhi(w0.z) * sc; wv[6] = bflo(w0.w) * sc; wv[7] = bfhi(w0.w) * sc;
                  wv[8] = bflo(w1.x) * sc; wv[9] = bfhi(w1.x) * sc; wv[10] = bflo(w1.y) * sc; wv[11] = bfhi(w1.y) * sc; wv[12] = bflo(w1.z) * sc; wv[13] = bfhi(w1.z) * sc; wv[14] = bflo(w1.w) * sc; wv[15] = bfhi(w1.w) * sc; }
                for (int i = lane; i < 2048; i += 64) hist[i] = 0u;
                dsa_pass1(proj, lds, wl, nadm, tid_o, lane, qa, wv, (float*)(ws + WS_SCORE) + (size_t)(tq + hh) * SEQ);
            }
            int b1[2]; unsigned ab1[2];
            hist_search<2048, true>(hist, 0, 256u, lane, b1[0], ab1[0]);
            hist_search<2048, true>(hist, 1, 256u, lane, b1[1], ab1[1]);
            asm volatile("" ::: "memory");
            LAS unsigned* cok = (LAS unsigned*)wl; LAS int* cix = (LAS int*)(wl + 4096);
            VM_WAIT();
#pragma unroll 1
            for (int qq = 0; qq < 2; ++qq) {
                const float* sr = (const float*)(ws + WS_SCORE) + (size_t)(tq + qq) * SEQ + 4 * lane;
                const unsigned bq = (unsigned)(qq ? b1[1] : b1[0]); unsigned ns = 0, nc = 0;
                const unsigned long long lowm = (1ull << lane) - 1ull;
                for (int k0 = 0; k0 < nadm; k0 += 2048) {
                    f32x4 v[8];
#pragma unroll
                    for (int u = 0; u < 8; ++u) { const int kk = k0 + 256 * u + 4 * lane; v[u] = kk < nadm ? __builtin_nontemporal_load((const f32x4*)(sr + k0 + 256 * u)) : (f32x4){0.f, 0.f, 0.f, 0.f}; }
#pragma unroll
                    for (int u = 0; u < 8; ++u) { if (k0 + 256 * u < nadm) {
                        const int kk = k0 + 256 * u + 4 * lane; const bool vld = kk < nadm;
#pragma unroll
                        for (int c = 0; c < 4; ++c) {
                            const unsigned ok = ord_key(v[u][c]), bin = ok >> 21; const bool isel = vld && bin > bq, icand = vld && bin == bq;
                            const unsigned long long ms = __ballot(isel), mc = __ballot(icand);
                            const unsigned ps = ns + (unsigned)__builtin_popcountll(ms & lowm), pc = nc + (unsigned)__builtin_popcountll(mc & lowm);
                            if (isel && ps < 256u) sel[qq * 256 + ps] = kk + c;
                            if (icand && pc < 512u) { cok[qq * 512 + pc] = ok; cix[qq * 512 + pc] = kk + c; }
                            ns += (unsigned)__builtin_popcountll(ms); nc += (unsigned)__builtin_popcountll(mc); } } }
                }
                LDS_WAIT(); asm volatile("" ::: "memory");
                const unsigned C = nc > 512u ? 512u : nc;
                const unsigned need = ns < 256u ? 256u - ns : 0u;
                unsigned kk8[8]; int ix8[8];
#pragma unroll
                for (int j = 0; j < 8; ++j) { const unsigned i = lane + 64 * j; const bool act = i < C; kk8[j] = act ? cok[qq * 512 + i] : 0u; ix8[j] = act ? cix[qq * 512 + i] : 0x7fffffff; }
                unsigned kstar = 0u; int istar = 0x7fffffff;
                if (need < C) {
                    unsigned prefix = bq << 21;
#pragma unroll 1
                    for (int bit = 20; bit >= 0; --bit) { const unsigned trial = prefix | (1u << bit); unsigned cnt = 0;
#pragma unroll
                        for (int j = 0; j < 8; ++j) cnt += (unsigned)__builtin_popcountll(__ballot(kk8[j] >= trial));
                        if (cnt >= need) prefix = trial; }
                    kstar = prefix;
                    unsigned ngt = 0, neq = 0;
#pragma unroll
                    for (int j = 0; j < 8; ++j) { ngt += (unsigned)__builtin_popcountll(__ballot(kk8[j] > kstar)); neq += (unsigned)__builtin_popcountll(__ballot(kk8[j] == kstar)); }
                    const unsigned m = need - ngt;
                    if (m < neq) { int ans = 0;
#pragma unroll 1
                        for (int bit = 12; bit >= 0; --bit) { const int tr = ans | (1 << bit); unsigned cnt = 0;
#pragma unroll
                            for (int j = 0; j < 8; ++j) cnt += (unsigned)__builtin_popcountll(__ballot(kk8[j] == kstar && ix8[j] < tr));
                            if (cnt < m) ans = tr; }
                        istar = ans; }
                }
                unsigned base = ns;
#pragma unroll
                for (int j = 0; j < 8; ++j) { const bool act = lane + 64u * j < C; const bool pred = act && (kk8[j] > kstar || (kk8[j] == kstar && ix8[j] <= istar));
                    const unsigned long long mk = __ballot(pred); const unsigned pos = base + (unsigned)__builtin_popcountll(mk & lowm);
                    if (pred && pos < 256u) sel[qq * 256 + pos] = ix8[j];
                    base += (unsigned)__builtin_popcountll(mk); }
                for (unsigned i = base + lane; i < 256u; i += 64) sel[qq * 256 + i] = -1;
            }
            LDS_WAIT(); asm volatile("" ::: "memory");
        } else {
            for (int i = lane; i < 512; i += 64) { const int k = i & 255; sel[i] = k < nadm ? k : -1; }
            LDS_WAIT(); asm volatile("" ::: "memory");
        }
#pragma unroll 1
        for (int qq = 0; qq < 2; ++qq) {
            const int t = tq + (qq & 1); const int head = fr & 7;
            const float slope = fast_exp2(-(float)(head + 1));
            bf16x8 qf[8];
            { const bf16* qp = proj + (size_t)t * NIN + C_QT + head * 256 + 8 * fq;
#pragma unroll
              for (int ks = 0; ks < 8; ++ks) qf[ks] = *(const bf16x8*)(qp + 32 * ks); }
            f32x4 oacc[16];
#pragma unroll
            for (int i = 0; i < 16; ++i) oacc[i] = (f32x4){0.f, 0.f, 0.f, 0.f};
            float mrun = -1e30f, lrun = 0.f;
            u32x4 gr[16];
#pragma unroll
            for (int i = 0; i < 16; ++i) { int s = sel[(qq & 1) * 256 + hh + 2 * i]; s = s < 0 ? 0 : s; gr[i] = *(const u32x4*)(kvn + (size_t)s * 256 + 8 * l31); }
            for (int kt = 0; kt < 8; ++kt) {
                asm volatile("" ::: "memory");
#pragma unroll
                for (int i = 0; i < 16; ++i) *(LAS u32x4*)(wl + (hh + 2 * i) * 528 + 16 * l31) = gr[i];
                if (kt + 1 < 8) {
#pragma unroll
                    for (int i = 0; i < 16; ++i) { int s = sel[(qq & 1) * 256 + 32 * (kt + 1) + hh + 2 * i]; s = s < 0 ? 0 : s; gr[i] = *(const u32x4*)(kvn + (size_t)s * 256 + 8 * l31); } }
                LDS_WAIT(); asm volatile("" ::: "memory");
                f32x4 sacc[2];
#pragma unroll
                for (int sb = 0; sb < 2; ++sb) { f32x4 c4 = (f32x4){0.f, 0.f, 0.f, 0.f};
#pragma unroll
                    for (int ks = 0; ks < 8; ++ks) { const bf16x8 af = *(const LAS bf16x8*)(wl + (16 * sb + fr) * 528 + 64 * ks + 16 * fq); c4 = __builtin_amdgcn_mfma_f32_16x16x32_bf16(af, qf[ks], c4, 0, 0, 0); }
                    sacc[sb] = c4; }
                float lg[8]; float mx = -1e30f;
#pragma unroll
                for (int sb = 0; sb < 2; ++sb) { const LAS int* sp = sel + (qq & 1) * 256 + 32 * kt + 16 * sb + 4 * fq;
#pragma unroll
                    for (int r = 0; r < 4; ++r) { const int s = sp[r]; const float d = (float)(t - s); float v = sacc[sb][r] - slope * fabsf(d); v = s < 0 ? -1e30f : v; lg[4 * sb + r] = v; mx = fmaxf(mx, v); } }
                mx = fmaxf(mx, __shfl_xor(mx, 16)); mx = fmaxf(mx, __shfl_xor(mx, 32));
                const float mnew = fmaxf(mrun, mx); const float alpha = fast_exp2((mrun - mnew) * 1.4426950408889634f);
                float ps = 0.f; float p[8];
#pragma unroll
                for (int i = 0; i < 8; ++i) { p[i] = lg[i] <= -1e29f ? 0.f : fast_exp2((lg[i] - mnew) * 1.4426950408889634f); ps += p[i]; }
                lrun = lrun * alpha + ps; mrun = mnew;
#pragma unroll
                for (int i = 0; i < 16; ++i) oacc[i] = oacc[i] * alpha;
                u32x4 pw; pw.x = pk2(p[0], p[1]); pw.y = pk2(p[2], p[3]); pw.z = pk2(p[4], p[5]); pw.w = pk2(p[6], p[7]);
                const bf16x8 pf = __builtin_bit_cast(bf16x8, pw);
#pragma unroll
                for (int rt = 0; rt < 16; ++rt) {
                    const LAS unsigned char* p0 = wl + (4 * fq + (fr >> 2)) * 528 + (16 * rt + 4 * (fr & 3)) * 2;
                    const v4i16_t a0 = __builtin_amdgcn_ds_read_tr16_b64_v4i16((LAS v4i16_t*)p0);
                    const v4i16_t a1 = __builtin_amdgcn_ds_read_tr16_b64_v4i16((LAS v4i16_t*)(p0 + 16 * 528));
                    bf16x8 af; af[0] = a0[0]; af[1] = a0[1]; af[2] = a0[2]; af[3] = a0[3]; af[4] = a1[0]; af[5] = a1[1]; af[6] = a1[2]; af[7] = a1[3];
                    oacc[rt] = __builtin_amdgcn_mfma_f32_16x16x32_bf16(af, pf, oacc[rt], 0, 0, 0); }
                LDS_WAIT(); asm volatile("" ::: "memory");
            }
            float lt = lrun; lt += __shfl_xor(lt, 16); lt += __shfl_xor(lt, 32);
            const float inv = 1.0f / lt;
#if FP8_MIXOUT
            if (fr < 8) { unsigned char* op = (unsigned char*)ycat + (size_t)t * NCAT + 1024 + fr * 256 + 4 * fq; const float inv8 = inv * 8.0f;
#pragma unroll
                for (int rt = 0; rt < 16; ++rt) { const f32x4 v = oacc[rt] * inv8; *(unsigned*)(op + 16 * rt) = pk4_fp8(v.x, v.y, v.z, v.w); } }
#else
            if (fr < 8) { bf16* op = ycat + (size_t)t * NCAT + 1024 + fr * 256 + 4 * fq;
#pragma unroll
                for (int rt = 0; rt < 16; ++rt) { const f32x4 v = oacc[rt] * inv; u32x2 w; w.x = pk2(v.x, v.y); w.y = pk2(v.z, v.w); *(u32x2*)(op + 16 * rt) = w; } }
#endif
        }
        LDS_WAIT(); asm volatile("" ::: "memory");
    }
}

__device__ __forceinline__ void attn_c_phase(const Args& a, LAS unsigned char* lds, int G, int wave_s) {
    int lane_o = (int)__builtin_amdgcn_mbcnt_hi(~0u, __builtin_amdgcn_mbcnt_lo(~0u, 0u)); asm volatile("" : "+v"(lane_o)); const int lane = lane_o, wave = wave_s, tid_o = wave_s * 64 + lane_o;
    unsigned char* ws = a.ws; const bf16* Q = (const bf16*)(ws + WS_Q); const bf16* K = (const bf16*)(ws + WS_K); const bf16* VT = (const bf16*)(ws + WS_VT); bf16* O = (bf16*)(ws + WS_O);
    LAS float* btab = (LAS float*)(lds + 65536);
    const int l31 = lane & 31, hh = lane >> 5;
    const float sc = 0.08838834764831845f * 1.4426950408889634f;
    const int kkey = tid_o >> 4, kc = tid_o & 15, vd = tid_o >> 3, vc = tid_o & 7;
    for (int un = blockIdx.x; un < 512; un += G) {
        const int head = un >> 5, cg = un & 31, ci = wave >> 1, chunk = 4 * cg + ci;
        __syncthreads();
        for (int i = tid_o; i < 513; i += NTHR) btab[i] = a.in[I_RELB][head * 513 + i] * 1.4426950408889634f;
        const int t = 64 * chunk + 32 * (wave & 1) + l31;
        bf16x8 qf[8];
        { const bf16* qp = Q + (size_t)t * DM + head * 128 + 8 * hh;
#pragma unroll
          for (int ks = 0; ks < 8; ++ks) qf[ks] = *(const bf16x8*)(qp + 16 * ks); }
        f32x16 oacc[4];
#pragma unroll
        for (int d = 0; d < 4; ++d)
#pragma unroll
            for (int i = 0; i < 16; ++i) oacc[d][i] = 0.f;
        float mrun = -1e30f, lrun = 0.f;
        const int cb0 = 4 * cg - 8;
        const int j0 = cb0 < 0 ? -cb0 : 0;
        const bf16* kg = K + (size_t)kkey * DM + head * 128 + kc * 8; const bf16* vg = VT + (size_t)(head * 128 + vd) * SEQ + vc * 8;
        const int kdst = kkey * 256 + ((kc ^ (kkey & 15)) * 16), vdst = 16384 + vd * 128 + ((vc ^ ((vd >> 1) & 7)) * 16);
        u32x4 sk0, sk1, sv0, sv1;
#define ATC_LD(j_) do { const size_t s0_ = (size_t)(64 * (cb0 + (j_))); sk0 = *(const u32x4*)(kg + s0_ * DM); sk1 = *(const u32x4*)(kg + (s0_ + 32) * DM); sv0 = *(const u32x4*)(vg + s0_); sv1 = *(const u32x4*)(vg + s0_ + (size_t)64 * SEQ); } while (0)
#define ATC_ST(b_) do { LAS unsigned char* d_ = lds + (b_) * 32768; *(LAS u32x4*)(d_ + kdst) = sk0; *(LAS u32x4*)(d_ + kdst + 32 * 256) = sk1; *(LAS u32x4*)(d_ + vdst) = sv0; *(LAS u32x4*)(d_ + vdst + 64 * 128) = sv1; } while (0)
        ATC_LD(j0); ATC_ST(j0 & 1);
        __syncthreads();
        for (int j = j0; j < 12; ++j) {
            if (j + 1 < 12) ATC_LD(j + 1);
            if (j >= ci && j <= ci + 8) {
                const LAS unsigned char* kb = lds + (j & 1) * 32768; const LAS unsigned char* vb = kb + 16384;
                const int s0 = 64 * (cb0 + j);
#pragma unroll
                for (int sub = 0; sub < 2; ++sub) {
                    f32x16 sa;
#pragma unroll
                    for (int i = 0; i < 16; ++i) sa[i] = 0.f;
                    const int krow = 32 * sub + l31;
#pragma unroll
                    for (int ks = 0; ks < 8; ++ks) { const bf16x8 kf = *(const LAS bf16x8*)(kb + krow * 256 + (((2 * ks + hh) ^ (krow & 15)) * 16)); sa = __builtin_amdgcn_mfma_f32_32x32x16_bf16(kf, qf[ks], sa, 0, 0, 0); }
                    float mx = -1e30f; float lg[16];
#pragma unroll
                    for (int i = 0; i < 16; ++i) { const int s = s0 + 32 * sub + (i & 3) + 8 * (i >> 2) + 4 * hh; int rel = t - s; rel = rel > 256 ? 256 : rel; lg[i] = sa[i] * sc + btab[rel + 256]; mx = fmaxf(mx, lg[i]); }
                    mx = fmaxf(mx, __shfl_xor(mx, 32));
                    const float mnew = fmaxf(mrun, mx), alpha = fast_exp2(mrun - mnew);
                    float ps = 0.f; float p[16];
#pragma unroll
                    for (int i = 0; i < 16; ++i) { p[i] = fast_exp2(lg[i] - mnew); ps += p[i]; }
                    lrun = lrun * alpha + ps; mrun = mnew;
#pragma unroll
                    for (int d = 0; d < 4; ++d)
#pragma unroll
                        for (int i = 0; i < 16; ++i) oacc[d][i] *= alpha;
#pragma unroll
                    for (int s = 0; s < 2; ++s) {
                        u32x4 pw; pw.x = pk2(p[8 * s], p[8 * s + 1]); pw.y = pk2(p[8 * s + 2], p[8 * s + 3]); pw.z = pk2(p[8 * s + 4], p[8 * s + 5]); pw.w = pk2(p[8 * s + 6], p[8 * s + 7]);
                        const bf16x8 pf = __builtin_bit_cast(bf16x8, pw);
                        const int q0 = 8 * sub + 4 * s + hh;
#pragma unroll
                        for (int d = 0; d < 4; ++d) { const int dr = 32 * d + l31; const LAS unsigned char* vr = vb + dr * 128 + (q0 & 1) * 8; const int sw = (dr >> 1) & 7;
                            const u32x2 v0 = *(const LAS u32x2*)(vr + (((q0 >> 1) ^ sw) * 16)), v1 = *(const LAS u32x2*)(vr + ((((q0 >> 1) + 1) ^ sw) * 16));
                            u32x4 vw; vw.x = v0.x; vw.y = v0.y; vw.z = v1.x; vw.w = v1.y;
                            oacc[d] = __builtin_amdgcn_mfma_f32_32x32x16_bf16(__builtin_bit_cast(bf16x8, vw), pf, oacc[d], 0, 0, 0); }
                    }
                }
            }
            if (j + 1 < 12) ATC_ST((j + 1) & 1);
            __syncthreads();
        }
#undef ATC_LD
#undef ATC_ST
        float lt = lrun + __shfl_xor(lrun, 32); const float inv = 1.0f / lt;
#if FP8_MIXOUT
        unsigned char* op = (unsigned char*)O + (size_t)t * DM + head * 128 + 4 * hh; const float inv8 = inv * 8.0f;
#pragma unroll
        for (int d = 0; d < 4; ++d)
#pragma unroll
            for (int gq = 0; gq < 4; ++gq) *(unsigned*)(op + 32 * d + 8 * gq) = pk4_fp8(oacc[d][4 * gq] * inv8, oacc[d][4 * gq + 1] * inv8, oacc[d][4 * gq + 2] * inv8, oacc[d][4 * gq + 3] * inv8);
#else
        bf16* op = O + (size_t)t * DM + head * 128 + 4 * hh;
#pragma unroll
        for (int d = 0; d < 4; ++d)
#pragma unroll
            for (int gq = 0; gq < 4; ++gq) { u32x2 w; w.x = pk2(oacc[d][4 * gq] * inv, oacc[d][4 * gq + 1] * inv); w.y = pk2(oacc[d][4 * gq + 2] * inv, oacc[d][4 * gq + 3] * inv);
                *(u32x2*)(op + 32 * d + 8 * gq) = w; }
#endif
    }
    __syncthreads();
}

__global__ void __launch_bounds__(NTHR, 2) fwd_kernel(Args args) {
    extern __shared__ __attribute__((aligned(16))) unsigned char lds_raw[];
    LAS unsigned char* lds = (LAS unsigned char*)lds_raw;
    volatile LAS unsigned* MISC = (volatile LAS unsigned*)(lds + MISC_OFF);
    const int wave_s = __builtin_amdgcn_readfirstlane((int)threadIdx.x >> 6);
    const int G = gridDim.x;
    unsigned char* ws = args.ws;
    if (threadIdx.x < 64) MISC[threadIdx.x] = 0u;
    __syncthreads();
    const int lo = args.ph_lo, hi = args.ph_hi;
    const bool multi = (hi - lo) > 1;
    XcdBarrier bar; bar.bar = (unsigned*)(ws + WS_CTL) + CW_BAR; bar.x = 0; bar.st = nullptr;
    if (multi) bar = xcd_barrier_post((unsigned*)(ws + WS_CTL) + CW_BAR, MISC + 8);
    bar.wave = wave_s;
#define IN(k) (lo <= (k) && (k) < hi)
#if TIMING
#define STAMP(k) do { if (blockIdx.x == 0 && wave_s == 0 && __builtin_amdgcn_mbcnt_hi(~0u, __builtin_amdgcn_mbcnt_lo(~0u, 0u)) == 0u) __hip_atomic_store((unsigned long long*)(ws + WS_DIAG) + (k), __builtin_amdgcn_s_memrealtime(), __ATOMIC_RELAXED, __HIP_MEMORY_SCOPE_AGENT); } while (0)
#define SEAM(k) do { if (IN((k) + 1)) xcd_barrier(bar); STAMP((k) + 1); } while (0)
#else
#define STAMP(k) do { } while (0)
#define SEAM(k) do { if (IN((k) + 1)) xcd_barrier(bar); } while (0)
#endif

 #if REP_MASK
#define PH_LOOP(k) _Pragma("unroll") for (int r_ = 0; r_ < ((((REP_MASK) >> (k)) & 1u) ? REP_N : 1); ++r_)
#else
#define PH_LOOP(k)
#endif
    float* H = args.out;
    float* mod = (float*)(ws + WS_MOD);
    bf16* hn = (bf16*)(ws + WS_HN); bf16* hmid = (bf16*)(ws + WS_HMID); bf16* proj = (bf16*)(ws + WS_PROJ);

    STAMP(0);
    PH_LOOP(0) { if (EN(0) && IN(0)) p0_prologue(args, lds, G, wave_s);
    if (IN(0)) SEAM(0); }

#define FFN_PHASES(S_, PB_) do { \
        constexpr int layer_ = (S_) >> 1, sub_ = ((S_) & 1) ? 2 : 0; \
        const float* hin_ = ((S_) == 0) ? args.in[I_X] : H; \
        const float* mvec_ = mod + layer_ * NMOD + sub_ * 3 * DM; \
        PH_LOOP(PB_) { if (EN(1) && IN(PB_)) norm_phase<false, true>(hin_, args.in[I_NORMG] + (layer_ * 3 + sub_) * DM, mvec_, mvec_ + DM, hn, nullptr, G, wave_s); \
        if ((S_) == 0 && EN(2) && IN(PB_)) { \
              \
            pg8::Gemm g{(const bf16*)(ws + WS_WUPRAW), (const bf16*)(ws + WS_WQRAW), 256, 2048, 128, 2048, 2048, 8, 128, 128, \
                        (const bf16*)(ws + WS_WOUTB) + 1024, (const bf16*)(ws + WS_WUPRAW) + 1024, 2048, 256, 8, 128, 128}; \
            pg8::StaticOrder S; S.init(g, G, (int)blockIdx.x); \
            pg8::EpiBf16 E{(bf16*)(ws + WS_WIN) + (size_t)1024 * DM, DM, (size_t)256 * DM, 0.08838834764831845f, FP8_MIXOUT ? (bf16*)(ws + WS_WOUT + 1024) : (bf16*)(ws + WS_WOUT) + 1024, NCAT, (size_t)256, FP8_MIXOUT ? 64.0f : 1.0f, 0, 0, FP8_MIXOUT}; \
            pg8::gemm_phase<pg8::EpiBf16>(lds, g, S, E, wave_s); } \
        if (IN(PB_)) SEAM(PB_); } \
        PH_LOOP((PB_) + 1) { if (EN(3) && IN((PB_) + 1)) { \
            pg8::Gemm g{hn, (const bf16*)(ws + WS_WGU + (size_t)(S_) * NGU * DM), SEQ, NGU, DM / 2, DM / 2, DM / 2, 1, 0, 0, nullptr, nullptr, 0, 0, 0, 0, 0}; \
            pg8::StaticOrder S; S.init(g, G, (int)blockIdx.x); \
            pg8::EpiSwiGLU E{(unsigned char*)hmid, FFP, 0x7c7c7c7c, 0x79797979};     \
            pg8::gemm_phase<pg8::EpiSwiGLU, true>(lds, g, S, E, wave_s); \
              \
            if ((S_) == 0) conv_fill<CI_FFN(0) + 5504, 2752, CI_IN, CI_NIN, CI_GLU, CI_NGLU>(args, lds, G, S.ntot, wave_s); \
            if ((S_) == 1) conv_fill<CI_FFN(2), 5504, CI_FFN(3) + 5504, 2752>(args, lds, G, S.ntot, wave_s); \
            if ((S_) == 2) conv_fill<CI_FFN(3), 5504>(args, lds, G, S.ntot, wave_s); } \
        if (IN((PB_) + 1)) SEAM((PB_) + 1); } \
        PH_LOOP((PB_) + 2) { if (EN(4) && IN((PB_) + 2)) { \
            pg8::Gemm g{hmid, (const bf16*)(ws + WS_WD + (size_t)(S_) * DM * FFP), SEQ, DM, FFP / 2, FFP / 2, FFP / 2, 1, 0, 0, nullptr, nullptr, 0, 0, 0, 0, 0}; \
            pg8::StaticOrder S; S.init(g, G, (int)blockIdx.x); \
            pg8::EpiResid E{hin_, H, mvec_ + 2 * DM, 0.5f, 0x7c7c7c7c, 0x78787878};     \
            pg8::gemm_phase<pg8::EpiResid, true>(lds, g, S, E, wave_s); } \
        if (IN((PB_) + 2)) SEAM((PB_) + 2); } \
    } while (0)
#define MIXOUT_PHASE(LYR_, PM_, APTR_, BPTR_, K_) do { \
        if (EN(12) && IN(PM_)) { \
            const float* m1_ = mod + (LYR_) * NMOD + 1 * 3 * DM; \
            constexpr int KU_ = FP8_MIXOUT ? (K_) / 2 : (K_); \
            pg8::Gemm g{(const bf16*)(APTR_), (const bf16*)(BPTR_), SEQ, DM, KU_, KU_, KU_, 1, 0, 0, nullptr, nullptr, 0, 0, 0, 0, 0}; \
            pg8::StaticOrder S; S.init(g, G, (int)blockIdx.x); \
            pg8::EpiResid E{H, H, m1_ + 2 * DM, 1.0f, 0x7c7c7c7c, 0x79797979}; \
            pg8::gemm_phase<pg8::EpiResid, FP8_MIXOUT != 0>(lds, g, S, E, wave_s); } \
        if (IN(PM_)) SEAM(PM_); \
    } while (0)

    FFN_PHASES(0, 1);
    {
        const float* m1 = mod + 0 * NMOD + 1 * 3 * DM;
        PH_LOOP(4) { if (EN(1) && IN(4)) norm_phase<false>(H, args.in[I_NORMG] + (0 * 3 + 1) * DM, m1, m1 + DM, hn, nullptr, G, wave_s);
        if (IN(4)) SEAM(4); }
        PH_LOOP(5) { if (EN(5) && IN(5)) {
            pg8::Gemm g{hn, (const bf16*)(ws + WS_WIN), SEQ, NIN, DM, DM, DM, 1, 0, 0, nullptr, nullptr, 0, 0, 0, 0, 0};
            pg8::StaticOrder S; S.init(g, G, (int)blockIdx.x);
            pg8::EpiBf16 E{proj, NIN, 0, 1.0f, nullptr, 0, 0, 0.f};
            pg8::gemm_phase<pg8::EpiBf16>(lds, g, S, E, wave_s);
            conv_fill<CI_OUT, 512, CI_FFN(1), 8256, CI_QKV, CI_NQKV>(args, lds, G, S.ntot, wave_s);
        }
        if (IN(5)) SEAM(5); }
        PH_LOOP(6) { if (EN(6) && IN(6)) phase_a2(args, lds, G, wave_s);
        if (IN(6)) SEAM(6); }
        PH_LOOP(24) { if (EN(7) && IN(7)) { s5_scan_out(args, lds, G, wave_s); __syncthreads(); } }
        STAMP(25);
        PH_LOOP(25) { if (EN(8) && IN(7)) dsa_phase(args, lds, G, wave_s); }
        if (IN(7)) SEAM(7);
        PH_LOOP(8) { if (EN(9) && IN(8)) {
            pg8::Gemm g{(const bf16*)(ws + WS_YAPRE), (const bf16*)(ws + WS_WGLU), SEQ, 1024, 1024, 1024, 1024, 1, 0, 0, nullptr, nullptr, 0, 0, 0, 0, 0};
            pg8::StaticOrder S; S.init(g, G, (int)blockIdx.x);
            pg8::EpiGLU E{(const bf16*)(ws + WS_YAPRE), args.in[I_BGLU], (bf16*)(ws + WS_YCAT), NCAT};
            pg8::gemm_phase<pg8::EpiGLU>(lds, g, S, E, wave_s);
            conv_fill<CI_CO, CI_NCO, CI_FFN(2) + 5504, 2752>(args, lds, G, S.ntot, wave_s);
        }
        if (IN(8)) SEAM(8); }
    }
#ifdef EXTRA_BARRIERS
    for (int xb_ = 0; xb_ < EXTRA_BARRIERS; ++xb_) xcd_barrier(bar);
#endif
#ifdef EXP_GEMM
    {
        xcd_barrier(bar);
#if EXP_GEMM == 1
        pg8::Gemm g{hmid, (const bf16*)(ws + WS_WD), SEQ, DM, FFP / 2, FFP / 2, FFP / 2, 1, 0, 0, nullptr, nullptr, 0, 0, 0, 0, 0};
        pg8::StaticOrder S; S.init(g, G, (int)blockIdx.x); S.force = EXP_FORCE;
        pg8::EpiBf16 E{(bf16*)(ws + WS_SCORE), DM, 0, 1.0f, nullptr, 0, 0, 0.f, 0x7c7c7c7c, 0x78787878};
        pg8::gemm_phase<pg8::EpiBf16, true>(lds, g, S, E, wave_s);
#elif EXP_GEMM == 3
        pg8::Gemm g{hmid, (const bf16*)(ws + WS_WD), SEQ, DM, FFP / 2, FFP / 2, FFP / 2, 1, 0, 0, nullptr, nullptr, 0, 0, 0, 0, 0};
        pg8::StaticOrder S; S.init(g, G, (int)blockIdx.x); S.force = EXP_FORCE;
        pg8::EpiResid E{H, (float*)(ws + WS_SCORE), mod + 2 * DM, 0.5f, 0x7c7c7c7c, 0x78787878};
        pg8::gemm_phase<pg8::EpiResid, true>(lds, g, S, E, wave_s);
#elif EXP_GEMM == 2
        pg8::Gemm g{hn, (const bf16*)(ws + WS_WGU), SEQ, NGU, DM / 2, DM / 2, DM / 2, 1, 0, 0, nullptr, nullptr, 0, 0, 0, 0, 0};
        pg8::StaticOrder S; S.init(g, G, (int)blockIdx.x); S.force = EXP_FORCE;
        pg8::EpiBf16 E{(bf16*)(ws + WS_SCORE), NGU, 0, 1.0f, nullptr, 0, 0, 0.f, 0x7c7c7c7c, 0x79797979};
        pg8::gemm_phase<pg8::EpiBf16, true>(lds, g, S, E, wave_s);
#endif
        xcd_barrier(bar);
    }
#endif
    MIXOUT_PHASE(0, 9, ws + WS_YCAT, ws + WS_WOUT, NCAT);
    FFN_PHASES(1, 10);
    FFN_PHASES(2, 13);
    {
        const float* m1 = mod + 1 * NMOD + 1 * 3 * DM;
        PH_LOOP(16) { if (EN(1) && IN(16)) norm_phase<false, FP8_QKV != 0>(H, args.in[I_NORMG] + (1 * 3 + 1) * DM, m1, m1 + DM, hn, nullptr, G, wave_s);
        if (IN(16)) SEAM(16); }
        PH_LOOP(17) { if (EN(10) && IN(17)) {
            constexpr int KU = FP8_QKV ? DM / 2 : DM;
            pg8::Gemm g{hn, (const bf16*)(ws + WS_WQKV), SEQ, 2048, KU, KU, KU, 2, 0, (size_t)2048 * KU,
                        (const bf16*)(ws + WS_WQKV) + (size_t)4096 * KU, hn, 2048, SEQ, 1, 0, 0};
            pg8::StaticOrder S; S.init(g, G, (int)blockIdx.x);
            pg8::EpiBf16 E{(bf16*)(ws + WS_Q), DM, (size_t)SEQ * DM, 1.0f, (bf16*)(ws + WS_VT), SEQ, 0, 1.0f, 0x7c7c7c7c, 0x79797979};
            pg8::gemm_phase<pg8::EpiBf16, FP8_QKV != 0>(lds, g, S, E, wave_s);
        }
        if (IN(17)) SEAM(17); }
        PH_LOOP(18) { if (EN(11) && IN(18)) attn_c_phase(args, lds, G, wave_s);
        if (IN(18)) SEAM(18); }
    }
    MIXOUT_PHASE(1, 19, ws + WS_O, ws + WS_WCOUT, DM);
    FFN_PHASES(3, 20);
    if (EN(13) && IN(23)) { norm_phase<true>(H, args.in[I_FING], nullptr, nullptr, nullptr, args.out, G, wave_s); }
#if TIMING
    {
        xcd_barrier(bar); STAMP(24);
        if (blockIdx.x == 0 && wave_s == 0) {
            const unsigned long long* ts = (const unsigned long long*)(ws + WS_DIAG);
            const unsigned long long a0 = __hip_atomic_load(ts + TSEL_A, __ATOMIC_RELAXED, __HIP_MEMORY_SCOPE_AGENT), a1 = __hip_atomic_load(ts + TSEL_A + TSEL_A_N, __ATOMIC_RELAXED, __HIP_MEMORY_SCOPE_AGENT);
            const unsigned long long want = (a1 - a0) * TAMP, t0 = __builtin_amdgcn_s_memrealtime();
            while (__builtin_amdgcn_s_memrealtime() - t0 < want) __builtin_amdgcn_s_sleep(32);
        }
    }
#endif
#undef IN
#undef SEAM
}

extern "C" void kernel_launch(void* const* d_in, const int* in_sizes, int n_in, void* d_out, int out_size, void* d_ws, size_t ws_size, hipStream_t stream) {
    static int grid = 0;
    if (grid == 0) {
        if (n_in != 26 || out_size != SEQ * DM || ws_size < WS_END) { fprintf(stderr, "kernel_launch: unexpected shapes (n_in %d out %d ws %zu need %zu)\n", n_in, out_size, ws_size, (size_t)WS_END); grid = -1; return; }
        int dev = 0, cus = 0, per_cu = 0;
        if (hipGetDevice(&dev) != hipSuccess || hipDeviceGetAttribute(&cus, hipDeviceAttributeMultiprocessorCount, dev) != hipSuccess) { grid = -1; return; }
        if (hipFuncSetAttribute((const void*)fwd_kernel, hipFuncAttributeMaxDynamicSharedMemorySize, LDS_BYTES) != hipSuccess) { fprintf(stderr, "kernel_launch: hipFuncSetAttribute failed\n"); grid = -1; return; }
        if (hipOccupancyMaxActiveBlocksPerMultiprocessor(&per_cu, (const void*)fwd_kernel, NTHR, LDS_BYTES) != hipSuccess || per_cu < 1) { fprintf(stderr, "kernel_launch: occupancy query says %d\n", per_cu); }
        (void)hipGetLastError();
        grid = cus;
    }
    if (grid < 0) return;
    (void)hipMemsetAsync((char*)d_ws + WS_CTL, 0, CTL_ZERO_BYTES, stream);
    Args a{};
    for (int i = 0; i < 26; ++i) a.in[i] = (const float*)d_in[i];
    a.out = (float*)d_out; a.ws = (unsigned char*)d_ws;
    a.ph_lo = 0; a.ph_hi = N_PHASES_RUN;
    hipLaunchKernelGGL(fwd_kernel, dim3(grid), dim3(NTHR), LDS_BYTES, stream, a);
}
```

```cpp
#include <hip/hip_runtime.h>
#include <cstdio>
#include <cstdint>

#ifndef SELFCHECK
#define SELFCHECK 0
#endif
#ifndef N_PHASES_RUN
#define N_PHASES_RUN 24
#endif
#ifndef REP_MASK
#define REP_MASK 0u
#endif
#ifndef REP_N
#define REP_N 2
#endif
#ifndef FP8_QKV
#define FP8_QKV 1
#endif
#ifndef FP8_MIXOUT
#define FP8_MIXOUT 1
#endif
#ifndef TIMING
#define TIMING 0
#endif
#ifndef TBLK
#define TBLK 100
#endif
#ifndef TAMP
#define TAMP 8
#endif
#ifndef TSEL_A
#define TSEL_A 0
#define TSEL_A_N 1
#define TSEL_B 1
#define TSEL_B_N 1
#endif

#ifndef EN_MASK
#define EN_MASK 0xFFFFFFFFu
#endif
#define EN(b) ((EN_MASK >> (b)) & 1u)
#define GAS __attribute__((address_space(1)))
#define LAS __attribute__((address_space(3)))
typedef unsigned short bf16;
typedef short bf16x8 __attribute__((ext_vector_type(8)));
typedef short s16x4 __attribute__((ext_vector_type(4)));
typedef float f32x2 __attribute__((ext_vector_type(2)));
typedef float f32x4 __attribute__((ext_vector_type(4)));
typedef float f32x16 __attribute__((ext_vector_type(16)));
typedef unsigned u32x2 __attribute__((ext_vector_type(2)));
typedef unsigned u32x4 __attribute__((ext_vector_type(4)));
typedef short v4i16_t __attribute__((ext_vector_type(4)));

constexpr int SEQ = 8192, DM = 2048, FF = 5504, NGU = 2 * FF  , NMOD = 18432;
constexpr int NIN = 4608;
constexpr int C_U = 0, C_QT = 1024, C_KVL = 3072, C_QI = 3328, C_KI = 4352, C_WI = 4416;
constexpr int FFP = 5632;
constexpr int NCAT = 3072;
constexpr int NWAVES = 8, NTHR = 512;

constexpr size_t MiB = 1u << 20;
constexpr size_t WS_CTL = 0, CTL_ZERO_BYTES = 1 * MiB;
constexpr size_t WS_MOD = 1 * MiB;
constexpr size_t WS_S5T = WS_MOD + 256 * 1024;
constexpr size_t WS_DIAG = 3 * MiB;
constexpr size_t WS_WGU = 4 * MiB;
constexpr size_t WS_WD = WS_WGU + 172 * MiB;
constexpr size_t WS_WIN = WS_WD + 86 * MiB;
constexpr size_t WS_WQRAW = WS_WIN + 18 * MiB;
constexpr size_t WS_WUPRAW = WS_WQRAW + 8 * MiB;
constexpr size_t WS_WGLU = WS_WUPRAW + 1 * MiB;
constexpr size_t WS_WOUT = WS_WGLU + 2 * MiB;
constexpr size_t WS_WOUTB = WS_WOUT + 12 * MiB;
constexpr size_t WS_WQKV = WS_WOUTB + 8 * MiB;
constexpr size_t WS_WCOUT = WS_WQKV + 24 * MiB;
constexpr size_t WS_HN = WS_WCOUT + 8 * MiB;
constexpr size_t WS_HMID = WS_HN + 32 * MiB;
constexpr size_t WS_PROJ = WS_HMID + 86 * MiB;
constexpr size_t WS_KVN = WS_PROJ + 72 * MiB;
constexpr size_t WS_E = WS_KVN + 4 * MiB;
constexpr size_t WS_YAPRE = WS_E + 4 * MiB;
constexpr size_t WS_YCAT = WS_YAPRE + 16 * MiB;
constexpr size_t WS_SCORE = WS_YCAT + 48 * MiB;
constexpr size_t WS_Q = WS_SCORE, WS_K = WS_SCORE + 32 * MiB, WS_VT = WS_SCORE + 64 * MiB, WS_O = WS_SCORE + 96 * MiB;
constexpr size_t WS_END = WS_SCORE + 256 * MiB;
constexpr int S5_AR = 0, S5_AI = 4096, S5_A64R = 8192, S5_A64I = 12288, S5_BBR = 16384, S5_BBI = 16384 + 65536;

constexpr int CW_BAR = 4096;

constexpr int RING_BYTES = 131072;
constexpr int SCRATCH_BYTES = 155648;
constexpr int MISC_OFF = SCRATCH_BYTES;
constexpr int LDS_BYTES = SCRATCH_BYTES + 256;

#define LDS_WAIT() asm volatile("s_waitcnt lgkmcnt(0)" ::: "memory")
#define VM_WAIT() asm volatile("s_waitcnt vmcnt(0)" ::: "memory")

__device__ __forceinline__ unsigned f2bf(float f) { unsigned u = __builtin_bit_cast(unsigned, f); return (u + 0x7fffu + ((u >> 16) & 1u)) >> 16; }
__device__ __forceinline__ unsigned pk2(float lo, float hi) { unsigned r; asm volatile("v_cvt_pk_bf16_f32 %0, %1, %2" : "=v"(r) : "v"(lo), "v"(hi)); return r; }
__device__ __forceinline__ float clamp448(float x) { return __builtin_amdgcn_fmed3f(x, -448.0f, 448.0f); }
__device__ __forceinline__ unsigned pk4_fp8(float a, float b, float c, float d) {
    int w = 0; w = __builtin_amdgcn_cvt_pk_fp8_f32(clamp448(a), clamp448(b), w, false); w = __builtin_amdgcn_cvt_pk_fp8_f32(clamp448(c), clamp448(d), w, true); return (unsigned)w; }
__device__ __forceinline__ float bf2f(unsigned short b) { return __builtin_bit_cast(float, (unsigned)b << 16); }
__device__ __forceinline__ float bflo(unsigned w) { return __builtin_bit_cast(float, w << 16); }
__device__ __forceinline__ float bfhi(unsigned w) { return __builtin_bit_cast(float, w & 0xffff0000u); }
__device__ __forceinline__ float fast_exp2(float x) { return __builtin_amdgcn_exp2f(x); }
__device__ __forceinline__ float fast_rcp(float x) { return __builtin_amdgcn_rcpf(x); }
__device__ __forceinline__ float silu_f(float x) { return x * fast_rcp(1.0f + fast_exp2(-1.4426950408889634f * x)); }
__device__ __forceinline__ float sigmoid_f(float x) { return fast_rcp(1.0f + fast_exp2(-1.4426950408889634f * x)); }
__device__ __forceinline__ float gelu_tanh_f(float y) {
    const float z = 0.7978845608028654f * (y + 0.044715f * y * y * y);
    const float e = fast_exp2(2.0f * 1.4426950408889634f * z);
    const float th = 1.0f - 2.0f * fast_rcp(e + 1.0f);
    return 0.5f * y * (1.0f + th);
}
__device__ __forceinline__ float wave_sum(float v) {
#pragma unroll
    for (int o = 1; o < 64; o <<= 1) v += __shfl_xor(v, o);
    return v;
}

namespace pg8 {
constexpr int BM = 256, BK = 64, HALF = 128, HTB = HALF * BK * 2, STAGE_BYTES = 8 * HTB, NXCD = 8, WGM = 8;
__host__ __device__ __forceinline__ int lds_byte(int r, int c) { const int st = (r >> 4) * 2 + (c >> 5), rr = r & 15, cc = c & 31, ob = rr * 64 + cc * 2; return st * 1024 + (ob ^ (((ob >> 9) & 1) << 5)); }
__host__ __device__ __forceinline__ void stage_rc(int b, int& R, int& C) { const int st = b / 1024, sb = b % 1024, swz = sb ^ (((sb >> 9) & 1) << 5); R = (st >> 1) * 16 + swz / 64; C = (st & 1) * 32 + (swz % 64) / 2; }
__host__ __device__ __forceinline__ int perm32(int rho) { const int n = rho >> 4, i = rho & 15; return 8 * (i >> 2) + 4 * n + (i & 3); }

typedef int v4i_t __attribute__((ext_vector_type(4)));
typedef int v8i_t __attribute__((ext_vector_type(8)));
__device__ __forceinline__ v8i_t cat8(bf16x8 lo, bf16x8 hi) { return __builtin_shufflevector(__builtin_bit_cast(v4i_t, lo), __builtin_bit_cast(v4i_t, hi), 0, 1, 2, 3, 4, 5, 6, 7); }
__device__ __forceinline__ bf16x8 lo8(v8i_t v) { return __builtin_bit_cast(bf16x8, __builtin_shufflevector(v, v, 0, 1, 2, 3)); }
__device__ __forceinline__ bf16x8 hi8(v8i_t v) { return __builtin_bit_cast(bf16x8, __builtin_shufflevector(v, v, 4, 5, 6, 7)); }
struct Unit { int pm, pn, z, seg; };
struct Gemm { const bf16* A; const bf16* Bt; int M, N, K, lda, ldb, nz; size_t zA, zB; const bf16* A1; const bf16* Bt1; int M1, N1, nz1; size_t zA1, zB1; };

struct StaticOrder {
    int nM0, nN0, n0, nM1, nN1, ntot, G, c; int force = 0;
    __device__ void init(const Gemm& g, int G_, int c_) { nM0 = g.M / BM; nN0 = g.N / BM; n0 = nM0 * nN0 * g.nz; nM1 = g.M1 / BM; nN1 = g.N1 / BM; ntot = n0 + nM1 * nN1 * g.nz1; G = G_; c = c_; }
    __device__ bool next(int i, Unit& u) const {
        int L = i * G + c; if (L >= ntot) return false;
        const int seg = L >= n0 ? 1 : 0; if (seg) L -= n0;
        const int nM = seg ? nM1 : nM0, nN = seg ? nN1 : nN0, nwg = nM * nN;
        u.seg = seg; u.z = L / nwg;
        int wgid = L % nwg; { const int q = nwg / NXCD, r = nwg % NXCD, xcd = wgid % NXCD, off = wgid / NXCD; wgid = (xcd < r ? xcd * (q + 1) : r * (q + 1) + (xcd - r) * q) + off; }
        const int nig = WGM * nN, gid = wgid / nig, fm = gid * WGM, gsz = (nM - fm) < WGM ? (nM - fm) : WGM;
        u.pm = fm + ((wgid % nig) % gsz); u.pn = (wgid % nig) / gsz; if (force & 1) u.pm = 0; if (force & 2) u.pn = 0; return true;
    }
};

struct EpiBf16 {
    static constexpr bool PERM = true;
    bf16* O; int ldc; size_t zC; float scale; bf16* O1; int ldc1; size_t zC1; float scale1; int scale_a = 0, scale_w = 0; int fp8_1 = 0;
    __device__ __forceinline__ void operator()(const f32x4 (&acc)[2][2][4][2], const Unit& u, int wr, int wc, int fr, int fq) const {
        const int row0 = u.pm * BM + wr * 64 + fr; const int col0 = u.pn * BM + wc * 32 + 8 * fq;
        bf16* base = u.seg ? O1 + (size_t)u.z * zC1 : O + (size_t)u.z * zC; const int ldc = u.seg ? ldc1 : this->ldc; const float scale = u.seg ? scale1 : this->scale;
#pragma unroll
        for (int ai = 0; ai < 2; ++ai)
#pragma unroll
            for (int m = 0; m < 4; ++m) { bf16* rowp = base + (size_t)(row0 + ai * HALF + m * 16) * ldc + col0;
#pragma unroll
                for (int bj = 0; bj < 2; ++bj) { const f32x4 v0 = acc[ai][bj][m][0] * scale, v1 = acc[ai][bj][m][1] * scale;
                    if (u.seg && fp8_1) { u32x2 w8; w8.x = pk4_fp8(v0[0], v0[1], v0[2], v0[3]); w8.y = pk4_fp8(v1[0], v1[1], v1[2], v1[3]);
                        *(u32x2*)((unsigned char*)O1 + (size_t)u.z * zC1 + (size_t)(row0 + ai * HALF + m * 16) * ldc1 + col0 + bj * HALF) = w8; }
                    else { u32x4 w; w.x = pk2(v0[0], v0[1]); w.y = pk2(v0[2], v0[3]); w.z = pk2(v1[0], v1[1]); w.w = pk2(v1[2], v1[3]);
                    *(u32x4*)(rowp + bj * HALF) = w; } } }
    }
};
struct EpiSwiGLU {
    static constexpr bool PERM = true;
    unsigned char* O; int ldc; int scale_a, scale_w;
    __device__ __forceinline__ void operator()(const f32x4 (&acc)[2][2][4][2], const Unit& u, int wr, int wc, int fr, int fq) const {
        const int row0 = u.pm * BM + wr * 64 + fr; const int col0 = u.pn * HALF + wc * 32 + 8 * fq;
#pragma unroll
        for (int ai = 0; ai < 2; ++ai)
#pragma unroll
            for (int m = 0; m < 4; ++m) { unsigned char* rowp = O + (size_t)(row0 + ai * HALF + m * 16) * ldc + col0;
                const f32x4 g0 = acc[ai][0][m][0], g1 = acc[ai][0][m][1], u0 = acc[ai][1][m][0] * 8.0f, u1 = acc[ai][1][m][1] * 8.0f;
                u32x2 w; w.x = pk4_fp8(silu_f(g0[0]) * u0[0], silu_f(g0[1]) * u0[1], silu_f(g0[2]) * u0[2], silu_f(g0[3]) * u0[3]);
                w.y = pk4_fp8(silu_f(g1[0]) * u1[0], silu_f(g1[1]) * u1[1], silu_f(g1[2]) * u1[2], silu_f(g1[3]) * u1[3]);
                *(u32x2*)rowp = w; }
    }
};
struct EpiResid {
    static constexpr bool PERM = false;
    const float* hin; float* out; const float* gate; float coef; int scale_a, scale_w;
    __device__ __forceinline__ void operator()(const f32x4 (&acc)[2][2][4][2], const Unit& u, int wr, int wc, int fr, int fq) const {
        const int row0 = u.pm * BM + wr * 64 + fr; const int col0 = u.pn * BM + wc * 32 + 4 * fq;
        f32x4 gv[2][2];
#pragma unroll
        for (int bj = 0; bj < 2; ++bj)
#pragma unroll
            for (int n = 0; n < 2; ++n) gv[bj][n] = *(const f32x4*)(gate + col0 + bj * HALF + n * 16) * coef;
#pragma unroll
        for (int ai = 0; ai < 2; ++ai)
#pragma unroll
            for (int m = 0; m < 4; ++m) { const size_t off = (size_t)(row0 + ai * HALF + m * 16) * DM + col0;
#pragma unroll
                for (int bj = 0; bj < 2; ++bj)
#pragma unroll
                    for (int n = 0; n < 2; ++n) { const f32x4 b = *(const f32x4*)(hin + off + bj * HALF + n * 16);
                        *(f32x4*)(out + off + bj * HALF + n * 16) = b + gv[bj][n] * acc[ai][bj][m][n]; } }
    }
};
struct EpiGLU {
    static constexpr bool PERM = true;
    const bf16* yp; const float* bias; bf16* O; int ldc; int scale_a = 0, scale_w = 0;
    __device__ __forceinline__ void operator()(const f32x4 (&acc)[2][2][4][2], const Unit& u, int wr, int wc, int fr, int fq) const {
        const int row0 = u.pm * BM + wr * 64 + fr; const int col0 = u.pn * BM + wc * 32 + 8 * fq;
#pragma unroll
        for (int bj = 0; bj < 2; ++bj) { const f32x4 b0 = *(const f32x4*)(bias + col0 + bj * HALF), b1 = *(const f32x4*)(bias + col0 + bj * HALF + 4);
#pragma unroll
            for (int ai = 0; ai < 2; ++ai)
#pragma unroll
                for (int m = 0; m < 4; ++m) { const size_t r = (size_t)(row0 + ai * HALF + m * 16);
                    const u32x4 y = *(const u32x4*)(yp + r * 1024 + col0 + bj * HALF);
                    const f32x4 z0 = acc[ai][bj][m][0] + b0, z1 = acc[ai][bj][m][1] + b1;
#if FP8_MIXOUT
                    u32x2 w8; w8.x = pk4_fp8(8.f * bflo(y.x) * sigmoid_f(z0[0]), 8.f * bfhi(y.x) * sigmoid_f(z0[1]), 8.f * bflo(y.y) * sigmoid_f(z0[2]), 8.f * bfhi(y.y) * sigmoid_f(z0[3]));
                    w8.y = pk4_fp8(8.f * bflo(y.z) * sigmoid_f(z1[0]), 8.f * bfhi(y.z) * sigmoid_f(z1[1]), 8.f * bflo(y.w) * sigmoid_f(z1[2]), 8.f * bfhi(y.w) * sigmoid_f(z1[3]));
                    *(u32x2*)((unsigned char*)O + r * ldc + col0 + bj * HALF) = w8; } }
#else
                    u32x4 w; w.x = pk2(bflo(y.x) * sigmoid_f(z0[0]), bfhi(y.x) * sigmoid_f(z0[1])); w.y = pk2(bflo(y.y) * sigmoid_f(z0[2]), bfhi(y.y) * sigmoid_f(z0[3]));
                    w.z = pk2(bflo(y.z) * sigmoid_f(z1[0]), bfhi(y.z) * sigmoid_f(z1[1])); w.w = pk2(bflo(y.w) * sigmoid_f(z1[2]), bfhi(y.w) * sigmoid_f(z1[3]));
                    *(u32x4*)(O + r * ldc + col0 + bj * HALF) = w; } }
#endif
    }
};

template <class Epi, bool FP8 = false>
__device__ __forceinline__ void gemm_phase(LAS unsigned char* lds, const Gemm g, const StaticOrder& S, const Epi& E, int wave_s) {
    int lane_o = (int)__builtin_amdgcn_mbcnt_hi(~0u, __builtin_amdgcn_mbcnt_lo(~0u, 0u)); asm volatile("" : "+v"(lane_o));
    const int wid = wave_s, lane = lane_o, tid = wave_s * 64 + lane_o, wr = wid >> 2, wc = wid & 3, fr = lane & 15, fq = lane >> 4;
    const int K = g.K, nt = K / BK;
    unsigned voffA[2], voffB[2];
#pragma unroll
    for (int i = 0; i < 2; ++i) { int R, C; stage_rc(tid * 16 + i * 8192, R, C); const int Rb = Epi::PERM ? ((R & ~31) + perm32(R & 31)) : R;
        voffA[i] = (unsigned)(R * g.lda + C) * 2u; voffB[i] = (unsigned)(Rb * g.ldb + C) * 2u; }
    const size_t kstep = (size_t)(BK * 2);
    const size_t hstepA = (size_t)HALF * g.lda * 2, hstepB = (size_t)HALF * g.ldb * 2;
    const size_t tstepA = 2 * hstepA, tstepB = 2 * hstepB;
    const unsigned ldsw = (unsigned)wid * 1024u;
    const int aoff = lds_byte(wr * 64 + fr, fq * 8), boff = lds_byte(wc * 32 + fr, fq * 8);
#define PG8_SA(b, h) (((b) * 2 + (h)) * HTB)
#define PG8_SB(b, h) ((4 + (b) * 2 + (h)) * HTB)
#define PG8_STAGE(bufoff, gbase, voff) do { _Pragma("unroll") for (int _i = 0; _i < 2; ++_i) \
        __builtin_amdgcn_global_load_lds((const unsigned*)((const char*)(gbase) + (voff)[_i]), (LAS unsigned*)(lds + (bufoff) + ldsw + _i * 8192), 16, 0, 0); } while (0)
#define PG8_LDA(dst, b, h) do { _Pragma("unroll") for (int m = 0; m < 4; ++m) { const bf16x8 l_ = *(const LAS bf16x8*)(lds + PG8_SA(b, h) + aoff + m * 2048), h_ = *(const LAS bf16x8*)(lds + PG8_SA(b, h) + aoff + m * 2048 + 1024); dst[m] = cat8(l_, h_); } } while (0)
#define PG8_LDB(dst, b, h) do { _Pragma("unroll") for (int n = 0; n < 2; ++n) { const bf16x8 l_ = *(const LAS bf16x8*)(lds + PG8_SB(b, h) + boff + n * 2048), h_ = *(const LAS bf16x8*)(lds + PG8_SB(b, h) + boff + n * 2048 + 1024); dst[n] = cat8(l_, h_); } } while (0)
#define PG8_MMA(ai, bj, At, Bt) do { __builtin_amdgcn_s_setprio(1); _Pragma("unroll") for (int m = 0; m < 4; ++m) _Pragma("unroll") for (int n = 0; n < 2; ++n) { \
        if constexpr (FP8) asm volatile("v_mfma_scale_f32_16x16x128_f8f6f4 %0, %1, %2, %0, %3, %4 op_sel_hi:[0,0,0]" : "+v"(acc[ai][bj][m][n]) : "v"(Bt[n]), "v"(At[m]), "v"(sc_w), "v"(sc_a)); \
        else { acc[ai][bj][m][n] = __builtin_amdgcn_mfma_f32_16x16x32_bf16(lo8(Bt[n]), lo8(At[m]), acc[ai][bj][m][n], 0, 0, 0); acc[ai][bj][m][n] = __builtin_amdgcn_mfma_f32_16x16x32_bf16(hi8(Bt[n]), hi8(At[m]), acc[ai][bj][m][n], 0, 0, 0); } } __builtin_amdgcn_s_setprio(0); } while (0)
#define PG8_WAIT_V(n) asm volatile("s_waitcnt vmcnt(" #n ")" ::: "memory")
#define PG8_WAIT_L(n) asm volatile("s_waitcnt lgkmcnt(" #n ")" ::: "memory")
#define PG8_BAR __builtin_amdgcn_s_barrier()
#define PG8_SCHED __builtin_amdgcn_sched_barrier(0)
    Unit cur, nxt; int ui = 0;
    if (!S.next(0, cur)) return;
    f32x4 acc[2][2][4][2];
#pragma unroll
    for (int a = 0; a < 2; ++a)
#pragma unroll
        for (int b = 0; b < 2; ++b)
#pragma unroll
            for (int m = 0; m < 4; ++m)
#pragma unroll
                for (int n = 0; n < 2; ++n) acc[a][b][m][n] = (f32x4){0.f, 0.f, 0.f, 0.f};
    v8i_t At[4], B0[2], B1[2];
    int sc_w = E.scale_w, sc_a = E.scale_a;
#define PG8_ABASE(u) ((const char*)((u).seg ? g.A1 + (size_t)(u).z * g.zA1 : g.A + (size_t)(u).z * g.zA) + (size_t)(u).pm * tstepA)
#define PG8_BBASE(u) ((const char*)((u).seg ? g.Bt1 + (size_t)(u).z * g.zB1 : g.Bt + (size_t)(u).z * g.zB) + (size_t)(u).pn * tstepB)
    const char* cA = PG8_ABASE(cur); const char* cB = PG8_BBASE(cur);
    PG8_STAGE(PG8_SB(0, 0), cB, voffB); PG8_STAGE(PG8_SB(0, 1), cB + hstepB, voffB); PG8_STAGE(PG8_SA(0, 0), cA, voffA); PG8_STAGE(PG8_SA(0, 1), cA + hstepA, voffA);
    if (wr == 1) PG8_BAR;
    PG8_WAIT_V(2); PG8_BAR;
    PG8_STAGE(PG8_SB(1, 0), cB + kstep, voffB); PG8_STAGE(PG8_SA(1, 0), cA + kstep, voffA); PG8_STAGE(PG8_SB(1, 1), cB + hstepB + kstep, voffB);
    PG8_WAIT_V(6); PG8_BAR;
    for (;;) {
        const bool has_next = S.next(ui + 1, nxt);
        const char* nA = has_next ? PG8_ABASE(nxt) : cA; const char* nB = has_next ? PG8_BBASE(nxt) : cB;
        for (int t = 0; t < nt; t += 2) {
            const bool last = (t == nt - 2);
            const char* a1 = cA + (size_t)(t + 1) * kstep;
            const char* a2 = last ? nA : cA + (size_t)(t + 2) * kstep; const char* b2 = last ? nB : cB + (size_t)(t + 2) * kstep;
            const char* a3 = a2 + kstep; const char* b3 = b2 + kstep;
            PG8_LDB(B0, 0, 0); PG8_LDB(B1, 0, 1); PG8_SCHED; PG8_LDA(At, 0, 0); PG8_STAGE(PG8_SA(1, 1), a1 + hstepA, voffA);
            PG8_WAIT_V(8); PG8_WAIT_L(0); PG8_BAR; PG8_MMA(0, 0, At, B0); PG8_MMA(0, 1, At, B1); PG8_BAR; PG8_SCHED;
            PG8_LDA(At, 0, 1); PG8_STAGE(PG8_SB(0, 0), b2, voffB); PG8_STAGE(PG8_SB(0, 1), b2 + hstepB, voffB); PG8_STAGE(PG8_SA(0, 0), a2, voffA);
            PG8_WAIT_V(8); PG8_WAIT_L(0); PG8_BAR; PG8_MMA(1, 0, At, B0); PG8_MMA(1, 1, At, B1); PG8_BAR; PG8_SCHED;
            PG8_LDB(B0, 1, 0); PG8_LDB(B1, 1, 1); PG8_SCHED; PG8_LDA(At, 1, 0); PG8_STAGE(PG8_SA(0, 1), a2 + hstepA, voffA);
            PG8_WAIT_V(8); PG8_WAIT_L(0); PG8_BAR; PG8_MMA(0, 0, At, B0); PG8_MMA(0, 1, At, B1); PG8_BAR; PG8_SCHED;
            PG8_LDA(At, 1, 1); PG8_STAGE(PG8_SB(1, 0), b3, voffB); PG8_STAGE(PG8_SB(1, 1), b3 + hstepB, voffB); PG8_STAGE(PG8_SA(1, 0), a3, voffA);
            PG8_WAIT_V(8); PG8_WAIT_L(0); PG8_BAR; PG8_MMA(1, 0, At, B0); PG8_MMA(1, 1, At, B1); PG8_BAR; PG8_SCHED;
        }
        if (wr == 0) PG8_BAR;
        if constexpr (FP8) asm volatile("s_nop 15\n\ts_nop 15" ::: "memory");
        E(acc, cur, wr, wc, fr, fq);
        if (!has_next) break;
#pragma unroll
        for (int a = 0; a < 2; ++a)
#pragma unroll
            for (int b = 0; b < 2; ++b)
#pragma unroll
                for (int m = 0; m < 4; ++m)
#pragma unroll
                    for (int n = 0; n < 2; ++n) acc[a][b][m][n] = (f32x4){0.f, 0.f, 0.f, 0.f};
        cur = nxt; cA = nA; cB = nB; ++ui;
        if (wr == 1) PG8_BAR;
    }
    PG8_WAIT_V(0);
    PG8_BAR;
#undef PG8_ABASE
#undef PG8_BBASE
#undef PG8_SA
#undef PG8_SB
#undef PG8_STAGE
#undef PG8_LDA
#undef PG8_LDB
#undef PG8_MMA
#undef PG8_WAIT_V
#undef PG8_WAIT_L
#undef PG8_BAR
#undef PG8_SCHED
}
}

#define XB_TMO      128
#define XB_XCNT(j)  (256  + 64 * (j))
#define XB_XSUB(j)  (1280 + 64 * (j))
#define XB_XGEN(j)  (2304 + 64 * (j))
#define XB_TOP      3328
#define XB_TOPGEN   3392
#define XCD_BAR_WORDS 3456
#define XB_SPIN_CAP (1u << 18)
__device__ __forceinline__ unsigned xb_ld(unsigned* p)              { return __hip_atomic_load(p, __ATOMIC_RELAXED, __HIP_MEMORY_SCOPE_AGENT); }
__device__ __forceinline__ unsigned xb_add(unsigned* p, unsigned v) { return __hip_atomic_fetch_add(p, v, __ATOMIC_RELAXED, __HIP_MEMORY_SCOPE_AGENT); }
__device__ __forceinline__ unsigned xb_xcc_id() { return (unsigned)__builtin_amdgcn_s_getreg((3 << 11) | 20) & 0xFu; }
#define XB_SPIN(cond, bar) do { unsigned _sp = 0; while (cond) { __builtin_amdgcn_s_sleep(1); \
    if ((++_sp & 255u) == 0u) { if (xb_ld(&(bar)[XB_TMO])) break; if (_sp > XB_SPIN_CAP) { atomicAdd(&(bar)[XB_TMO], 1u); break; } } } } while (0)
struct XcdBarrier { unsigned* bar; unsigned x; volatile LAS unsigned* st; int wave; };
__device__ __forceinline__ XcdBarrier xcd_barrier_post(unsigned* bar, volatile LAS unsigned* st) {
    XcdBarrier b; b.bar = bar; b.x = xb_xcc_id(); b.st = st;
    if (threadIdx.x == 0) (void)xb_add(&bar[XB_XCNT(b.x)], 1u);
    return b;
}
__device__ __forceinline__ void xcd_barrier_complete(unsigned* bar, unsigned x, unsigned& nloc, unsigned& nx) {
    const unsigned G = gridDim.x * gridDim.y * gridDim.z;
    unsigned sum, cnt, mine, sp = 0u;
    for (;;) {
        sum = 0u; cnt = 0u; mine = 0u;
#pragma unroll
        for (unsigned j = 0; j < 16; ++j) { const unsigned c = xb_ld(&bar[XB_XCNT(j)]); sum += c; cnt += (c > 0u) ? 1u : 0u; mine = (j == x) ? c : mine; }
        if (sum == G) break;
        __builtin_amdgcn_s_sleep(1);
        if ((++sp & 255u) == 0u) { if (xb_ld(&bar[XB_TMO])) break; if (sp > XB_SPIN_CAP) { atomicAdd(&bar[XB_TMO], 1u); break; } }
    }
    nloc = mine > 0u ? mine : 1u; nx = cnt > 0u ? cnt : 1u;
}
__device__ __forceinline__ void xcd_barrier(const XcdBarrier& b) {
    asm volatile("s_waitcnt vmcnt(0)" ::: "memory");
    __syncthreads();
    if (b.wave == 0 && __builtin_amdgcn_mbcnt_hi(~0u, __builtin_amdgcn_mbcnt_lo(~0u, 0u)) == 0u) {
        unsigned* bar = b.bar;
        __builtin_amdgcn_s_waitcnt(0);
        unsigned nloc = b.st[0], nx = b.st[1];
        if (nloc == 0u) { xcd_barrier_complete(bar, b.x, nloc, nx); b.st[0] = nloc; b.st[1] = nx; }
        const unsigned old = xb_add(&bar[XB_XSUB(b.x)], 1u);
        const unsigned gen = old / nloc;
        if (old + 1u == (gen + 1u) * nloc) {
            __builtin_amdgcn_fence(__ATOMIC_RELEASE, "agent");
            asm volatile("s_waitcnt vmcnt(0)" ::: "memory");
            const unsigned og = xb_add(&bar[XB_TOP], 1u);
            const unsigned tg = og / nx;
            if (og + 1u == (tg + 1u) * nx) xb_add(&bar[XB_TOPGEN], 1u);
            else XB_SPIN(xb_ld(&bar[XB_TOPGEN]) == tg, bar);
            __builtin_amdgcn_fence(__ATOMIC_ACQUIRE, "agent");
            xb_add(&bar[XB_XGEN(b.x)], 1u);
            asm volatile("s_waitcnt vmcnt(0)" ::: "memory");
        } else {
            XB_SPIN(xb_ld(&bar[XB_XGEN(b.x)]) == gen, bar);
            __builtin_amdgcn_fence(__ATOMIC_ACQUIRE, "agent");
            asm volatile("s_waitcnt vmcnt(0)" ::: "memory");
        }
    }
    __syncthreads();
}

#ifndef DSA_XREP
#define DSA_XREP 0
#define DSA_XF 0
#endif
#ifndef DSA_REP_P1
#define DSA_REP_P1 1
#endif
#ifndef DSA_REP_P2
#define DSA_REP_P2 1
#endif
#ifndef DSA_REP_ATT
#define DSA_REP_ATT 1
#endif
__device__ __forceinline__ int opaque_int(int n) { asm volatile("" : "+s"(n)); return n; }
__device__ __forceinline__ int ph_reps(int k) { int n = ((REP_MASK >> k) & 1u) ? REP_N : 1; asm volatile("" : "+s"(n)); return n; }
struct Args { const float* in[26]; float* out; unsigned char* ws; int ph_lo, ph_hi; };
enum { I_X = 0, I_C, I_ADAW, I_ADAB, I_NORMG, I_WG, I_WU, I_WDN, I_ABWIN, I_LRE, I_LIM, I_LOGDT, I_BRE, I_BIM, I_CRE, I_CIM, I_S5D, I_WGLU, I_BGLU, I_KVG, I_WKVUP, I_ABWOUT,
       I_CWQKV, I_RELB, I_CWOUT, I_FING };

__device__ __forceinline__ void tr_item(const float* src, int ldsrc, int nvalid, int k0, int n0, bf16* dst, int lddst, LAS float* scr, int lane) {
    const int nn = n0 + (lane & 31); const bool ok = nn < nvalid;
#pragma unroll 8
    for (int i = 0; i < 32; ++i) { const int kk = 2 * i + (lane >> 5); scr[kk * 33 + (lane & 31)] = ok ? __builtin_nontemporal_load(src + (size_t)(k0 + kk) * ldsrc + nn) : 0.f; }
    LDS_WAIT(); asm volatile("" ::: "memory");
    const int c = lane & 7;
#pragma unroll
    for (int j = 0; j < 4; ++j) { const int n = (lane >> 3) + 8 * j; const LAS float* s = scr + (8 * c) * 33 + n;
        u32x4 o; o.x = pk2(s[0 * 33], s[1 * 33]); o.y = pk2(s[2 * 33], s[3 * 33]); o.z = pk2(s[4 * 33], s[5 * 33]); o.w = pk2(s[6 * 33], s[7 * 33]);
        if (n0 + n < nvalid) *(u32x4*)(dst + (size_t)n * lddst + 8 * c) = o; }
    LDS_WAIT(); asm volatile("" ::: "memory");
}

__device__ __forceinline__ void tr_item8(const float* src, int ldsrc, int k0, int n0, unsigned char* dst, int lddst, float scale, LAS float* scr, int lane) {
    const int nn = n0 + (lane & 31);
#pragma unroll 8
    for (int i = 0; i < 32; ++i) { const int kk = 2 * i + (lane >> 5); scr[kk * 33 + (lane & 31)] = src[(size_t)(k0 + kk) * ldsrc + nn] * scale; }
    LDS_WAIT(); asm volatile("" ::: "memory");
    const int n = lane & 31, kh = lane >> 5; const LAS float* sp = scr + (32 * kh) * 33 + n;
    u32x4 o0, o1;
    o0.x = pk4_fp8(sp[0 * 33], sp[1 * 33], sp[2 * 33], sp[3 * 33]); o0.y = pk4_fp8(sp[4 * 33], sp[5 * 33], sp[6 * 33], sp[7 * 33]);
    o0.z = pk4_fp8(sp[8 * 33], sp[9 * 33], sp[10 * 33], sp[11 * 33]); o0.w = pk4_fp8(sp[12 * 33], sp[13 * 33], sp[14 * 33], sp[15 * 33]);
    o1.x = pk4_fp8(sp[16 * 33], sp[17 * 33], sp[18 * 33], sp[19 * 33]); o1.y = pk4_fp8(sp[20 * 33], sp[21 * 33], sp[22 * 33], sp[23 * 33]);
    o1.z = pk4_fp8(sp[24 * 33], sp[25 * 33], sp[26 * 33], sp[27 * 33]); o1.w = pk4_fp8(sp[28 * 33], sp[29 * 33], sp[30 * 33], sp[31 * 33]);
    unsigned char* d = dst + (size_t)n * lddst + 32 * kh;
    *(u32x4*)d = o0; *(u32x4*)(d + 16) = o1;
    LDS_WAIT(); asm volatile("" ::: "memory");
}

template <bool FP8>
__device__ __forceinline__ void tr_item64(const float* src, int ldsrc, int k0, int n0, void* dst, int lddst, float scale, LAS float* scr, int lane) {
    const float* sp = src + (size_t)(k0 + (lane >> 4)) * ldsrc + n0 + 4 * (lane & 15);
    f32x4 v[16];
#pragma unroll
    for (int i = 0; i < 16; ++i) v[i] = __builtin_nontemporal_load((const f32x4*)(sp + (size_t)(4 * i) * ldsrc));
#pragma unroll
    for (int i = 0; i < 16; ++i) { LAS float* w = scr + (4 * i + (lane >> 4)) * 65 + 4 * (lane & 15); w[0] = v[i].x * scale; w[1] = v[i].y * scale; w[2] = v[i].z * scale; w[3] = v[i].w * scale; }
    LDS_WAIT(); asm volatile("" ::: "memory");
    if (FP8) {
        const int c = lane & 3;
#pragma unroll
        for (int j = 0; j < 4; ++j) { const int n = 16 * j + (lane >> 2); const LAS float* r = scr + (16 * c) * 65 + n;
            u32x4 o; o.x = pk4_fp8(r[0], r[65], r[130], r[195]); o.y = pk4_fp8(r[260], r[325], r[390], r[455]); o.z = pk4_fp8(r[520], r[585], r[650], r[715]); o.w = pk4_fp8(r[780], r[845], r[910], r[975]);
            *(u32x4*)((unsigned char*)dst + (size_t)n * lddst + 16 * c) = o; }
    } else {
        const int c = lane & 7;
#pragma unroll
        for (int j = 0; j < 8; ++j) { const int n = 8 * j + (lane >> 3); const LAS float* r = scr + (8 * c) * 65 + n;
            u32x4 o; o.x = pk2(r[0], r[65]); o.y = pk2(r[130], r[195]); o.z = pk2(r[260], r[325]); o.w = pk2(r[390], r[455]);
            *(u32x4*)((bf16*)dst + (size_t)n * lddst + 8 * c) = o; }
    }
    LDS_WAIT(); asm volatile("" ::: "memory");
}

constexpr int CI_NFFN = 4 * 3 * 2752, CI_NIN = 32 * 107, CI_NGLU = 16 * 16, CI_NOUT = 32 * 32, CI_NQKV = 32 * 96, CI_NCO = 32 * 32;
constexpr int CI_IN = CI_NFFN, CI_GLU = CI_IN + CI_NIN, CI_OUT = CI_GLU + CI_NGLU, CI_QKV = CI_OUT + CI_NOUT, CI_CO = CI_QKV + CI_NQKV, CI_END = CI_CO + CI_NCO;
#define CI_FFN(f) ((f) * 8256)
__device__ __forceinline__ void conv_item(const Args& a, int it, LAS float* scr, int lane) {
    unsigned char* ws = a.ws;
    unsigned char* Wgu = ws + WS_WGU; unsigned char* Wd = ws + WS_WD; bf16* Win = (bf16*)(ws + WS_WIN); bf16* Wglu = (bf16*)(ws + WS_WGLU);
    bf16* Wout = (bf16*)(ws + WS_WOUT); bf16* Woutb = (bf16*)(ws + WS_WOUTB); bf16* Wqkv = (bf16*)(ws + WS_WQKV); bf16* Wcout = (bf16*)(ws + WS_WCOUT);
    constexpr int I_FFN = CI_NFFN, I_IN = CI_NIN, I_GLU = CI_NGLU, I_OUT = CI_NOUT, I_QKV = CI_NQKV;
    do {
        int r = it;
        if (r < I_FFN) {
            const int f = r / 8256, rr = r % 8256, which = rr / 2752, q = rr % 2752;
            if (which < 2) { const int kb = q / 86, nb = q % 86, n0 = 64 * nb, k0 = 64 * kb;
                const float* src = a.in[which ? I_WU : I_WG] + (size_t)f * DM * FF;
                const int row = 256 * (n0 / 128) + (n0 % 128) + 128 * which;
                tr_item64<true>(src, FF, k0, n0, Wgu + (size_t)f * NGU * DM + (size_t)row * DM + k0, DM, 64.0f, scr, lane);
            } else { const int kb = q / 32, nb = q % 32, n0 = 64 * nb, k0 = 64 * kb;
                const float* src = a.in[I_WDN] + (size_t)f * FF * DM;
                tr_item64<true>(src, DM, k0, n0, Wd + (size_t)f * DM * FFP + (size_t)n0 * FFP + k0, FFP, 128.0f, scr, lane); }
            break; }
        r -= I_FFN;
        if (r < I_IN) { const int kb = r / 107, nb = r % 107, n0 = 32 * nb, k0 = 64 * kb;
            if (n0 >= 1024 && n0 < 2048) break;
            const int row = n0 + (n0 >= 2048 ? 1024 : 0);
            tr_item(a.in[I_ABWIN], 3408, 3408, k0, n0, Win + (size_t)row * DM + k0, DM, scr, lane); break; }
        r -= I_IN;
        if (r < I_GLU) { const int kb = r / 16, nb = r % 16, n0 = 64 * nb, k0 = 64 * kb;
            tr_item64<false>(a.in[I_WGLU], 1024, k0, n0, Wglu + (size_t)n0 * 1024 + k0, 1024, 1.0f, scr, lane); break; }
        r -= I_GLU;
        if (r < I_OUT) { const int kb = r / 32, nb = r % 32, n0 = 64 * nb, k0 = 64 * kb;
#if FP8_MIXOUT
            if (k0 < 1024) tr_item64<true>(a.in[I_ABWOUT], DM, k0, n0, (unsigned char*)Wout + (size_t)n0 * NCAT + k0, NCAT, 64.0f, scr, lane);
#else
            if (k0 < 1024) tr_item64<false>(a.in[I_ABWOUT], DM, k0, n0, Wout + (size_t)n0 * NCAT + k0, NCAT, 1.0f, scr, lane);
#endif
            else           tr_item64<false>(a.in[I_ABWOUT], DM, k0, n0, Woutb + (size_t)n0 * DM + k0, DM, 1.0f, scr, lane);
            break; }
        r -= I_OUT;
        if (r < I_QKV) { const int kb = r / 96, nb = r % 96, n0 = 64 * nb, k0 = 64 * kb;
#if FP8_QKV
            tr_item64<true>(a.in[I_CWQKV], 6144, k0, n0, (unsigned char*)Wqkv + (size_t)n0 * DM + k0, DM, 64.0f, scr, lane); break; }
#else
            tr_item64<false>(a.in[I_CWQKV], 6144, k0, n0, Wqkv + (size_t)n0 * DM + k0, DM, 1.0f, scr, lane); break; }
#endif
        r -= I_QKV;
        { const int kb = r / 32, nb = r % 32, n0 = 64 * nb, k0 = 64 * kb;
#if FP8_MIXOUT
            tr_item64<true>(a.in[I_CWOUT], DM, k0, n0, (unsigned char*)Wcout + (size_t)n0 * DM + k0, DM, 64.0f, scr, lane); }
#else
            tr_item64<false>(a.in[I_CWOUT], DM, k0, n0, Wcout + (size_t)n0 * DM + k0, DM, 1.0f, scr, lane); }
#endif
    } while (0);
}
template <int L0, int N0, int L1 = 0, int N1 = 0, int L2 = 0, int N2 = 0, int L3 = 0, int N3 = 0>
__device__ __forceinline__ void conv_ranges(const Args& a, LAS unsigned char* lds, int wkr, int nwkr, int wave, int lane) {
    LAS float* scr = (LAS float*)(lds + wave * 16640);
    constexpr int tot = N0 + N1 + N2 + N3;
    for (int v = wkr; v < tot; v += nwkr) {
        int it;
        if (v < N0) it = L0 + v; else if (v < N0 + N1) it = L1 + (v - N0); else if (v < N0 + N1 + N2) it = L2 + (v - N0 - N1); else it = L3 + (v - N0 - N1 - N2);
        conv_item(a, it, scr, lane); }
}
template <int L0, int N0, int L1 = 0, int N1 = 0, int L2 = 0, int N2 = 0, int L3 = 0, int N3 = 0>
__device__ __forceinline__ void conv_fill(const Args& a, LAS unsigned char* lds, int G, int ntot, int wave_s) {
    const int rem = ntot % G;
    if (rem == 0 || (int)blockIdx.x < rem) return;
    int lane_o = (int)__builtin_amdgcn_mbcnt_hi(~0u, __builtin_amdgcn_mbcnt_lo(~0u, 0u)); asm volatile("" : "+v"(lane_o));
    conv_ranges<L0, N0, L1, N1, L2, N2, L3, N3>(a, lds, ((int)blockIdx.x - rem) * NWAVES + wave_s, (G - rem) * NWAVES, wave_s, lane_o);
}

__device__ __forceinline__ void p0_prologue(const Args& a, LAS unsigned char* lds, int G, int wave_s) {
    int lane_o = (int)__builtin_amdgcn_mbcnt_hi(~0u, __builtin_amdgcn_mbcnt_lo(~0u, 0u)); asm volatile("" : "+v"(lane_o)); const int lane = lane_o, wave = wave_s, tid_o = wave_s * 64 + lane_o;
    unsigned char* ws = a.ws;
    const int tid = tid_o;
    {
        LAS float* cond = (LAS float*)(lds + 140000); LAS float* red = (LAS float*)(lds + 135168);
        for (int k = tid; k < DM; k += NTHR) cond[k] = silu_f(a.in[I_C][k]);
        __syncthreads();
        float* mod = (float*)(ws + WS_MOD);
        for (int u = blockIdx.x; u < 256; u += G) {
            const int n0 = 144 * u;
            if (lane < 36) {
                const float* w = a.in[I_ADAW] + (size_t)(n0 / NMOD) * DM * NMOD + (size_t)(wave * 256) * NMOD + (n0 % NMOD) + 4 * lane;
                f32x4 s4 = (f32x4){0.f, 0.f, 0.f, 0.f};
#pragma unroll 1
                for (int kb = 0; kb < 256; kb += 32) { f32x4 v[32];
#pragma unroll
                    for (int k = 0; k < 32; ++k) v[k] = __builtin_nontemporal_load((const f32x4*)(w + (size_t)(kb + k) * NMOD));
#pragma unroll
                    for (int k = 0; k < 32; ++k) s4 += v[k] * cond[wave * 256 + kb + k]; }
                *(LAS f32x4*)(red + wave * 144 + 4 * lane) = s4;
            }
            __syncthreads();
            if (tid < 144) { float sum = 0.f;
#pragma unroll
                for (int w8 = 0; w8 < 8; ++w8) sum += red[w8 * 144 + tid];
                mod[n0 + tid] = sum + a.in[I_ADAB][n0 + tid]; }
            __syncthreads();
        }
    }
    conv_ranges<CI_FFN(0), 5504, CI_OUT + 512, 512>(a, lds, blockIdx.x * NWAVES + wave, G * NWAVES, wave, lane);
    {
        const int gt = blockIdx.x * NTHR + tid, NGT = G * NTHR;
        bf16* Wqraw = (bf16*)(ws + WS_WQRAW); bf16* Wupraw = (bf16*)(ws + WS_WUPRAW); bf16* Win = (bf16*)(ws + WS_WIN); unsigned char* Wd = ws + WS_WD;
        for (int i = gt; i < 2048 * 256; i += NGT) { const int k = i >> 8, d4 = (i & 255) * 4; const f32x4 v = *(const f32x4*)(a.in[I_ABWIN] + (size_t)k * 3408 + 1024 + d4);
            u32x2 o; o.x = pk2(v.x, v.y); o.y = pk2(v.z, v.w); *(u32x2*)(Wqraw + (size_t)k * DM + d4) = o; }
        for (int i = gt; i < 256 * 512; i += NGT) { const f32x4 v = *(const f32x4*)(a.in[I_WKVUP] + (size_t)i * 4);
            u32x2 o; o.x = pk2(v.x, v.y); o.y = pk2(v.z, v.w); *(u32x2*)(Wupraw + (size_t)i * 4) = o; }
        for (int i = gt; i < (NIN - 4432) * DM / 8; i += NGT) *(u32x4*)(Win + (size_t)4432 * DM + (size_t)i * 8) = (u32x4){0u, 0u, 0u, 0u};
        for (int i = gt; i < 4 * DM * 8; i += NGT) *(u32x4*)(Wd + (size_t)(i >> 3) * FFP + FF + 16 * (i & 7)) = (u32x4){0u, 0u, 0u, 0u};
        for (int i = gt; i < SEQ * 8; i += NGT) *(u32x4*)(ws + WS_HMID + (size_t)(i >> 3) * FFP + FF + 16 * (i & 7)) = (u32x4){0u, 0u, 0u, 0u};
        if (gt < 4096) { const int g = gt >> 6;
            const double dt = exp((double)a.in[I_LOGDT][g]); const double lr = a.in[I_LRE][gt], li = a.in[I_LIM][gt];
            const double mag = exp(lr * dt), ar = mag * cos(li * dt), ai = mag * sin(li * dt);
            const double den = lr * lr + li * li, nr = ar - 1.0, fre = (nr * lr + ai * li) / den, fim = (ai * lr - nr * li) / den;
            const double m64 = exp(64.0 * lr * dt), a64r = m64 * cos(64.0 * li * dt), a64i = m64 * sin(64.0 * li * dt);
            float* T = (float*)(ws + WS_S5T);
            T[S5_AR + gt] = (float)ar; T[S5_AI + gt] = (float)ai; T[S5_A64R + gt] = (float)a64r; T[S5_A64I + gt] = (float)a64i;
            for (int c = 0; c < 16; ++c) { const double br = a.in[I_BRE][gt * 16 + c], bi = a.in[I_BIM][gt * 16 + c];
                T[S5_BBR + gt * 16 + c] = (float)(fre * br - fim * bi); T[S5_BBI + gt * 16 + c] = (float)(fre * bi + fim * br); }
        }
    }
}

template <bool FINAL, bool OUT8 = false>
__device__ __forceinline__ void norm_phase(const float* hin, const float* gvec, const float* shift, const float* scale, bf16* hn, float* fout, int G, int wave_s) {
    int lane_o = (int)__builtin_amdgcn_mbcnt_hi(~0u, __builtin_amdgcn_mbcnt_lo(~0u, 0u)); asm volatile("" : "+v"(lane_o)); const int lane = lane_o, wave = wave_s, tid_o = wave_s * 64 + lane_o;
    const int gw = blockIdx.x * NWAVES + wave, NGW = G * NWAVES;
    f32x4 gs[8], sh[8];
#pragma unroll
    for (int j = 0; j < 8; ++j) { const int c = 4 * lane + 256 * j; const f32x4 gg = *(const f32x4*)(gvec + c);
        if (FINAL) { gs[j] = gg; sh[j] = (f32x4){0.f, 0.f, 0.f, 0.f}; }
        else { const f32x4 sc = *(const f32x4*)(scale + c); gs[j] = gg * (sc + 1.0f); sh[j] = *(const f32x4*)(shift + c); } }
    for (int m = gw; m < SEQ; m += NGW) {
        const f32x4* xr = (const f32x4*)(hin + (size_t)m * DM) + lane;
        f32x4 v[8]; float s = 0.f;
#pragma unroll
        for (int j = 0; j < 8; ++j) { v[j] = xr[64 * j]; s += (v[j].x * v[j].x + v[j].y * v[j].y) + (v[j].z * v[j].z + v[j].w * v[j].w); }
        const float rstd = 1.0f / sqrtf(wave_sum(s) * (1.0f / DM) + 1e-6f);
        if (FINAL) { f32x4* o = (f32x4*)(fout + (size_t)m * DM) + lane;
#pragma unroll
            for (int j = 0; j < 8; ++j) o[64 * j] = v[j] * rstd * gs[j];
        } else if (OUT8) { unsigned* o = (unsigned*)((unsigned char*)hn + (size_t)m * DM) + lane;
#pragma unroll
            for (int j = 0; j < 8; ++j) { const f32x4 y = (v[j] * rstd * gs[j] + sh[j]) * 8.0f; o[64 * j] = pk4_fp8(y.x, y.y, y.z, y.w); }
        } else { u32x2* o = (u32x2*)(hn + (size_t)m * DM) + lane;
#pragma unroll
            for (int j = 0; j < 8; ++j) { const f32x4 y = v[j] * rstd * gs[j] + sh[j]; u32x2 w; w.x = pk2(y.x, y.y); w.y = pk2(y.z, y.w); o[64 * j] = w; } }
    }
}

__device__ __forceinline__ void s5_stage_u(const bf16* proj, int g, int j, LAS float* ut, int lane) {
    const u32x4* p = (const u32x4*)(proj + (size_t)(64 * j + lane) * NIN + C_U + 16 * g);
    const u32x4 a = p[0], b = p[1];
    LAS f32x4* o = (LAS f32x4*)(ut + lane * 16);
    o[0] = (f32x4){bflo(a.x), bfhi(a.x), bflo(a.y), bfhi(a.y)}; o[1] = (f32x4){bflo(a.z), bfhi(a.z), bflo(a.w), bfhi(a.w)};
    o[2] = (f32x4){bflo(b.x), bfhi(b.x), bflo(b.y), bfhi(b.y)}; o[3] = (f32x4){bflo(b.z), bfhi(b.z), bflo(b.w), bfhi(b.w)};
    LDS_WAIT(); asm volatile("" ::: "memory");
}
__device__ __forceinline__ void phase_a2(const Args& a, LAS unsigned char* lds, int G, int wave_s) {
    int lane_o = (int)__builtin_amdgcn_mbcnt_hi(~0u, __builtin_amdgcn_mbcnt_lo(~0u, 0u)); asm volatile("" : "+v"(lane_o)); const int lane = lane_o, wave = wave_s, tid_o = wave_s * 64 + lane_o;
    unsigned char* ws = a.ws; const bf16* proj = (const bf16*)(ws + WS_PROJ);
    const int gw = blockIdx.x * NWAVES + wave, NGW = G * NWAVES;
    { bf16* kvn = (bf16*)(ws + WS_KVN); const f32x4 gg = *(const f32x4*)(a.in[I_KVG] + 4 * lane);
      for (int m = gw; m < SEQ; m += NGW) { const u32x2 w = *(const u32x2*)(proj + (size_t)m * NIN + C_KVL + 4 * lane);
          const f32x4 v = (f32x4){bflo(w.x), bfhi(w.x), bflo(w.y), bfhi(w.y)};
          const float s = wave_sum((v.x * v.x + v.y * v.y) + (v.z * v.z + v.w * v.w)); const float rstd = 1.0f / sqrtf(s * (1.0f / 256.0f) + 1e-6f);
          const f32x4 y = v * rstd * gg; u32x2 o; o.x = pk2(y.x, y.y); o.y = pk2(y.z, y.w); *(u32x2*)(kvn + (size_t)m * 256 + 4 * lane) = o; } }
    const float* T = (const float*)(ws + WS_S5T); float* E = (float*)(ws + WS_E);
    LAS float* ut = (LAS float*)(lds + wave * 8192);
    for (int u = gw; u < 64 * 128; u += NGW) { const int g = u & 63, j = u >> 6, sp = g * 64 + lane;
        s5_stage_u(proj, g, j, ut, lane);
        const float ar = T[S5_AR + sp], ai = T[S5_AI + sp];
        float bbr[16], bbi[16];
#pragma unroll
        for (int c4 = 0; c4 < 4; ++c4) { const f32x4 r = *(const f32x4*)(T + S5_BBR + sp * 16 + 4 * c4), i = *(const f32x4*)(T + S5_BBI + sp * 16 + 4 * c4);
            bbr[4 * c4] = r.x; bbr[4 * c4 + 1] = r.y; bbr[4 * c4 + 2] = r.z; bbr[4 * c4 + 3] = r.w; bbi[4 * c4] = i.x; bbi[4 * c4 + 1] = i.y; bbi[4 * c4 + 2] = i.z; bbi[4 * c4 + 3] = i.w; }
        float xr = 0.f, xi = 0.f;
        for (int t = 0; t < 64; ++t) { const LAS f32x4* up = (const LAS f32x4*)(ut + t * 16); float bur = 0.f, bui = 0.f;
#pragma unroll
            for (int c4 = 0; c4 < 4; ++c4) { const f32x4 uv = up[c4];
                bur += bbr[4 * c4] * uv.x + bbr[4 * c4 + 1] * uv.y + bbr[4 * c4 + 2] * uv.z + bbr[4 * c4 + 3] * uv.w;
                bui += bbi[4 * c4] * uv.x + bbi[4 * c4 + 1] * uv.y + bbi[4 * c4 + 2] * uv.z + bbi[4 * c4 + 3] * uv.w; }
            const float nr = ar * xr - ai * xi + bur, ni = ar * xi + ai * xr + bui; xr = nr; xi = ni; }
        E[(size_t)(g * 128 + j) * 64 + lane] = xr; E[(size_t)(64 * 128 * 64) + (size_t)(g * 128 + j) * 64 + lane] = xi;
        LDS_WAIT(); asm volatile("" ::: "memory");
    }
}

__device__ __forceinline__ void s5_scan_out(const Args& a, LAS unsigned char* lds, int G, int wave_s) {
    int lane_o = (int)__builtin_amdgcn_mbcnt_hi(~0u, __builtin_amdgcn_mbcnt_lo(~0u, 0u)); asm volatile("" : "+v"(lane_o)); const int lane = lane_o, wave = wave_s, tid_o = wave_s * 64 + lane_o;
    unsigned char* ws = a.ws; const bf16* proj = (const bf16*)(ws + WS_PROJ);
    const int gw = blockIdx.x * NWAVES + wave, NGW = G * NWAVES;
    const float* T = (const float*)(ws + WS_S5T); const float* E = (const float*)(ws + WS_E); bf16* yap = (bf16*)(ws + WS_YAPRE);
    LAS float* ut = (LAS float*)(lds + wave * 16384);
    LAS unsigned char* X = lds + wave * 16384 + 4096;
    const int fr = lane & 15, fq = lane >> 4;
    for (int wu = gw; wu < 2048; wu += NGW) { const int g = wu & 63, jb = (wu >> 6) * 4, sp = g * 64 + lane;
        const float ar = T[S5_AR + sp], ai = T[S5_AI + sp], a64r = T[S5_A64R + sp], a64i = T[S5_A64I + sp];
        float bbr[16], bbi[16];
#pragma unroll
        for (int c4 = 0; c4 < 4; ++c4) { const f32x4 r = *(const f32x4*)(T + S5_BBR + sp * 16 + 4 * c4), i = *(const f32x4*)(T + S5_BBI + sp * 16 + 4 * c4);
            bbr[4 * c4] = r.x; bbr[4 * c4 + 1] = r.y; bbr[4 * c4 + 2] = r.z; bbr[4 * c4 + 3] = r.w; bbi[4 * c4] = i.x; bbi[4 * c4 + 1] = i.y; bbi[4 * c4 + 2] = i.z; bbi[4 * c4 + 3] = i.w; }
        bf16x8 cf[4];
#pragma unroll
        for (int ks = 0; ks < 4; ++ks) { const int k0 = 32 * ks + 8 * fq; const bool im = k0 >= 64; const float* src = a.in[im ? I_CIM : I_CRE] + (size_t)(g * 16 + fr) * 64 + (k0 & 63);
            const f32x4 v0 = *(const f32x4*)src, v1 = *(const f32x4*)(src + 4); const float sg = im ? -1.f : 1.f;
            u32x4 w; w.x = pk2(sg * v0.x, sg * v0.y); w.y = pk2(sg * v0.z, sg * v0.w); w.z = pk2(sg * v1.x, sg * v1.y); w.w = pk2(sg * v1.z, sg * v1.w);
            cf[ks] = __builtin_bit_cast(bf16x8, w); }
        const float dsk = a.in[I_S5D][g * 16 + fr];
        float xr = 0.f, xi = 0.f;
        for (int i = 0; i < jb; i += 4) { float er[4], ei[4];
#pragma unroll
            for (int q = 0; q < 4; ++q) { er[q] = E[(size_t)(g * 128 + i + q) * 64 + lane]; ei[q] = E[(size_t)(64 * 128 * 64) + (size_t)(g * 128 + i + q) * 64 + lane]; }
#pragma unroll
            for (int q = 0; q < 4; ++q) { const float nr = a64r * xr - a64i * xi + er[q], ni = a64r * xi + a64i * xr + ei[q]; xr = nr; xi = ni; } }
#pragma unroll 1
        for (int jj = 0; jj < 4; ++jj) { const int j = jb + jj;
        s5_stage_u(proj, g, j, ut, lane);
        for (int tt = 0; tt < 4; ++tt) {
            for (int t16 = 0; t16 < 16; ++t16) { const LAS f32x4* up = (const LAS f32x4*)(ut + (16 * tt + t16) * 16); float bur = 0.f, bui = 0.f;
#pragma unroll
                for (int c4 = 0; c4 < 4; ++c4) { const f32x4 uv = up[c4];
                    bur += bbr[4 * c4] * uv.x + bbr[4 * c4 + 1] * uv.y + bbr[4 * c4 + 2] * uv.z + bbr[4 * c4 + 3] * uv.w;
                    bui += bbi[4 * c4] * uv.x + bbi[4 * c4 + 1] * uv.y + bbi[4 * c4 + 2] * uv.z + bbi[4 * c4 + 3] * uv.w; }
                const float nr = ar * xr - ai * xi + bur, ni = ar * xi + ai * xr + bui; xr = nr; xi = ni;
                *(LAS unsigned short*)(X + t16 * 272 + 2 * lane) = (unsigned short)f2bf(xr); *(LAS unsigned short*)(X + t16 * 272 + 128 + 2 * lane) = (unsigned short)f2bf(xi); }
            LDS_WAIT(); asm volatile("" ::: "memory");
            f32x4 acc = (f32x4){0.f, 0.f, 0.f, 0.f};
#pragma unroll
            for (int ks = 0; ks < 4; ++ks) { const bf16x8 af = *(const LAS bf16x8*)(X + fr * 272 + 64 * ks + 16 * fq); acc = __builtin_amdgcn_mfma_f32_16x16x32_bf16(af, cf[ks], acc, 0, 0, 0); }
#pragma unroll
            for (int r = 0; r < 4; ++r) { const int tl = 16 * tt + 4 * fq + r; const float y = acc[r] + dsk * ut[tl * 16 + fr];
                yap[(size_t)(64 * j + tl) * 1024 + 16 * g + fr] = (bf16)f2bf(gelu_tanh_f(y)); }
            LDS_WAIT(); asm volatile("" ::: "memory");
        }
        }
    }
}

__device__ __forceinline__ void lds_add(LAS unsigned* p, unsigned v) { (void)__hip_atomic_fetch_add(p, v, __ATOMIC_RELAXED, __HIP_MEMORY_SCOPE_WORKGROUP); }
__device__ __forceinline__ float relu_i(float x) { int xi = __builtin_bit_cast(int, x); xi = xi > 0 ? xi : 0; return __builtin_bit_cast(float, xi); }
__device__ __forceinline__ unsigned ord_key(float s) { const unsigned u = __builtin_bit_cast(unsigned, s); return u ^ ((u >> 31) ? 0xFFFFFFFFu : 0x80000000u); }
template <int NB, bool PACKED>
__device__ __forceinline__ void hist_search(const LAS unsigned* hist, int field, unsigned need, int lane, int& bstar, unsigned& above) {
    constexpr int PER = NB / 64;
    const int sh = PACKED ? 16 * field : 0; const unsigned fm = PACKED ? 0xffffu : 0xffffffffu;
    unsigned tot = 0;
#pragma unroll 4
    for (int i = 0; i < PER; i += 4) { const u32x4 h = *(const LAS u32x4*)(hist + lane * PER + i); tot += ((h.x >> sh) & fm) + ((h.y >> sh) & fm) + ((h.z >> sh) & fm) + ((h.w >> sh) & fm); }
    unsigned incl = tot;
#pragma unroll
    for (int o = 1; o < 64; o <<= 1) { const unsigned v = __shfl_down(incl, o); if (lane + o < 64) incl += v; }
    const unsigned excl = incl - tot;
    const unsigned long long mask = __ballot(incl >= need);
    const int lstar = 63 - __builtin_clzll(mask | 1ull);
    unsigned cum = excl; int b = -1; unsigned ab = 0;
#pragma unroll 1
    for (int i = PER - 4; i >= 0; i -= 4) { const u32x4 h = *(const LAS u32x4*)(hist + lane * PER + i);
        const unsigned c3 = (h.w >> sh) & fm, c2 = (h.z >> sh) & fm, c1 = (h.y >> sh) & fm, c0 = (h.x >> sh) & fm;
        if (b < 0) { if (cum + c3 >= need) { b = lane * PER + i + 3; ab = cum; } else cum += c3; }
        if (b < 0) { if (cum + c2 >= need) { b = lane * PER + i + 2; ab = cum; } else cum += c2; }
        if (b < 0) { if (cum + c1 >= need) { b = lane * PER + i + 1; ab = cum; } else cum += c1; }
        if (b < 0) { if (cum + c0 >= need) { b = lane * PER + i + 0; ab = cum; } else cum += c0; } }
    bstar = __shfl(b, lstar); above = __shfl(ab, lstar);
}

__device__ __forceinline__ void dsa_p1_chunk(LAS unsigned char* lds, LAS unsigned* hist, int ch, int buf, int nadm, int l31, int hh, const bf16x8 (&qa)[4], const float (&wv)[16], float* srow) {
    const bool full = 128 * ch + 64 < nadm;
    const LAS unsigned char* tb = lds + (buf * 4) * 18944 + 8192 + l31 * 128;
    f32x16 acc[4];
#pragma unroll
    for (int tl = 0; tl < 4; ++tl)
#pragma unroll
        for (int i = 0; i < 16; ++i) acc[tl][i] = 0.f;
#pragma unroll
    for (int tl = 0; tl < 4; ++tl) {
#pragma unroll
        for (int ks = 0; ks < 4; ++ks) { const bf16x8 kf = *(const LAS bf16x8*)(tb + tl * 18944 + (((2 * ks + hh) ^ (l31 & 7)) * 16));
            acc[tl] = __builtin_amdgcn_mfma_f32_32x32x16_bf16(qa[ks], kf, acc[tl], 0, 0, 0); } }
#pragma unroll
    for (int tl = 0; tl < 4; ++tl) {
        float s0 = 0.f, s1 = 0.f;
#pragma unroll
        for (int i = 0; i < 16; i += 2) { s0 += wv[i] * relu_i(acc[tl][i]); s1 += wv[i + 1] * relu_i(acc[tl][i + 1]); }
        const unsigned ok = ord_key(s0 + s1), bin = ok >> 21;
        if (tl < 2 || full) lds_add(&hist[bin], 1u << (16 * hh));
        __builtin_nontemporal_store(s0 + s1, srow + 128 * ch + 32 * tl + l31);
    }
}
__device__ __forceinline__ void dsa_pass1(const bf16* proj, LAS unsigned char* lds, LAS unsigned char* wl, int nadm, int tid, int lane, const bf16x8 (&qa)[4], const float (&wv)[16], float* srow) {
    const int l31 = lane & 31, hh = lane >> 5;
    LAS unsigned* hist = (LAS unsigned*)wl;
    const int skey = tid >> 3, ssub = tid & 7;
    const bf16* gsrc = proj + (size_t)skey * NIN + C_KI + 8 * ssub;
    const int sdst = ((skey >> 5) * 18944) + 8192 + (skey & 31) * 128 + ((ssub ^ (skey & 7)) * 16);
    const int nch = (nadm + 127) / 128;
#define DSA_LD(c_, r0_, r1_) do { const int cc_ = (c_) < nch ? (c_) : nch - 1; r0_ = *(const u32x4*)(gsrc + (size_t)(128 * cc_) * NIN); r1_ = *(const u32x4*)(gsrc + (size_t)(128 * cc_ + 64) * NIN); } while (0)
#define DSA_ST(b_, r0_, r1_) do { const int bo_ = (b_) * 4 * 18944; *(LAS u32x4*)(lds + sdst + bo_) = r0_; *(LAS u32x4*)(lds + sdst + bo_ + 2 * 18944) = r1_; } while (0)
#define DSA_STEP(c_, b_, l0_, l1_, w0_, w1_) do { DSA_LD((c_) + 4, l0_, l1_); dsa_p1_chunk(lds, hist, (c_), (b_), nadm, l31, hh, qa, wv, srow); if ((c_) + 1 < nch) DSA_ST((b_) ^ 1, w0_, w1_); __syncthreads(); } while (0)
    u32x4 ra0, ra1, rb0, rb1, rc0, rc1, rd0, rd1;
    DSA_LD(0, ra0, ra1); DSA_LD(1, rb0, rb1); DSA_LD(2, rc0, rc1); DSA_LD(3, rd0, rd1);
    DSA_ST(0, ra0, ra1);
    __syncthreads();
#pragma unroll 1
    for (int ch = 0; ch < nch; ch += 4) {
        DSA_STEP(ch, 0, ra0, ra1, rb0, rb1);
        if (ch + 1 >= nch) break;
        DSA_STEP(ch + 1, 1, rb0, rb1, rc0, rc1);
        if (ch + 2 >= nch) break;
        DSA_STEP(ch + 2, 0, rc0, rc1, rd0, rd1);
        if (ch + 3 >= nch) break;
        DSA_STEP(ch + 3, 1, rd0, rd1, ra0, ra1);
    }
#undef DSA_LD
#undef DSA_ST
#undef DSA_STEP
}

__device__ __forceinline__ void dsa_phase(const Args& a, LAS unsigned char* lds, int G, int wave_s) {
    int lane_o = (int)__builtin_amdgcn_mbcnt_hi(~0u, __builtin_amdgcn_mbcnt_lo(~0u, 0u)); asm volatile("" : "+v"(lane_o)); const int lane = lane_o, wave = wave_s, tid_o = wave_s * 64 + lane_o;
    unsigned char* ws = a.ws; const bf16* proj = (const bf16*)(ws + WS_PROJ); const bf16* kvn = (const bf16*)(ws + WS_KVN);
    bf16* ycat = (bf16*)(ws + WS_YCAT);
    constexpr int WREG = 18944;
    LAS unsigned char* wl = lds + wave * WREG;
    LAS unsigned* hist = (LAS unsigned*)wl; LAS int* sel = (LAS int*)(wl + 16896);
    const int l31 = lane & 31, hh = lane >> 5, fr = lane & 15, fq = lane >> 4;
    for (int un = blockIdx.x; un < 512; un += G) {
        __syncthreads();
        const int unit = (un < 256) ? un : 767 - un;
        const int t0 = unit * 16, tq = t0 + 2 * wave;
        const int nadm = ((t0 >> 6) + 1) * 64;
        if (nadm > 256) {
            {
                bf16x8 qa[4];
                { const int r = l31, qq = (r >> 2) & 1, head = (r & 3) + 4 * (r >> 3);
                  const bf16* qp = proj + (size_t)(tq + qq) * NIN + C_QI + head * 64 + 8 * hh;
#pragma unroll
                  for (int ks = 0; ks < 4; ++ks) qa[ks] = *(const bf16x8*)(qp + 16 * ks); }
                float wv[16];
                { const u32x4 w0 = *(const u32x4*)(proj + (size_t)(tq + hh) * NIN + C_WI), w1 = *(const u32x4*)(proj + (size_t)(tq + hh) * NIN + C_WI + 8);
                  const float sc = 1.0f / 32.0f;
                  wv[0] = bflo(w0.x) * sc; wv[1] = bfhi(w0.x) * sc; wv[2] = bflo(w0.y) * sc; wv[3] = bfhi(w0.y) * sc; wv[4] = bflo(w0.z) * sc; wv[5] = bfhi(w0.z) * sc; wv[6] = bflo(w0.w) * sc; wv[7] = bfhi(w0.w) * sc;
                  wv[8] = bflo(w1.x) * sc; wv[9] = bfhi(w1.x) * sc; wv[10] = bflo(w1.y) * sc; wv[11] = bfhi(w1.y) * sc; wv[12] = bflo(w1.z) * sc; wv[13] = bfhi(w1.z) * sc; wv[14] = bflo(w1.w) * sc; wv[15] = bfhi(w1.w) * sc; }
                for (int i = lane; i < 2048; i += 64) hist[i] = 0u;
                dsa_pass1(proj, lds, wl, nadm, tid_o, lane, qa, wv, (float*)(ws + WS_SCORE) + (size_t)(tq + hh) * SEQ);
            }
            int b1[2]; unsigned ab1[2];
            hist_search<2048, true>(hist, 0, 256u, lane, b1[0], ab1[0]);
            hist_search<2048, true>(hist, 1, 256u, lane, b1[1], ab1[1]);
            asm volatile("" ::: "memory");
            LAS unsigned* cok = (LAS unsigned*)wl; LAS int* cix = (LAS int*)(wl + 4096);
            VM_WAIT();
#pragma unroll 1
            for (int qq = 0; qq < 2; ++qq) {
                const float* sr = (const float*)(ws + WS_SCORE) + (size_t)(tq + qq) * SEQ + 4 * lane;
                const unsigned bq = (unsigned)(qq ? b1[1] : b1[0]); unsigned ns = 0, nc = 0;
                const unsigned long long lowm = (1ull << lane) - 1ull;
                for (int k0 = 0; k0 < nadm; k0 += 2048) {
                    f32x4 v[8];
#pragma unroll
                    for (int u = 0; u < 8; ++u) { const int kk = k0 + 256 * u + 4 * lane; v[u] = kk < nadm ? __builtin_nontemporal_load((const f32x4*)(sr + k0 + 256 * u)) : (f32x4){0.f, 0.f, 0.f, 0.f}; }
#pragma unroll
                    for (int u = 0; u < 8; ++u) { if (k0 + 256 * u < nadm) {
                        const int kk = k0 + 256 * u + 4 * lane; const bool vld = kk < nadm;
#pragma unroll
                        for (int c = 0; c < 4; ++c) {
                            const unsigned ok = ord_key(v[u][c]), bin = ok >> 21; const bool isel = vld && bin > bq, icand = vld && bin == bq;
                            const unsigned long long ms = __ballot(isel), mc = __ballot(icand);
                            const unsigned ps = ns + (unsigned)__builtin_popcountll(ms & lowm), pc = nc + (unsigned)__builtin_popcountll(mc & lowm);
                            if (isel && ps < 256u) sel[qq * 256 + ps] = kk + c;
                            if (icand && pc < 512u) { cok[qq * 512 + pc] = ok; cix[qq * 512 + pc] = kk + c; }
                            ns += (unsigned)__builtin_popcountll(ms); nc += (unsigned)__builtin_popcountll(mc); } } }
                }
                LDS_WAIT(); asm volatile("" ::: "memory");
                const unsigned C = nc > 512u ? 512u : nc;
                const unsigned need = ns < 256u ? 256u - ns : 0u;
                unsigned kk8[8]; int ix8[8];
#pragma unroll
                for (int j = 0; j < 8; ++j) { const unsigned i = lane + 64 * j; const bool act = i < C; kk8[j] = act ? cok[qq * 512 + i] : 0u; ix8[j] = act ? cix[qq * 512 + i] : 0x7fffffff; }
                unsigned kstar = 0u; int istar = 0x7fffffff;
                if (need < C) {
                    unsigned prefix = bq << 21;
#pragma unroll 1
                    for (int bit = 20; bit >= 0; --bit) { const unsigned trial = prefix | (1u << bit); unsigned cnt = 0;
#pragma unroll
                        for (int j = 0; j < 8; ++j) cnt += (unsigned)__builtin_popcountll(__ballot(kk8[j] >= trial));
                        if (cnt >= need) prefix = trial; }
                    kstar = prefix;
                    unsigned ngt = 0, neq = 0;
#pragma unroll
                    for (int j = 0; j < 8; ++j) { ngt += (unsigned)__builtin_popcountll(__ballot(kk8[j] > kstar)); neq += (unsigned)__builtin_popcountll(__ballot(kk8[j] == kstar)); }
                    const unsigned m = need - ngt;
                    if (m < neq) { int ans = 0;
#pragma unroll 1
                        for (int bit = 12; bit >= 0; --bit) { const int tr = ans | (1 << bit); unsigned cnt = 0;
#pragma unroll
                            for (int j = 0; j < 8; ++j) cnt += (unsigned)__builtin_popcountll(__ballot(kk8[j] == kstar && ix8[j] < tr));
                            if (cnt < m) ans = tr; }
                        istar = ans; }
                }
                unsigned base = ns;
#pragma unroll
                for (int j = 0; j < 8; ++j) { const bool act = lane + 64u * j < C; const bool pred = act && (kk8[j] > kstar || (kk8[j] == kstar && ix8[j] <= istar));
                    const unsigned long long mk = __ballot(pred); const unsigned pos = base + (unsigned)__builtin_popcountll(mk & lowm);
                    if (pred && pos < 256u) sel[qq * 256 + pos] = ix8[j];
                    base += (unsigned)__builtin_popcountll(mk); }
                for (unsigned i = base + lane; i < 256u; i += 64) sel[qq * 256 + i] = -1;
            }
            LDS_WAIT(); asm volatile("" ::: "memory");
        } else {
            for (int i = lane; i < 512; i += 64) { const int k = i & 255; sel[i] = k < nadm ? k : -1; }
            LDS_WAIT(); asm volatile("" ::: "memory");
        }
#pragma unroll 1
        for (int qq = 0; qq < 2; ++qq) {
            const int t = tq + (qq & 1); const int head = fr & 7;
            const float slope = fast_exp2(-(float)(head + 1));
            bf16x8 qf[8];
            { const bf16* qp = proj + (size_t)t * NIN + C_QT + head * 256 + 8 * fq;
#pragma unroll
              for (int ks = 0; ks < 8; ++ks) qf[ks] = *(const bf16x8*)(qp + 32 * ks); }
            f32x4 oacc[16];
#pragma unroll
            for (int i = 0; i < 16; ++i) oacc[i] = (f32x4){0.f, 0.f, 0.f, 0.f};
            float mrun = -1e30f, lrun = 0.f;
            u32x4 gr[16];
#pragma unroll
            for (int i = 0; i < 16; ++i) { int s = sel[(qq & 1) * 256 + hh + 2 * i]; s = s < 0 ? 0 : s; gr[i] = *(const u32x4*)(kvn + (size_t)s * 256 + 8 * l31); }
            for (int kt = 0; kt < 8; ++kt) {
                asm volatile("" ::: "memory");
#pragma unroll
                for (int i = 0; i < 16; ++i) *(LAS u32x4*)(wl + (hh + 2 * i) * 528 + 16 * l31) = gr[i];
                if (kt + 1 < 8) {
#pragma unroll
                    for (int i = 0; i < 16; ++i) { int s = sel[(qq & 1) * 256 + 32 * (kt + 1) + hh + 2 * i]; s = s < 0 ? 0 : s; gr[i] = *(const u32x4*)(kvn + (size_t)s * 256 + 8 * l31); } }
                LDS_WAIT(); asm volatile("" ::: "memory");
                f32x4 sacc[2];
#pragma unroll
                for (int sb = 0; sb < 2; ++sb) { f32x4 c4 = (f32x4){0.f, 0.f, 0.f, 0.f};
#pragma unroll
                    for (int ks = 0; ks < 8; ++ks) { const bf16x8 af = *(const LAS bf16x8*)(wl + (16 * sb + fr) * 528 + 64 * ks + 16 * fq); c4 = __builtin_amdgcn_mfma_f32_16x16x32_bf16(af, qf[ks], c4, 0, 0, 0); }
                    sacc[sb] = c4; }
                float lg[8]; float mx = -1e30f;
#pragma unroll
                for (int sb = 0; sb < 2; ++sb) { const LAS int* sp = sel + (qq & 1) * 256 + 32 * kt + 16 * sb + 4 * fq;
#pragma unroll
                    for (int r = 0; r < 4; ++r) { const int s = sp[r]; const float d = (float)(t - s); float v = sacc[sb][r] - slope * fabsf(d); v = s < 0 ? -1e30f : v; lg[4 * sb + r] = v; mx = fmaxf(mx, v); } }
                mx = fmaxf(mx, __shfl_xor(mx, 16)); mx = fmaxf(mx, __shfl_xor(mx, 32));
                const float mnew = fmaxf(mrun, mx); const float alpha = fast_exp2((mrun - mnew) * 1.4426950408889634f);
                float ps = 0.f; float p[8];
#pragma unroll
                for (int i = 0; i < 8; ++i) { p[i] = lg[i] <= -1e29f ? 0.f : fast_exp2((lg[i] - mnew) * 1.4426950408889634f); ps += p[i]; }
                lrun = lrun * alpha + ps; mrun = mnew;
#pragma unroll
                for (int i = 0; i < 16; ++i) oacc[i] = oacc[i] * alpha;
                u32x4 pw; pw.x = pk2(p[0], p[1]); pw.y = pk2(p[2], p[3]); pw.z = pk2(p[4], p[5]); pw.w = pk2(p[6], p[7]);
                const bf16x8 pf = __builtin_bit_cast(bf16x8, pw);
#pragma unroll
                for (int rt = 0; rt < 16; ++rt) {
                    const LAS unsigned char* p0 = wl + (4 * fq + (fr >> 2)) * 528 + (16 * rt + 4 * (fr & 3)) * 2;
                    const v4i16_t a0 = __builtin_amdgcn_ds_read_tr16_b64_v4i16((LAS v4i16_t*)p0);
                    const v4i16_t a1 = __builtin_amdgcn_ds_read_tr16_b64_v4i16((LAS v4i16_t*)(p0 + 16 * 528));
                    bf16x8 af; af[0] = a0[0]; af[1] = a0[1]; af[2] = a0[2]; af[3] = a0[3]; af[4] = a1[0]; af[5] = a1[1]; af[6] = a1[2]; af[7] = a1[3];
                    oacc[rt] = __builtin_amdgcn_mfma_f32_16x16x32_bf16(af, pf, oacc[rt], 0, 0, 0); }
                LDS_WAIT(); asm volatile("" ::: "memory");
            }
            float lt = lrun; lt += __shfl_xor(lt, 16); lt += __shfl_xor(lt, 32);
            const float inv = 1.0f / lt;
#if FP8_MIXOUT
            if (fr < 8) { unsigned char* op = (unsigned char*)ycat + (size_t)t * NCAT + 1024 + fr * 256 + 4 * fq; const float inv8 = inv * 8.0f;
#pragma unroll
                for (int rt = 0; rt < 16; ++rt) { const f32x4 v = oacc[rt] * inv8; *(unsigned*)(op + 16 * rt) = pk4_fp8(v.x, v.y, v.z, v.w); } }
#else
            if (fr < 8) { bf16* op = ycat + (size_t)t * NCAT + 1024 + fr * 256 + 4 * fq;
#pragma unroll
                for (int rt = 0; rt < 16; ++rt) { const f32x4 v = oacc[rt] * inv; u32x2 w; w.x = pk2(v.x, v.y); w.y = pk2(v.z, v.w); *(u32x2*)(op + 16 * rt) = w; } }
#endif
        }
        LDS_WAIT(); asm volatile("" ::: "memory");
    }
}

__device__ __forceinline__ void attn_c_phase(const Args& a, LAS unsigned char* lds, int G, int wave_s) {
    int lane_o = (int)__builtin_amdgcn_mbcnt_hi(~0u, __builtin_amdgcn_mbcnt_lo(~0u, 0u)); asm volatile("" : "+v"(lane_o)); const int lane = lane_o, wave = wave_s, tid_o = wave_s * 64 + lane_o;
    unsigned char* ws = a.ws; const bf16* Q = (const bf16*)(ws + WS_Q); const bf16* K = (const bf16*)(ws + WS_K); const bf16* VT = (const bf16*)(ws + WS_VT); bf16* O = (bf16*)(ws + WS_O);
    LAS float* btab = (LAS float*)(lds + 65536);
    const int l31 = lane & 31, hh = lane >> 5;
    const float sc = 0.08838834764831845f * 1.4426950408889634f;
    const int kkey = tid_o >> 4, kc = tid_o & 15, vd = tid_o >> 3, vc = tid_o & 7;
    for (int un = blockIdx.x; un < 512; un += G) {
        const int head = un >> 5, cg = un & 31, ci = wave >> 1, chunk = 4 * cg + ci;
        __syncthreads();
        for (int i = tid_o; i < 513; i += NTHR) btab[i] = a.in[I_RELB][head * 513 + i] * 1.4426950408889634f;
        const int t = 64 * chunk + 32 * (wave & 1) + l31;
        bf16x8 qf[8];
        { const bf16* qp = Q + (size_t)t * DM + head * 128 + 8 * hh;
#pragma unroll
          for (int ks = 0; ks < 8; ++ks) qf[ks] = *(const bf16x8*)(qp + 16 * ks); }
        f32x16 oacc[4];
#pragma unroll
        for (int d = 0; d < 4; ++d)
#pragma unroll
            for (int i = 0; i < 16; ++i) oacc[d][i] = 0.f;
        float mrun = -1e30f, lrun = 0.f;
        const int cb0 = 4 * cg - 8;
        const int j0 = cb0 < 0 ? -cb0 : 0;
        const bf16* kg = K + (size_t)kkey * DM + head * 128 + kc * 8; const bf16* vg = VT + (size_t)(head * 128 + vd) * SEQ + vc * 8;
        const int kdst = kkey * 256 + ((kc ^ (kkey & 15)) * 16), vdst = 16384 + vd * 128 + ((vc ^ ((vd >> 1) & 7)) * 16);
        u32x4 sk0, sk1, sv0, sv1;
#define ATC_LD(j_) do { const size_t s0_ = (size_t)(64 * (cb0 + (j_))); sk0 = *(const u32x4*)(kg + s0_ * DM); sk1 = *(const u32x4*)(kg + (s0_ + 32) * DM); sv0 = *(const u32x4*)(vg + s0_); sv1 = *(const u32x4*)(vg + s0_ + (size_t)64 * SEQ); } while (0)
#define ATC_ST(b_) do { LAS unsigned char* d_ = lds + (b_) * 32768; *(LAS u32x4*)(d_ + kdst) = sk0; *(LAS u32x4*)(d_ + kdst + 32 * 256) = sk1; *(LAS u32x4*)(d_ + vdst) = sv0; *(LAS u32x4*)(d_ + vdst + 64 * 128) = sv1; } while (0)
        ATC_LD(j0); ATC_ST(j0 & 1);
        __syncthreads();
        for (int j = j0; j < 12; ++j) {
            if (j + 1 < 12) ATC_LD(j + 1);
            if (j >= ci && j <= ci + 8) {
                const LAS unsigned char* kb = lds + (j & 1) * 32768; const LAS unsigned char* vb = kb + 16384;
                const int s0 = 64 * (cb0 + j);
#pragma unroll
                for (int sub = 0; sub < 2; ++sub) {
                    f32x16 sa;
#pragma unroll
                    for (int i = 0; i < 16; ++i) sa[i] = 0.f;
                    const int krow = 32 * sub + l31;
#pragma unroll
                    for (int ks = 0; ks < 8; ++ks) { const bf16x8 kf = *(const LAS bf16x8*)(kb + krow * 256 + (((2 * ks + hh) ^ (krow & 15)) * 16)); sa = __builtin_amdgcn_mfma_f32_32x32x16_bf16(kf, qf[ks], sa, 0, 0, 0); }
                    float mx = -1e30f; float lg[16];
#pragma unroll
                    for (int i = 0; i < 16; ++i) { const int s = s0 + 32 * sub + (i & 3) + 8 * (i >> 2) + 4 * hh; int rel = t - s; rel = rel > 256 ? 256 : rel; lg[i] = sa[i] * sc + btab[rel + 256]; mx = fmaxf(mx, lg[i]); }
                    mx = fmaxf(mx, __shfl_xor(mx, 32));
                    const float mnew = fmaxf(mrun, mx), alpha = fast_exp2(mrun - mnew);
                    float ps = 0.f; float p[16];
#pragma unroll
                    for (int i = 0; i < 16; ++i) { p[i] = fast_exp2(lg[i] - mnew); ps += p[i]; }
                    lrun = lrun * alpha + ps; mrun = mnew;
#pragma unroll
                    for (int d = 0; d < 4; ++d)
#pragma unroll
                        for (int i = 0; i < 16; ++i) oacc[d][i] *= alpha;
#pragma unroll
                    for (int s = 0; s < 2; ++s) {
                        u32x4 pw; pw.x = pk2(p[8 * s], p[8 * s + 1]); pw.y = pk2(p[8 * s + 2], p[8 * s + 3]); pw.z = pk2(p[8 * s + 4], p[8 * s + 5]); pw.w = pk2(p[8 * s + 6], p[8 * s + 7]);
                        const bf16x8 pf = __builtin_bit_cast(bf16x8, pw);
                        const int q0 = 8 * sub + 4 * s + hh;
#pragma unroll
                        for (int d = 0; d < 4; ++d) { const int dr = 32 * d + l31; const LAS unsigned char* vr = vb + dr * 128 + (q0 & 1) * 8; const int sw = (dr >> 1) & 7;
                            const u32x2 v0 = *(const LAS u32x2*)(vr + (((q0 >> 1) ^ sw) * 16)), v1 = *(const LAS u32x2*)(vr + ((((q0 >> 1) + 1) ^ sw) * 16));
                            u32x4 vw; vw.x = v0.x; vw.y = v0.y; vw.z = v1.x; vw.w = v1.y;
                            oacc[d] = __builtin_amdgcn_mfma_f32_32x32x16_bf16(__builtin_bit_cast(bf16x8, vw), pf, oacc[d], 0, 0, 0); }
                    }
                }
            }
            if (j + 1 < 12) ATC_ST((j + 1) & 1);
            __syncthreads();
        }
#undef ATC_LD
#undef ATC_ST
        float lt = lrun + __shfl_xor(lrun, 32); const float inv = 1.0f / lt;
#if FP8_MIXOUT
        unsigned char* op = (unsigned char*)O + (size_t)t * DM + head * 128 + 4 * hh; const float inv8 = inv * 8.0f;
#pragma unroll
        for (int d = 0; d < 4; ++d)
#pragma unroll
            for (int gq = 0; gq < 4; ++gq) *(unsigned*)(op + 32 * d + 8 * gq) = pk4_fp8(oacc[d][4 * gq] * inv8, oacc[d][4 * gq + 1] * inv8, oacc[d][4 * gq + 2] * inv8, oacc[d][4 * gq + 3] * inv8);
#else
        bf16* op = O + (size_t)t * DM + head * 128 + 4 * hh;
#pragma unroll
        for (int d = 0; d < 4; ++d)
#pragma unroll
            for (int gq = 0; gq < 4; ++gq) { u32x2 w; w.x = pk2(oacc[d][4 * gq] * inv, oacc[d][4 * gq + 1] * inv); w.y = pk2(oacc[d][4 * gq + 2] * inv, oacc[d][4 * gq + 3] * inv);
                *(u32x2*)(op + 32 * d + 8 * gq) = w; }
#endif
    }
    __syncthreads();
}

__global__ void __launch_bounds__(NTHR, 2) fwd_kernel(Args args) {
    extern __shared__ __attribute__((aligned(16))) unsigned char lds_raw[];
    LAS unsigned char* lds = (LAS unsigned char*)lds_raw;
    volatile LAS unsigned* MISC = (volatile LAS unsigned*)(lds + MISC_OFF);
    const int wave_s = __builtin_amdgcn_readfirstlane((int)threadIdx.x >> 6);
    const int G = gridDim.x;
    unsigned char* ws = args.ws;
    if (threadIdx.x < 64) MISC[threadIdx.x] = 0u;
    __syncthreads();
    const int lo = args.ph_lo, hi = args.ph_hi;
    const bool multi = (hi - lo) > 1;
    XcdBarrier bar; bar.bar = (unsigned*)(ws + WS_CTL) + CW_BAR; bar.x = 0; bar.st = nullptr;
    if (multi) bar = xcd_barrier_post((unsigned*)(ws + WS_CTL) + CW_BAR, MISC + 8);
    bar.wave = wave_s;
#define IN(k) (lo <= (k) && (k) < hi)
#if TIMING
#define STAMP(k) do { if (blockIdx.x == 0 && wave_s == 0 && __builtin_amdgcn_mbcnt_hi(~0u, __builtin_amdgcn_mbcnt_lo(~0u, 0u)) == 0u) __hip_atomic_store((unsigned long long*)(ws + WS_DIAG) + (k), __builtin_amdgcn_s_memrealtime(), __ATOMIC_RELAXED, __HIP_MEMORY_SCOPE_AGENT); } while (0)
#define SEAM(k) do { if (IN((k) + 1)) xcd_barrier(bar); STAMP((k) + 1); } while (0)
#else
#define STAMP(k) do { } while (0)
#define SEAM(k) do { if (IN((k) + 1)) xcd_barrier(bar); } while (0)
#endif

 #if REP_MASK
#define PH_LOOP(k) _Pragma("unroll") for (int r_ = 0; r_ < ((((REP_MASK) >> (k)) & 1u) ? REP_N : 1); ++r_)
#else
#define PH_LOOP(k)
#endif
    float* H = args.out;
    float* mod = (float*)(ws + WS_MOD);
    bf16* hn = (bf16*)(ws + WS_HN); bf16* hmid = (bf16*)(ws + WS_HMID); bf16* proj = (bf16*)(ws + WS_PROJ);

    STAMP(0);
    PH_LOOP(0) { if (EN(0) && IN(0)) p0_prologue(args, lds, G, wave_s);
    if (IN(0)) SEAM(0); }

#define FFN_PHASES(S_, PB_) do { \
        constexpr int layer_ = (S_) >> 1, sub_ = ((S_) & 1) ? 2 : 0; \
        const float* hin_ = ((S_) == 0) ? args.in[I_X] : H; \
        const float* mvec_ = mod + layer_ * NMOD + sub_ * 3 * DM; \
        PH_LOOP(PB_) { if (EN(1) && IN(PB_)) norm_phase<false, true>(hin_, args.in[I_NORMG] + (layer_ * 3 + sub_) * DM, mvec_, mvec_ + DM, hn, nullptr, G, wave_s); \
        if ((S_) == 0 && EN(2) && IN(PB_)) { \
              \
            pg8::Gemm g{(const bf16*)(ws + WS_WUPRAW), (const bf16*)(ws + WS_WQRAW), 256, 2048, 128, 2048, 2048, 8, 128, 128, \
                        (const bf16*)(ws + WS_WOUTB) + 1024, (const bf16*)(ws + WS_WUPRAW) + 1024, 2048, 256, 8, 128, 128}; \
            pg8::StaticOrder S; S.init(g, G, (int)blockIdx.x); \
            pg8::EpiBf16 E{(bf16*)(ws + WS_WIN) + (size_t)1024 * DM, DM, (size_t)256 * DM, 0.08838834764831845f, FP8_MIXOUT ? (bf16*)(ws + WS_WOUT + 1024) : (bf16*)(ws + WS_WOUT) + 1024, NCAT, (size_t)256, FP8_MIXOUT ? 64.0f : 1.0f, 0, 0, FP8_MIXOUT}; \
            pg8::gemm_phase<pg8::EpiBf16>(lds, g, S, E, wave_s); } \
        if (IN(PB_)) SEAM(PB_); } \
        PH_LOOP((PB_) + 1) { if (EN(3) && IN((PB_) + 1)) { \
            pg8::Gemm g{hn, (const bf16*)(ws + WS_WGU + (size_t)(S_) * NGU * DM), SEQ, NGU, DM / 2, DM / 2, DM / 2, 1, 0, 0, nullptr, nullptr, 0, 0, 0, 0, 0}; \
            pg8::StaticOrder S; S.init(g, G, (int)blockIdx.x); \
            pg8::EpiSwiGLU E{(unsigned char*)hmid, FFP, 0x7c7c7c7c, 0x79797979};     \
            pg8::gemm_phase<pg8::EpiSwiGLU, true>(lds, g, S, E, wave_s); \
              \
            if ((S_) == 0) conv_fill<CI_FFN(0) + 5504, 2752, CI_IN, CI_NIN, CI_GLU, CI_NGLU>(args, lds, G, S.ntot, wave_s); \
            if ((S_) == 1) conv_fill<CI_FFN(2), 5504, CI_FFN(3) + 5504, 2752>(args, lds, G, S.ntot, wave_s); \
            if ((S_) == 2) conv_fill<CI_FFN(3), 5504>(args, lds, G, S.ntot, wave_s); } \
        if (IN((PB_) + 1)) SEAM((PB_) + 1); } \
        PH_LOOP((PB_) + 2) { if (EN(4) && IN((PB_) + 2)) { \
            pg8::Gemm g{hmid, (const bf16*)(ws + WS_WD + (size_t)(S_) * DM * FFP), SEQ, DM, FFP / 2, FFP / 2, FFP / 2, 1, 0, 0, nullptr, nullptr, 0, 0, 0, 0, 0}; \
            pg8::StaticOrder S; S.init(g, G, (int)blockIdx.x); \
            pg8::EpiResid E{hin_, H, mvec_ + 2 * DM, 0.5f, 0x7c7c7c7c, 0x78787878};     \
            pg8::gemm_phase<pg8::EpiResid, true>(lds, g, S, E, wave_s); } \
        if (IN((PB_) + 2)) SEAM((PB_) + 2); } \
    } while (0)
#define MIXOUT_PHASE(LYR_, PM_, APTR_, BPTR_, K_) do { \
        if (EN(12) && IN(PM_)) { \
            const float* m1_ = mod + (LYR_) * NMOD + 1 * 3 * DM; \
            constexpr int KU_ = FP8_MIXOUT ? (K_) / 2 : (K_); \
            pg8::Gemm g{(const bf16*)(APTR_), (const bf16*)(BPTR_), SEQ, DM, KU_, KU_, KU_, 1, 0, 0, nullptr, nullptr, 0, 0, 0, 0, 0}; \
            pg8::StaticOrder S; S.init(g, G, (int)blockIdx.x); \
            pg8::EpiResid E{H, H, m1_ + 2 * DM, 1.0f, 0x7c7c7c7c, 0x79797979}; \
            pg8::gemm_phase<pg8::EpiResid, FP8_MIXOUT != 0>(lds, g, S, E, wave_s); } \
        if (IN(PM_)) SEAM(PM_); \
    } while (0)

    FFN_PHASES(0, 1);
    {
        const float* m1 = mod + 0 * NMOD + 1 * 3 * DM;
        PH_LOOP(4) { if (EN(1) && IN(4)) norm_phase<false>(H, args.in[I_NORMG] + (0 * 3 + 1) * DM, m1, m1 + DM, hn, nullptr, G, wave_s);
        if (IN(4)) SEAM(4); }
        PH_LOOP(5) { if (EN(5) && IN(5)) {
            pg8::Gemm g{hn, (const bf16*)(ws + WS_WIN), SEQ, NIN, DM, DM, DM, 1, 0, 0, nullptr, nullptr, 0, 0, 0, 0, 0};
            pg8::StaticOrder S; S.init(g, G, (int)blockIdx.x);
            pg8::EpiBf16 E{proj, NIN, 0, 1.0f, nullptr, 0, 0, 0.f};
            pg8::gemm_phase<pg8::EpiBf16>(lds, g, S, E, wave_s);
            conv_fill<CI_OUT, 512, CI_FFN(1), 8256, CI_QKV, CI_NQKV>(args, lds, G, S.ntot, wave_s);
        }
        if (IN(5)) SEAM(5); }
        PH_LOOP(6) { if (EN(6) && IN(6)) phase_a2(args, lds, G, wave_s);
        if (IN(6)) SEAM(6); }
        PH_LOOP(24) { if (EN(7) && IN(7)) { s5_scan_out(args, lds, G, wave_s); __syncthreads(); } }
        STAMP(25);
        PH_LOOP(25) { if (EN(8) && IN(7)) dsa_phase(args, lds, G, wave_s); }
        if (IN(7)) SEAM(7);
        PH_LOOP(8) { if (EN(9) && IN(8)) {
            pg8::Gemm g{(const bf16*)(ws + WS_YAPRE), (const bf16*)(ws + WS_WGLU), SEQ, 1024, 1024, 1024, 1024, 1, 0, 0, nullptr, nullptr, 0, 0, 0, 0, 0};
            pg8::StaticOrder S; S.init(g, G, (int)blockIdx.x);
            pg8::EpiGLU E{(const bf16*)(ws + WS_YAPRE), args.in[I_BGLU], (bf16*)(ws + WS_YCAT), NCAT};
            pg8::gemm_phase<pg8::EpiGLU>(lds, g, S, E, wave_s);
            conv_fill<CI_CO, CI_NCO, CI_FFN(2) + 5504, 2752>(args, lds, G, S.ntot, wave_s);
        }
        if (IN(8)) SEAM(8); }
    }
#ifdef EXTRA_BARRIERS
    for (int xb_ = 0; xb_ < EXTRA_BARRIERS; ++xb_) xcd_barrier(bar);
#endif
#ifdef EXP_GEMM
    {
        xcd_barrier(bar);
#if EXP_GEMM == 1
        pg8::Gemm g{hmid, (const bf16*)(ws + WS_WD), SEQ, DM, FFP / 2, FFP / 2, FFP / 2, 1, 0, 0, nullptr, nullptr, 0, 0, 0, 0, 0};
        pg8::StaticOrder S; S.init(g, G, (int)blockIdx.x); S.force = EXP_FORCE;
        pg8::EpiBf16 E{(bf16*)(ws + WS_SCORE), DM, 0, 1.0f, nullptr, 0, 0, 0.f, 0x7c7c7c7c, 0x78787878};
        pg8::gemm_phase<pg8::EpiBf16, true>(lds, g, S, E, wave_s);
#elif EXP_GEMM == 3
        pg8::Gemm g{hmid, (const bf16*)(ws + WS_WD), SEQ, DM, FFP / 2, FFP / 2, FFP / 2, 1, 0, 0, nullptr, nullptr, 0, 0, 0, 0, 0};
        pg8::StaticOrder S; S.init(g, G, (int)blockIdx.x); S.force = EXP_FORCE;
        pg8::EpiResid E{H, (float*)(ws + WS_SCORE), mod + 2 * DM, 0.5f, 0x7c7c7c7c, 0x78787878};
        pg8::gemm_phase<pg8::EpiResid, true>(lds, g, S, E, wave_s);
#elif EXP_GEMM == 2
        pg8::Gemm g{hn, (const bf16*)(ws + WS_WGU), SEQ, NGU, DM / 2, DM / 2, DM / 2, 1, 0, 0, nullptr, nullptr, 0, 0, 0, 0, 0};
        pg8::StaticOrder S; S.init(g, G, (int)blockIdx.x); S.force = EXP_FORCE;
        pg8::EpiBf16 E{(bf16*)(ws + WS_SCORE), NGU, 0, 1.0f, nullptr, 0, 0, 0.f, 0x7c7c7c7c, 0x79797979};
        pg8::gemm_phase<pg8::EpiBf16, true>(lds, g, S, E, wave_s);
#endif
        xcd_barrier(bar);
    }
#endif
    MIXOUT_PHASE(0, 9, ws + WS_YCAT, ws + WS_WOUT, NCAT);
    FFN_PHASES(1, 10);
    FFN_PHASES(2, 13);
    {
        const float* m1 = mod + 1 * NMOD + 1 * 3 * DM;
        PH_LOOP(16) { if (EN(1) && IN(16)) norm_phase<false, FP8_QKV != 0>(H, args.in[I_NORMG] + (1 * 3 + 1) * DM, m1, m1 + DM, hn, nullptr, G, wave_s);
        if (IN(16)) SEAM(16); }
        PH_LOOP(17) { if (EN(10) && IN(17)) {
            constexpr int KU = FP8_QKV ? DM / 2 : DM;
            pg8::Gemm g{hn, (const bf16*)(ws + WS_WQKV), SEQ, 2048, KU, KU, KU, 2, 0, (size_t)2048 * KU,
                        (const bf16*)(ws + WS_WQKV) + (size_t)4096 * KU, hn, 2048, SEQ, 1, 0, 0};
            pg8::StaticOrder S; S.init(g, G, (int)blockIdx.x);
            pg8::EpiBf16 E{(bf16*)(ws + WS_Q), DM, (size_t)SEQ * DM, 1.0f, (bf16*)(ws + WS_VT), SEQ, 0, 1.0f, 0x7c7c7c7c, 0x79797979};
            pg8::gemm_phase<pg8::EpiBf16, FP8_QKV != 0>(lds, g, S, E, wave_s);
        }
        if (IN(17)) SEAM(17); }
        PH_LOOP(18) { if (EN(11) && IN(18)) attn_c_phase(args, lds, G, wave_s);
        if (IN(18)) SEAM(18); }
    }
    MIXOUT_PHASE(1, 19, ws + WS_O, ws + WS_WCOUT, DM);
    FFN_PHASES(3, 20);
    if (EN(13) && IN(23)) { norm_phase<true>(H, args.in[I_FING], nullptr, nullptr, nullptr, args.out, G, wave_s); }
#if TIMING
    {
        xcd_barrier(bar); STAMP(24);
        if (blockIdx.x == 0 && wave_s == 0) {
            const unsigned long long* ts = (const unsigned long long*)(ws + WS_DIAG);
            const unsigned long long a0 = __hip_atomic_load(ts + TSEL_A, __ATOMIC_RELAXED, __HIP_MEMORY_SCOPE_AGENT), a1 = __hip_atomic_load(ts + TSEL_A + TSEL_A_N, __ATOMIC_RELAXED, __HIP_MEMORY_SCOPE_AGENT);
            const unsigned long long want = (a1 - a0) * TAMP, t0 = __builtin_amdgcn_s_memrealtime();
            while (__builtin_amdgcn_s_memrealtime() - t0 < want) __builtin_amdgcn_s_sleep(32);
        }
    }
#endif
#undef IN
#undef SEAM
}

extern "C" void kernel_launch(void* const* d_in, const int* in_sizes, int n_in, void* d_out, int out_size, void* d_ws, size_t ws_size, hipStream_t stream) {
    static int grid = 0;
    if (grid == 0) {
        if (n_in != 26 || out_size != SEQ * DM || ws_size < WS_END) { fprintf(stderr, "kernel_launch: unexpected shapes (n_in %d out %d ws %zu need %zu)\n", n_in, out_size, ws_size, (size_t)WS_END); grid = -1; return; }
        int dev = 0, cus = 0, per_cu = 0;
        if (hipGetDevice(&dev) != hipSuccess || hipDeviceGetAttribute(&cus, hipDeviceAttributeMultiprocessorCount, dev) != hipSuccess) { grid = -1; return; }
        if (hipFuncSetAttribute((const void*)fwd_kernel, hipFuncAttributeMaxDynamicSharedMemorySize, LDS_BYTES) != hipSuccess) { fprintf(stderr, "kernel_launch: hipFuncSetAttribute failed\n"); grid = -1; return; }
        if (hipOccupancyMaxActiveBlocksPerMultiprocessor(&per_cu, (const void*)fwd_kernel, NTHR, LDS_BYTES) != hipSuccess || per_cu < 1) { fprintf(stderr, "kernel_launch: occupancy query says %d\n", per_cu); }
        (void)hipGetLastError();
        grid = cus;
    }
    if (grid < 0) return;
    (void)hipMemsetAsync((char*)d_ws + WS_CTL, 0, CTL_ZERO_BYTES, stream);
    Args a{};
    for (int i = 0; i < 26; ++i) a.in[i] = (const float*)d_in[i];
    a.out = (float*)d_out; a.ws = (unsigned char*)d_ws;
    a.ph_lo = 0; a.ph_hi = N_PHASES_RUN;
    hipLaunchKernelGGL(fwd_kernel, dim3(grid), dim3(NTHR), LDS_BYTES, stream, a);
}
```
